# Optimizing an MI355X kernel written in HIP

```python
import math
import jax
import jax.numpy as jnp
from jax import lax

D_MODEL = 1024
BATCH = 4
SEQ = 8192
DEPTH = 2

QBLOCK = 128
HEAD_DIM = 64
NSA_HEADS = 8
NSA_GROUPS = 2
NSA_HPG = NSA_HEADS // NSA_GROUPS
CMP_LEN = 32
CMP_STRIDE = 16
CMP_HIDDEN = 256
SEL_BLOCK = 64
N_SELECT = 16
WINDOW = 512
FORCE_BONUS = 1.0e4
DIFF_HEADS = 4
DIFF_DIM = 64
MLA_HEADS = 8
MLA_NOPE = 64
MLA_ROPE = 32
MLA_V = 64
Q_LORA = 256
KV_LORA = 128
ROPE_THETA = 10000.0
N_EXPERTS = 16
N_GROUPS = 4
EXPERTS_PER_GROUP = N_EXPERTS // N_GROUPS
TOP_K = 2
D_FF_EXPERT = 512
DEEPNORM_ALPHA = (2 * DEPTH) ** 0.25
DEEPNORM_BETA = (8 * DEPTH) ** -0.25
LN_EPS = 1e-5
RMS_EPS = 1e-6
NSA_WIDTH = NSA_HEADS * HEAD_DIM
NSA_KV = NSA_GROUPS * HEAD_DIM
DIFF_WIDTH = DIFF_HEADS * 2 * DIFF_DIM
MLA_WIDTH = MLA_HEADS * MLA_V
IN_SPLITS = (NSA_WIDTH,) + (NSA_KV,) * 6 + (3 * NSA_HEADS, DIFF_WIDTH, DIFF_WIDTH, DIFF_WIDTH, Q_LORA, KV_LORA, MLA_ROPE, 3 * D_MODEL)
IN_WIDTH = sum(IN_SPLITS)

kernel_name = 'hybrid_nsa_diff_mla_moe_deepnorm'


def layer_norm(x, g, b):
    xf = x.astype(jnp.float32)
    mu = jnp.mean(xf, -1, keepdims=True)
    var = jnp.mean(jnp.square(xf - mu), -1, keepdims=True)
    return ((xf - mu) * lax.rsqrt(var + LN_EPS)).astype(x.dtype) * g + b


def rms_norm(x, g):
    xf = x.astype(jnp.float32)
    return (xf * lax.rsqrt(jnp.mean(xf * xf, -1, keepdims=True) + RMS_EPS)).astype(x.dtype) * g


def masked_softmax(s, mask):
    s = jnp.where(mask, s, -1e30)
    mx = jnp.max(s, -1, keepdims=True)
    e = jnp.where(mask, jnp.exp(s - mx), 0.0)
    return e / jnp.maximum(jnp.sum(e, -1, keepdims=True), 1e-30)


def alibi_slopes():
    n = NSA_HEADS + DIFF_HEADS
    return 2.0 ** (-8.0 * jnp.arange(1, n + 1, dtype=jnp.float32) / n)


def rope(x, pos):
    half = x.shape[-1] // 2
    freqs = ROPE_THETA ** (-jnp.arange(half, dtype=jnp.float32) / half)
    ang = pos.astype(jnp.float32)[:, None] * freqs[None, :]
    shape = (1, x.shape[1]) + (1,) * (x.ndim - 3) + (half,)
    cos = jnp.cos(ang).reshape(shape).astype(x.dtype)
    sin = jnp.sin(ang).reshape(shape).astype(x.dtype)
    x1, x2 = x[..., :half], x[..., half:]
    return jnp.concatenate([x1 * cos - x2 * sin, x1 * sin + x2 * cos], -1)


def split_cols(a, widths):
    out, o = [], 0
    for w in widths:
        out.append(a[..., o:o + w])
        o += w
    return out


def sweep_query_blocks(block_fn, seq):
    n = seq // QBLOCK
    out = lax.map(block_fn, jnp.arange(n, dtype=jnp.int32) * QBLOCK)
    out = jnp.moveaxis(out, 0, 1)
    return out.reshape((out.shape[0], n * QBLOCK) + out.shape[3:])


def compress_blocks(x, pos_emb, w1, w2):
    B, S, G, Dh = x.shape
    ratio = CMP_LEN // CMP_STRIDE
    n_chunk = S // CMP_STRIDE
    n_cmp = n_chunk - ratio + 1
    chunks = x.reshape(B, n_chunk, CMP_STRIDE, G, Dh)
    blocks = jnp.concatenate([chunks[:, j:j + n_cmp] for j in range(ratio)], axis=2)
    blocks = blocks + pos_emb[:, None, :]
    flat = jnp.moveaxis(blocks, 3, 2).reshape(B, n_cmp, G, CMP_LEN * Dh)
    return jax.nn.gelu(flat @ w1) @ w2


def nsa_mixer(q, kc, vc, ks, vs, kw, vw, gates, cmp_pos_k, cmp_w1_k, cmp_w2_k, cmp_pos_v, cmp_w1_v, cmp_w2_v, slopes):
    B, S = q.shape[:2]
    G, Dh = NSA_GROUPS, HEAD_DIM
    scale = Dh ** -0.5
    ratio = CMP_LEN // CMP_STRIDE
    n_chunk = S // CMP_STRIDE
    n_sb = S // SEL_BLOCK
    n_sel = min(N_SELECT, n_sb)
    chunks_per_sb = SEL_BLOCK // CMP_STRIDE
    k_cmp = compress_blocks(kc, cmp_pos_k, cmp_w1_k, cmp_w2_k)
    v_cmp = compress_blocks(vc, cmp_pos_v, cmp_w1_v, cmp_w2_v)
    n_cmp = k_cmp.shape[1]
    cmp_end = jnp.arange(n_cmp) * CMP_STRIDE + (CMP_LEN - 1)
    ks_blk = ks.transpose(0, 2, 1, 3).reshape(B, G, n_sb, SEL_BLOCK, Dh)
    vs_blk = vs.transpose(0, 2, 1, 3).reshape(B, G, n_sb, SEL_BLOCK, Dh)
    kw_pad = jnp.pad(kw, ((0, 0), (WINDOW, 0), (0, 0), (0, 0)))
    vw_pad = jnp.pad(vw, ((0, 0), (WINDOW, 0), (0, 0), (0, 0)))
    slope = slopes.reshape(G, NSA_HPG)[None, :, :, None, None]
    sb_ids = jnp.arange(n_sb)
    gather_blocks = jax.vmap(jax.vmap(lambda a, i: a[i]))

    def block(q0):
        t = q0 + jnp.arange(QBLOCK)
        qb = lax.dynamic_slice_in_dim(q, q0, QBLOCK, 1).reshape(B, QBLOCK, G, NSA_HPG, Dh)
        gb = lax.dynamic_slice_in_dim(gates, q0, QBLOCK, 1).reshape(B, QBLOCK, G, NSA_HPG, 3)
        s_c = jnp.einsum('bqghd,bcgd->bghqc', qb, k_cmp).astype(jnp.float32) * scale
        dist_c = t[:, None] - cmp_end[None, :]
        p_c = masked_softmax(s_c - slope * dist_c.astype(jnp.float32), dist_c >= 0)
        o_c = jnp.einsum('bghqc,bcgd->bqghd', p_c.astype(q.dtype), v_cmp)
        p_grp = jnp.sum(p_c, 2)
        p_pad = jnp.pad(p_grp, ((0, 0), (0, 0), (0, 0), (ratio - 1, ratio - 1)))
        chunk = p_pad[..., ratio - 1:ratio - 1 + n_chunk]
        for j in range(1, ratio):
            chunk = chunk + p_pad[..., ratio - 1 - j:ratio - 1 - j + n_chunk]
        sb_score = chunk.reshape(B, G, QBLOCK, n_sb, chunks_per_sb).sum(-1)
        cur = t // SEL_BLOCK
        forced = (sb_ids[None, :] == 0) | (sb_ids[None, :] == cur[:, None]) | (sb_ids[None, :] == cur[:, None] - 1)
        started = sb_ids[None, :] * SEL_BLOCK <= t[:, None]
        sb_score = jnp.where(forced, sb_score + FORCE_BONUS, sb_score)
        sb_score = jnp.where(started, sb_score, -FORCE_BONUS)
        _, sel = lax.top_k(sb_score, n_sel)
        sel_flat = sel.reshape(B, G, QBLOCK * n_sel)
        k_sel = gather_blocks(ks_blk, sel_flat).reshape(B, G, QBLOCK, n_sel * SEL_BLOCK, Dh)
        v_sel = gather_blocks(vs_blk, sel_flat).reshape(B, G, QBLOCK, n_sel * SEL_BLOCK, Dh)
        pos_sel = (sel[..., None] * SEL_BLOCK + jnp.arange(SEL_BLOCK)).reshape(B, G, QBLOCK, n_sel * SEL_BLOCK)
        dist_s = (t[None, None, :, None] - pos_sel)[:, :, None]
        s_s = jnp.einsum('bqghd,bgqkd->bghqk', qb, k_sel).astype(jnp.float32) * scale
        p_s = masked_softmax(s_s - slope * dist_s.astype(jnp.float32), dist_s >= 0)
        o_s = jnp.einsum('bghqk,bgqkd->bqghd', p_s.astype(q.dtype), v_sel)
        k_w = lax.dynamic_slice_in_dim(kw_pad, q0, WINDOW + QBLOCK, 1)
        v_w = lax.dynamic_slice_in_dim(vw_pad, q0, WINDOW + QBLOCK, 1)
        s_pos = q0 - WINDOW + jnp.arange(WINDOW + QBLOCK)
        dist_w = t[:, None] - s_pos[None, :]
        mask_w = (dist_w >= 0) & (dist_w < WINDOW) & (s_pos[None, :] >= 0)
        s_w = jnp.einsum('bqghd,bkgd->bghqk', qb, k_w).astype(jnp.float32) * scale
        p_w = masked_softmax(s_w - slope * dist_w.astype(jnp.float32), mask_w)
        o_w = jnp.einsum('bghqk,bkgd->bqghd', p_w.astype(q.dtype), v_w)
        o = gb[..., 0:1] * o_c + gb[..., 1:2] * o_s + gb[..., 2:3] * o_w
        return o.reshape(B, QBLOCK, NSA_HEADS * Dh)

    return sweep_query_blocks(block, S)


def diff_mixer(q, k, v, lam_params, subln_g, lam_init, slopes):
    B, S = q.shape[:2]
    d = DIFF_DIM
    scale = d ** -0.5
    q1, q2 = q[..., :d], q[..., d:]
    k1, k2 = k[..., :d], k[..., d:]
    lp = lam_params.astype(jnp.float32)
    lam = jnp.exp(jnp.sum(lp[0] * lp[1])) - jnp.exp(jnp.sum(lp[2] * lp[3])) + lam_init
    slope = slopes[None, :, None, None]
    key_pos = jnp.arange(S)

    def block(q0):
        t = q0 + jnp.arange(QBLOCK)
        dist = t[:, None] - key_pos[None, :]
        mask = dist >= 0
        bias = -slope * dist.astype(jnp.float32)
        q1b = lax.dynamic_slice_in_dim(q1, q0, QBLOCK, 1)
        q2b = lax.dynamic_slice_in_dim(q2, q0, QBLOCK, 1)
        a1 = masked_softmax(jnp.einsum('bqhd,bkhd->bhqk', q1b, k1).astype(jnp.float32) * scale + bias, mask)
        a2 = masked_softmax(jnp.einsum('bqhd,bkhd->bhqk', q2b, k2).astype(jnp.float32) * scale + bias, mask)
        a = a1 - lam * a2
        return jnp.einsum('bhqk,bkhd->bqhd', a.astype(v.dtype), v)

    o = sweep_query_blocks(block, S)
    o = rms_norm(o, subln_g) * (1.0 - lam_init)
    return o.reshape(B, S, DIFF_HEADS * 2 * d)


def mla_mixer(c_q, c_kv, k_r, q_norm_g, kv_norm_g, w_uq, w_ukv):
    B, S = c_q.shape[:2]
    pos = jnp.arange(S)
    q = (rms_norm(c_q, q_norm_g) @ w_uq).reshape(B, S, MLA_HEADS, MLA_NOPE + MLA_ROPE)
    q_n, q_r = q[..., :MLA_NOPE], rope(q[..., MLA_NOPE:], pos)
    kv = (rms_norm(c_kv, kv_norm_g) @ w_ukv).reshape(B, S, MLA_HEADS, MLA_NOPE + MLA_V)
    k_n, v = kv[..., :MLA_NOPE], kv[..., MLA_NOPE:]
    k_r = rope(k_r, pos)
    scale = (MLA_NOPE + MLA_ROPE) ** -0.5
    key_pos = jnp.arange(S)

    def block(q0):
        t = q0 + jnp.arange(QBLOCK)
        qn = lax.dynamic_slice_in_dim(q_n, q0, QBLOCK, 1)
        qr = lax.dynamic_slice_in_dim(q_r, q0, QBLOCK, 1)
        s = (jnp.einsum('bqhd,bkhd->bhqk', qn, k_n) + jnp.einsum('bqhr,bkr->bhqk', qr, k_r)).astype(jnp.float32) * scale
        p = masked_softmax(s, key_pos[None, :] <= t[:, None])
        return jnp.einsum('bhqk,bkhd->bqhd', p.astype(v.dtype), v)

    o = sweep_query_blocks(block, S)
    return o.reshape(B, S, MLA_HEADS * MLA_V)


def mixer_block(h, layer, w_in, cmp_pos_k, cmp_w1_k, cmp_w2_k, cmp_pos_v, cmp_w1_v, cmp_w2_v, diff_lambda, diff_subln_g, mla_q_norm_g, mla_kv_norm_g, mla_w_uq, mla_w_ukv, w_br_nsa, w_br_diff, w_br_mla, w_out):
    B, S, _ = h.shape
    nq, kc, vc, ks, vs, kw, vw, ng, dq, dk, dv, cq, ckv, kr, mg = split_cols(h @ w_in, IN_SPLITS)

    def heads(a, n):
        return a.reshape(B, S, n, -1)

    slopes = alibi_slopes()
    o_nsa = nsa_mixer(heads(nq, NSA_HEADS), heads(kc, NSA_GROUPS), heads(vc, NSA_GROUPS), heads(ks, NSA_GROUPS), heads(vs, NSA_GROUPS), heads(kw, NSA_GROUPS), heads(vw, NSA_GROUPS), jax.nn.sigmoid(heads(ng, NSA_HEADS)), cmp_pos_k, cmp_w1_k, cmp_w2_k, cmp_pos_v, cmp_w1_v, cmp_w2_v, slopes[:NSA_HEADS])
    lam_init = 0.8 - 0.6 * math.exp(-0.3 * layer)
    o_diff = diff_mixer(heads(dq, DIFF_HEADS), heads(dk, DIFF_HEADS), heads(dv, DIFF_HEADS), diff_lambda, diff_subln_g, lam_init, slopes[NSA_HEADS:])
    o_mla = mla_mixer(cq, ckv, kr, mla_q_norm_g, mla_kv_norm_g, mla_w_uq, mla_w_ukv)
    g = jax.nn.sigmoid(mg).reshape(B, S, 3, D_MODEL)
    y = g[:, :, 0] * (o_nsa @ w_br_nsa) + g[:, :, 1] * (o_diff @ w_br_diff) + g[:, :, 2] * (o_mla @ w_br_mla)
    return y @ w_out


def moe_ffn(h, router_w, router_b, w1, w3, w2):
    B, S, D = h.shape
    hf = h.reshape(B * S, D)
    aff = jax.nn.sigmoid((hf @ router_w).astype(jnp.float32))
    sel = (aff + router_b.astype(jnp.float32)).reshape(-1, N_GROUPS, EXPERTS_PER_GROUP)
    grp_score = jnp.sum(lax.top_k(sel, TOP_K)[0], -1)
    grp = jnp.argmax(grp_score, -1)
    in_grp = jnp.einsum('tge,tg->te', sel, jax.nn.one_hot(grp, N_GROUPS, dtype=jnp.float32))
    _, local = lax.top_k(in_grp, TOP_K)
    eidx = grp[:, None] * EXPERTS_PER_GROUP + local
    gate = jnp.take_along_axis(aff, eidx, axis=1)
    gate = gate / jnp.sum(gate, -1, keepdims=True)
    combine = jnp.einsum('tk,tke->te', gate, jax.nn.one_hot(eidx, N_EXPERTS, dtype=jnp.float32)).astype(h.dtype)
    y = jnp.zeros_like(hf)
    for e in range(N_EXPERTS):
        y = y + combine[:, e:e + 1] * ((jax.nn.silu(hf @ w1[e]) * (hf @ w3[e])) @ w2[e])
    return y.reshape(B, S, D)


def setup_inputs(seed: int = 0) -> dict:
    key = jax.random.key(seed)
    ks = jax.random.split(key, 32)
    L, D = DEPTH, D_MODEL

    def nrm(k, shape, scale):
        return jax.random.normal(k, shape, jnp.float32) * scale

    return {
        'x': nrm(ks[0], (BATCH, SEQ, D), 1.0),
        'ln_in_g': 1.0 + nrm(ks[1], (D,), 0.02),
        'ln_in_b': nrm(ks[2], (D,), 0.02),
        'w_in': nrm(ks[3], (L, D, IN_WIDTH), D ** -0.5),
        'cmp_pos_k': nrm(ks[4], (L, CMP_LEN, HEAD_DIM), 0.1),
        'cmp_w1_k': nrm(ks[5], (L, CMP_LEN * HEAD_DIM, CMP_HIDDEN), (CMP_LEN * HEAD_DIM) ** -0.5),
        'cmp_w2_k': nrm(ks[6], (L, CMP_HIDDEN, HEAD_DIM), CMP_HIDDEN ** -0.5),
        'cmp_pos_v': nrm(ks[7], (L, CMP_LEN, HEAD_DIM), 0.1),
        'cmp_w1_v': nrm(ks[8], (L, CMP_LEN * HEAD_DIM, CMP_HIDDEN), (CMP_LEN * HEAD_DIM) ** -0.5),
        'cmp_w2_v': nrm(ks[9], (L, CMP_HIDDEN, HEAD_DIM), CMP_HIDDEN ** -0.5),
        'diff_lambda': nrm(ks[10], (L, 4, DIFF_DIM), 0.1),
        'diff_subln_g': 1.0 + nrm(ks[11], (L, 2 * DIFF_DIM), 0.02),
        'mla_q_norm_g': 1.0 + nrm(ks[12], (L, Q_LORA), 0.02),
        'mla_kv_norm_g': 1.0 + nrm(ks[13], (L, KV_LORA), 0.02),
        'mla_w_uq': nrm(ks[14], (L, Q_LORA, MLA_HEADS * (MLA_NOPE + MLA_ROPE)), Q_LORA ** -0.5),
        'mla_w_ukv': nrm(ks[15], (L, KV_LORA, MLA_HEADS * (MLA_NOPE + MLA_V)), KV_LORA ** -0.5),
        'w_br_nsa': nrm(ks[16], (L, NSA_WIDTH, D), NSA_WIDTH ** -0.5),
        'w_br_diff': nrm(ks[17], (L, DIFF_WIDTH, D), DIFF_WIDTH ** -0.5),
        'w_br_mla': nrm(ks[18], (L, MLA_WIDTH, D), MLA_WIDTH ** -0.5),
        'w_out': nrm(ks[19], (L, D, D), D ** -0.5 * DEEPNORM_BETA),
        'ln1_g': 1.0 + nrm(ks[20], (L, D), 0.02),
        'ln1_b': nrm(ks[21], (L, D), 0.02),
        'router_w': nrm(ks[22], (D, N_EXPERTS), D ** -0.5),
        'router_b': nrm(ks[23], (N_EXPERTS,), 0.01),
        'moe_w1': nrm(ks[24], (L, N_EXPERTS, D, D_FF_EXPERT), D ** -0.5),
        'moe_w3': nrm(ks[25], (L, N_EXPERTS, D, D_FF_EXPERT), D ** -0.5),
        'moe_w2': nrm(ks[26], (L, N_EXPERTS, D_FF_EXPERT, D), D_FF_EXPERT ** -0.5 * DEEPNORM_BETA),
        'ln2_g': 1.0 + nrm(ks[27], (L, D), 0.02),
        'ln2_b': nrm(ks[28], (L, D), 0.02),
    }


def reference(x, ln_in_g, ln_in_b, w_in, cmp_pos_k, cmp_w1_k, cmp_w2_k, cmp_pos_v, cmp_w1_v, cmp_w2_v, diff_lambda, diff_subln_g, mla_q_norm_g, mla_kv_norm_g, mla_w_uq, mla_w_ukv, w_br_nsa, w_br_diff, w_br_mla, w_out, ln1_g, ln1_b, router_w, router_b, moe_w1, moe_w3, moe_w2, ln2_g, ln2_b):
    h = layer_norm(x, ln_in_g, ln_in_b)
    for l in range(DEPTH):
        mix = mixer_block(h, l, w_in[l], cmp_pos_k[l], cmp_w1_k[l], cmp_w2_k[l], cmp_pos_v[l], cmp_w1_v[l], cmp_w2_v[l], diff_lambda[l], diff_subln_g[l], mla_q_norm_g[l], mla_kv_norm_g[l], mla_w_uq[l], mla_w_ukv[l], w_br_nsa[l], w_br_diff[l], w_br_mla[l], w_out[l])
        h = layer_norm(DEEPNORM_ALPHA * h + mix, ln1_g[l], ln1_b[l])
        ffn = moe_ffn(h, router_w, router_b, moe_w1[l], moe_w3[l], moe_w2[l])
        h = layer_norm(DEEPNORM_ALPHA * h + ffn, ln2_g[l], ln2_b[l])
    return h
```

```cpp
#include <hip/hip_runtime.h>
#include <cstdio>
#include <cstdint>

#ifndef MK_PER_PHASE
#define MK_PER_PHASE 0
#endif

#ifndef PROBE_REPEAT
#define PROBE_REPEAT 0
#endif
#ifndef PHMASK
#define PHMASK 0xFFFF
#endif
#define PHON(i) (((PHMASK) >> (i)) & 1)
#define LAS __attribute__((address_space(3)))
#define GAS __attribute__((address_space(1)))
typedef unsigned short bf16;
typedef short bf16x8 __attribute__((ext_vector_type(8)));
typedef short s16x4 __attribute__((ext_vector_type(4)));
typedef float f32x2 __attribute__((ext_vector_type(2)));
typedef float f32x4 __attribute__((ext_vector_type(4)));
typedef float f32x16 __attribute__((ext_vector_type(16)));
typedef unsigned u32x2 __attribute__((ext_vector_type(2)));
typedef unsigned u32x4 __attribute__((ext_vector_type(4)));
typedef __bf16 bf16x2_t __attribute__((ext_vector_type(2)));
typedef short v4i16_t __attribute__((ext_vector_type(4)));

constexpr int T = 32768, S = 8192, NB = 4, DM = 1024, NLAYER = 2;
constexpr int IN_W = 6328;
constexpr int PW = 3328;
constexpr int PC_NQ = 0, PC_KC = 512, PC_VC = 640, PC_KS = 768, PC_VS = 896, PC_KW = 1024, PC_VW = 1152, PC_DQ = 1280, PC_DK = 1792, PC_DV = 2304,
              PC_CQ = 2816, PC_CKV = 3072, PC_KR = 3200, PC_NG = 3232;
constexpr float LOG2E = 1.4426950408889634f;
constexpr float ALPHA = 1.4142135623730951f;
constexpr int NEXP = 16, CAP = 32768, DFF = 512;

constexpr size_t MiB = 1u << 20;
constexpr size_t WS_CTL = 0, CTL_BYTES = 1 * MiB;
constexpr size_t WS_CS = 1 * MiB;
constexpr size_t WS_MISC = 2 * MiB;
constexpr size_t WS_RSQ = 3 * MiB;
constexpr size_t WS_RSKV = WS_RSQ + 256 * 1024;
constexpr size_t WS_RTE = 4 * MiB;
constexpr size_t WS_RTP = WS_RTE + 512 * 1024;
constexpr size_t WS_RTG = WS_RTP + 512 * 1024;
constexpr size_t WS_ROWIDX = 6 * MiB;
constexpr size_t WS_KCMP = 8 * MiB;
constexpr size_t WS_VCMP = WS_KCMP + 512 * 1024;
constexpr size_t WS_UL = 10 * MiB;
constexpr size_t WS_WTS = 32 * MiB;
constexpr size_t WL_WIN = 0, WL_WG = 7 * MiB, WL_WBR = 13 * MiB, WL_WOUT = 16 * MiB, WL_WUQ = 18 * MiB, WL_WUKV = 18 * MiB + 512 * 1024, WL_WC1 = 19 * MiB, WL_STRIDE = 22 * MiB;
constexpr size_t WS_HB = 76 * MiB;
constexpr size_t WS_P = 140 * MiB;
constexpr size_t WS_HS = WS_P + 136 * MiB;
constexpr size_t WS_GS = 348 * MiB;
constexpr size_t WS_END = 444 * MiB;
constexpr size_t DO_QM = 0, DO_KVM = 48 * MiB, DO_W13 = 0, DO_W2 = 32 * MiB;

constexpr int CW_BAR = 4096;
constexpr int CW_CNT = 16384;

constexpr int LDS_RING = 131072, LDS_MISC = 131072, LDS_BYTES = 147456;
constexpr int NPHASE = 1 + 11 * NLAYER;

__device__ __forceinline__ int lane_id_v() { int l; asm volatile("v_mbcnt_lo_u32_b32 %0, -1, 0\n\tv_mbcnt_hi_u32_b32 %0, -1, %0" : "=v"(l)); return l; }
__device__ __forceinline__ unsigned f2bf(float f) { unsigned u = __builtin_bit_cast(unsigned, f); return (u + 0x7fffu + ((u >> 16) & 1u)) >> 16; }
__device__ __forceinline__ unsigned pk2(float lo, float hi) { f32x2 v = {lo, hi}; bf16x2_t b = __builtin_convertvector(v, bf16x2_t); return __builtin_bit_cast(unsigned, b); }
__device__ __forceinline__ float bflo(unsigned w) { return __uint_as_float(w << 16); }
__device__ __forceinline__ float bfhi(unsigned w) { return __uint_as_float(w & 0xffff0000u); }
__device__ __forceinline__ float bf2f(bf16 v) { return __uint_as_float(((unsigned)v) << 16); }
__device__ __forceinline__ float fexp2(float x) { return __builtin_amdgcn_exp2f(x); }
__device__ __forceinline__ float sigmoidf_(float x) { return 1.0f / (1.0f + __expf(-x)); }
__device__ __forceinline__ float wave_sum(float v) {
#pragma unroll
    for (int o = 1; o < 64; o <<= 1) v += __shfl_xor(v, o);
    return v;
}
__device__ __forceinline__ float hmax(float v) { auto rr = __builtin_amdgcn_permlane32_swap(__float_as_uint(v), __float_as_uint(v), false, false); return fmaxf(__uint_as_float(rr[0]), __uint_as_float(rr[1])); }
__device__ __forceinline__ float hsum(float v) { auto rr = __builtin_amdgcn_permlane32_swap(__float_as_uint(v), __float_as_uint(v), false, false); return __uint_as_float(rr[0]) + __uint_as_float(rr[1]); }

#define XB_TMO      128
#define XB_XCNT(j)  (256  + 64 * (j))
#define XB_XSUB(j)  (1280 + 64 * (j))
#define XB_XGEN(j)  (2304 + 64 * (j))
#define XB_TOP      3328
#define XB_TOPGEN   3392
#define XCD_BAR_WORDS 3456
#define XB_SPIN_CAP (1u << 23)
__device__ __forceinline__ unsigned xb_ld(unsigned* p)              { return __hip_atomic_load(p, __ATOMIC_RELAXED, __HIP_MEMORY_SCOPE_AGENT); }
__device__ __forceinline__ unsigned xb_add(unsigned* p, unsigned v) { return __hip_atomic_fetch_add(p, v, __ATOMIC_RELAXED, __HIP_MEMORY_SCOPE_AGENT); }
__device__ __forceinline__ unsigned xb_xcc_id() { return (unsigned)__builtin_amdgcn_s_getreg((3 << 11) | 20) & 0xFu; }
#define XB_SPIN(cond, bar) do { unsigned _sp = 0; while (cond) { __builtin_amdgcn_s_sleep(1); \
    if ((++_sp & 255u) == 0u) { if (xb_ld(&(bar)[XB_TMO])) break; if (_sp > XB_SPIN_CAP) { atomicAdd(&(bar)[XB_TMO], 1u); break; } } } } while (0)
struct XcdBarrier { unsigned* bar; unsigned x; volatile LAS unsigned* st; };
__device__ __forceinline__ XcdBarrier xcd_barrier_post(unsigned* bar, volatile LAS unsigned* st) {
    XcdBarrier b; b.bar = bar; b.x = xb_xcc_id(); b.st = st;
    if (threadIdx.x == 0) (void)xb_add(&bar[XB_XCNT(b.x)], 1u);
    return b;
}
__device__ __forceinline__ void xcd_barrier_complete(unsigned* bar, unsigned x, unsigned& nloc, unsigned& nx) {
    const unsigned G = gridDim.x * gridDim.y * gridDim.z;
    unsigned sum, cnt, mine, sp = 0u;
    for (;;) {
        sum = 0u; cnt = 0u; mine = 0u;
#pragma unroll
        for (unsigned j = 0; j < 16; ++j) { const unsigned c = xb_ld(&bar[XB_XCNT(j)]); sum += c; cnt += (c > 0u) ? 1u : 0u; mine = (j == x) ? c : mine; }
        if (sum == G) break;
        __builtin_amdgcn_s_sleep(1);
        if ((++sp & 255u) == 0u) { if (xb_ld(&bar[XB_TMO])) break; if (sp > XB_SPIN_CAP) { atomicAdd(&bar[XB_TMO], 1u); break; } }
    }
    nloc = mine > 0u ? mine : 1u; nx = cnt > 0u ? cnt : 1u;
}
__device__ __forceinline__ void xcd_barrier(const XcdBarrier& b) {
    asm volatile("s_waitcnt vmcnt(0)" ::: "memory");
    __syncthreads();
    if (threadIdx.x == 0) {
        unsigned* bar = b.bar;
        __builtin_amdgcn_s_waitcnt(0);
        unsigned nloc = b.st[0], nx = b.st[1];
        if (nloc == 0u) { xcd_barrier_complete(bar, b.x, nloc, nx); b.st[0] = nloc; b.st[1] = nx; }
        const unsigned old = xb_add(&bar[XB_XSUB(b.x)], 1u);
        const unsigned gen = old / nloc;
        if (old + 1u == (gen + 1u) * nloc) {
            __builtin_amdgcn_fence(__ATOMIC_RELEASE, "agent");
            asm volatile("s_waitcnt vmcnt(0)" ::: "memory");
            const unsigned og = xb_add(&bar[XB_TOP], 1u);
            const unsigned tg = og / nx;
            if (og + 1u == (tg + 1u) * nx) xb_add(&bar[XB_TOPGEN], 1u);
            else XB_SPIN(xb_ld(&bar[XB_TOPGEN]) == tg, bar);
            __builtin_amdgcn_fence(__ATOMIC_ACQUIRE, "agent");
            xb_add(&bar[XB_XGEN(b.x)], 1u);
            asm volatile("s_waitcnt vmcnt(0)" ::: "memory");
        } else {
            XB_SPIN(xb_ld(&bar[XB_XGEN(b.x)]) == gen, bar);
            __builtin_amdgcn_fence(__ATOMIC_ACQUIRE, "agent");
            asm volatile("s_waitcnt vmcnt(0)" ::: "memory");
        }
    }
    __syncthreads();
}

namespace pg8 {
constexpr int BM = 256, BK = 64, HALF = 128, HTB = HALF * BK * 2, STAGE_BYTES = 8 * HTB;
__device__ __forceinline__ int lds_byte(int r, int c) { const int st = (r >> 4) * 2 + (c >> 5), rr = r & 15, cc = c & 31, ob = rr * 64 + cc * 2; return st * 1024 + (ob ^ (((ob >> 9) & 1) << 5)); }
__device__ __forceinline__ void stage_rc(int b, int& R, int& C) { const int st = b / 1024, sb = b % 1024, swz = sb ^ (((sb >> 9) & 1) << 5); R = (st >> 1) * 16 + swz / 64; C = (st & 1) * 32 + (swz % 64) / 2; }
__device__ __forceinline__ int perm32(int rho) { const int n = rho >> 4, i = rho & 15; return 8 * (i >> 2) + 4 * n + (i & 3); }
struct Unit { int pm, pn, e; };
__device__ __forceinline__ void glds16_s(const void* sbase, unsigned voff, unsigned lds_dst) { unsigned keep;
    asm volatile("s_mov_b32 %0, m0\n\ts_mov_b32 m0, %3\n\ts_nop 0\n\tglobal_load_lds_dwordx4 %1, %2\n\ts_mov_b32 m0, %0" : "=&s"(keep) : "v"(voff), "s"(sbase), "s"(lds_dst) : "memory"); }
template <class Epi, class Sched, bool ALIGN_EPI>
__device__ __forceinline__ void gemm_phase(LAS unsigned char* lds, const int wid_in, const int K, const unsigned kstepA, const Sched& S, const Epi& E) {
    const int wid = wid_in, lane = lane_id_v(), tid = wid * 64 + lane, wr = wid >> 2, wc = wid & 3, fr = lane & 15, fq = lane >> 4;
    const int nt = K / BK;
    int Rr[2], Cc[2]; unsigned voffB[2];
#pragma unroll
    for (int i = 0; i < 2; ++i) { int R, C; stage_rc(tid * 16 + i * 8192, R, C); Rr[i] = R; Cc[i] = C; const int Rb = (R & ~31) + perm32(R & 31); voffB[i] = (unsigned)(Rb * K + C) * 2u; }
    const size_t kstepB = (size_t)(BK * 2);
    const size_t hstepB = (size_t)HALF * K * 2;
    const unsigned ldsb = (unsigned)(uintptr_t)lds + (unsigned)wid * 1024u;
    const int aoff = lds_byte(wr * 64 + fr, fq * 8), boff = lds_byte(wc * 32 + fr, fq * 8);
#define PG8_SA(b, h) (((b) * 2 + (h)) * HTB)
#define PG8_SB(b, h) ((4 + (b) * 2 + (h)) * HTB)
#define PG8_STAGE(bufoff, gbase, voff) do { _Pragma("unroll") for (int _i = 0; _i < 2; ++_i) \
        glds16_s((const void*)(gbase), (voff)[_i], ldsb + (unsigned)((bufoff) + _i * 8192)); } while (0)
#define PG8_LDA(dst, b, h) do { _Pragma("unroll") for (int m = 0; m < 4; ++m) _Pragma("unroll") for (int k = 0; k < 2; ++k) dst[m][k] = *(const LAS bf16x8*)(lds + PG8_SA(b, h) + aoff + m * 2048 + k * 1024); } while (0)
#define PG8_LDB(dst, b, h) do { _Pragma("unroll") for (int n = 0; n < 2; ++n) _Pragma("unroll") for (int k = 0; k < 2; ++k) dst[n][k] = *(const LAS bf16x8*)(lds + PG8_SB(b, h) + boff + n * 2048 + k * 1024); } while (0)
#define PG8_MMA(ai, bj, At, Bt) do { __builtin_amdgcn_s_setprio(1); _Pragma("unroll") for (int m = 0; m < 4; ++m) _Pragma("unroll") for (int n = 0; n < 2; ++n) _Pragma("unroll") for (int k = 0; k < 2; ++k) \
        acc[ai][bj][m][n] = __builtin_amdgcn_mfma_f32_16x16x32_bf16(Bt[n][k], At[m][k], acc[ai][bj][m][n], 0, 0, 0); __builtin_amdgcn_s_setprio(0); } while (0)
#define PG8_WAIT_V(n) asm volatile("s_waitcnt vmcnt(" #n ")" ::: "memory")
#define PG8_WAIT_L(n) asm volatile("s_waitcnt lgkmcnt(" #n ")" ::: "memory")
#define PG8_BAR __builtin_amdgcn_s_barrier()
#define PG8_SCHED __builtin_amdgcn_sched_barrier(0)
    Unit cur, nxt; int ui = 0;
    if (!S.next(0, cur)) return;
    f32x4 acc[2][2][4][2];
#pragma unroll
    for (int a = 0; a < 2; ++a)
#pragma unroll
        for (int b = 0; b < 2; ++b)
#pragma unroll
            for (int m = 0; m < 4; ++m)
#pragma unroll
                for (int n = 0; n < 2; ++n) acc[a][b][m][n] = (f32x4){0.f, 0.f, 0.f, 0.f};
    bf16x8 At[4][2], B0[2][2], B1[2][2];
    const char* cA; const char* cB; unsigned vc[2][2], vn[2][2];
    S.ptrs(cur, cA, cB); S.aoff(cur, Rr, Cc, vc);
    unsigned ksA = kstepA, ksN = kstepA;
    if constexpr (Sched::VAR_KSTEP) { ksA = S.kstep(cur); ksN = ksA; }
    PG8_STAGE(PG8_SB(0, 0), cB, voffB); PG8_STAGE(PG8_SB(0, 1), cB + hstepB, voffB); PG8_STAGE(PG8_SA(0, 0), cA, vc[0]); PG8_STAGE(PG8_SA(0, 1), cA, vc[1]);
    if (wr == 1) PG8_BAR;
    PG8_WAIT_V(2); PG8_BAR;
    PG8_STAGE(PG8_SB(1, 0), cB + kstepB, voffB); PG8_STAGE(PG8_SA(1, 0), cA + ksA, vc[0]); PG8_STAGE(PG8_SB(1, 1), cB + hstepB + kstepB, voffB);
    PG8_WAIT_V(6); PG8_BAR;
    for (;;) {
        const bool has_next = S.next(ui + 1, nxt);
        const char* nA = cA; const char* nB = cB;
        if (has_next) { S.ptrs(nxt, nA, nB); if constexpr (Sched::PER_UNIT_AOFF && !Sched::AOFF_CHEAP) S.aoff(nxt, Rr, Cc, vn); if constexpr (Sched::VAR_KSTEP) ksN = S.kstep(nxt); }
        else if constexpr (Sched::PER_UNIT_AOFF) {
            if constexpr (Sched::AOFF_CHEAP) nxt = cur;
#pragma unroll
            for (int h = 0; h < 2; ++h)
#pragma unroll
                for (int i = 0; i < 2; ++i) vn[h][i] = vc[h][i];
        }
        for (int t = 0; t < nt; t += 2) {
            const bool last = (t == nt - 2);
            const char* a1 = cA + (size_t)(t + 1) * ksA;
            const char* a2 = last ? nA : cA + (size_t)(t + 2) * ksA; const char* b2 = last ? nB : cB + (size_t)(t + 2) * kstepB;
            const char* a3 = a2 + (last ? ksN : ksA); const char* b3 = b2 + kstepB;
#define PG8_STAGE_A2(bufoff, gbase, h) do { if constexpr (Sched::PER_UNIT_AOFF) { if (last) { if constexpr (Sched::AOFF_CHEAP) { unsigned vt_[2][2]; S.aoff(nxt, Rr, Cc, vt_); PG8_STAGE(bufoff, gbase, vt_[h]); } else PG8_STAGE(bufoff, gbase, vn[h]); } else PG8_STAGE(bufoff, gbase, vc[h]); } else PG8_STAGE(bufoff, gbase, vc[h]); } while (0)
            PG8_LDB(B0, 0, 0); PG8_LDB(B1, 0, 1); PG8_SCHED; PG8_LDA(At, 0, 0); PG8_STAGE(PG8_SA(1, 1), a1, vc[1]);
            PG8_WAIT_V(8); PG8_WAIT_L(0); PG8_BAR; PG8_MMA(0, 0, At, B0); PG8_MMA(0, 1, At, B1); PG8_BAR; PG8_SCHED;
            PG8_LDA(At, 0, 1); PG8_STAGE(PG8_SB(0, 0), b2, voffB); PG8_STAGE(PG8_SB(0, 1), b2 + hstepB, voffB); PG8_STAGE_A2(PG8_SA(0, 0), a2, 0);
            PG8_WAIT_V(8); PG8_WAIT_L(0); PG8_BAR; PG8_MMA(1, 0, At, B0); PG8_MMA(1, 1, At, B1); PG8_BAR; PG8_SCHED;
            PG8_LDB(B0, 1, 0); PG8_LDB(B1, 1, 1); PG8_SCHED; PG8_LDA(At, 1, 0); PG8_STAGE_A2(PG8_SA(0, 1), a2, 1);
            PG8_WAIT_V(8); PG8_WAIT_L(0); PG8_BAR; PG8_MMA(0, 0, At, B0); PG8_MMA(0, 1, At, B1); PG8_BAR; PG8_SCHED;
            PG8_LDA(At, 1, 1); PG8_STAGE(PG8_SB(1, 0), b3, voffB); PG8_STAGE(PG8_SB(1, 1), b3 + hstepB, voffB); PG8_STAGE_A2(PG8_SA(1, 0), a3, 0);
            PG8_WAIT_V(8); PG8_WAIT_L(0); PG8_BAR; PG8_MMA(1, 0, At, B0); PG8_MMA(1, 1, At, B1); PG8_BAR; PG8_SCHED;
        }
        if constexpr (ALIGN_EPI) { if (wr == 0) PG8_BAR; }
        E(acc, cur, wr, wc, fr, fq);
        if (!has_next) break;
        bool keep = false; if constexpr (Epi::CHAIN) keep = E.keep(cur);
        if (!keep) {
#pragma unroll
        for (int a = 0; a < 2; ++a)
#pragma unroll
            for (int b = 0; b < 2; ++b)
#pragma unroll
                for (int m = 0; m < 4; ++m)
#pragma unroll
                    for (int n = 0; n < 2; ++n) acc[a][b][m][n] = (f32x4){0.f, 0.f, 0.f, 0.f};
        }
        cur = nxt; cA = nA; cB = nB; ++ui; ksA = ksN;
        if constexpr (Sched::PER_UNIT_AOFF) {
            if constexpr (Sched::AOFF_CHEAP) S.aoff(cur, Rr, Cc, vc);
            else {
#pragma unroll
            for (int h = 0; h < 2; ++h)
#pragma unroll
                for (int i = 0; i < 2; ++i) vc[h][i] = vn[h][i];
            }
        }
        if constexpr (ALIGN_EPI) { if (wr == 1) PG8_BAR; }
    }
    PG8_WAIT_V(0);
    if constexpr (!ALIGN_EPI) { if (wr == 0) PG8_BAR; }
    PG8_BAR;
#undef PG8_SA
#undef PG8_SB
#undef PG8_STAGE
#undef PG8_STAGE_A2
#undef PG8_LDA
#undef PG8_LDB
#undef PG8_MMA
#undef PG8_WAIT_V
#undef PG8_WAIT_L
#undef PG8_BAR
#undef PG8_SCHED
}

struct TileSched {
    static constexpr bool AOFF_CHEAP = false;
    static constexpr bool VAR_KSTEP = false;
    static constexpr bool PER_UNIT_AOFF = false;
    const char* A; const char* Bt; int lda; int K; int nN; int ntot; int G; int v;
    __device__ __forceinline__ bool next(int i, Unit& u) const { const int L = i * G + v; if (L >= ntot) return false; u.pm = L / nN; u.pn = L % nN; u.e = i; return true; }
    __device__ __forceinline__ void ptrs(const Unit& u, const char*& cA, const char*& cB) const { cA = A + (size_t)u.pm * 256 * lda; cB = Bt + (size_t)u.pn * 256 * K * 2; }
    __device__ __forceinline__ void aoff(const Unit&, const int (&R)[2], const int (&C)[2], unsigned (&vo)[2][2]) const {
#pragma unroll
        for (int h = 0; h < 2; ++h)
#pragma unroll
            for (int i = 0; i < 2; ++i) vo[h][i] = (unsigned)((h * 128 + R[i]) * lda + C[i] * 2);
    }
};
struct CmpSched {
    static constexpr bool AOFF_CHEAP = false;
    static constexpr bool VAR_KSTEP = false;
    static constexpr bool PER_UNIT_AOFF = false;
    const char* P; const char* W; int G; int v;
    __device__ __forceinline__ bool next(int i, Unit& u) const { const int L = i * G + v; if (L >= 64) return false; u.pm = (L >> 1) & 1; u.pn = L & 1; u.e = L >> 2; return true; }
    __device__ __forceinline__ void ptrs(const Unit& u, const char*& cA, const char*& cB) const {
        const int kv = u.e >> 3, b = (u.e >> 1) & 3, g = u.e & 1;
        cA = P + ((size_t)(b * S + u.pm * 4096) * PW + PC_KC + kv * 128 + g * 64) * 2; cB = W + (size_t)kv * (512 * 1024 * 2) + (size_t)u.pn * 256 * 2048; }
    __device__ __forceinline__ void aoff(const Unit&, const int (&R)[2], const int (&C)[2], unsigned (&vo)[2][2]) const {
#pragma unroll
        for (int h = 0; h < 2; ++h)
#pragma unroll
            for (int i = 0; i < 2; ++i) vo[h][i] = (unsigned)((h * 128 + R[i]) * (16 * PW * 2) + C[i] * 2);
    }
};
struct MoeSched {
    static constexpr bool VAR_KSTEP = false, AOFF_CHEAP = false;
    static constexpr bool PER_UNIT_AOFF = true;
    const char* A; const char* W; const int* rowidx; const volatile LAS int* TP; const volatile LAS int* CNT; int lda; int K; size_t wstride; bool gather; int G; int v;
    __device__ __forceinline__ bool next(int i, Unit& u) const {
        const int L = i * G + v; const int rt = L >> 2; if (rt >= __builtin_amdgcn_readfirstlane(TP[16])) return false;
        int e = 0;
#pragma unroll
        for (int j = 1; j < 16; ++j) e += (rt >= TP[j]) ? 1 : 0;
        u.pm = rt; u.pn = L & 3; u.e = __builtin_amdgcn_readfirstlane(e); return true; }
    __device__ __forceinline__ void ptrs(const Unit& u, const char*& cA, const char*& cB) const {
        cA = gather ? A : A + (size_t)u.pm * 256 * lda; cB = W + (size_t)u.e * wstride + (size_t)u.pn * 256 * K * 2; }
    __device__ __forceinline__ void aoff(const Unit& u, const int (&R)[2], const int (&C)[2], unsigned (&vo)[2][2]) const {
        if (gather) {
            const int r0 = (u.pm - __builtin_amdgcn_readfirstlane(TP[u.e])) * 256, cnt = __builtin_amdgcn_readfirstlane(CNT[u.e]);
#pragma unroll
            for (int h = 0; h < 2; ++h)
#pragma unroll
                for (int i = 0; i < 2; ++i) { int r = r0 + h * 128 + R[i]; r = r < cnt ? r : 0; const int tok = rowidx[u.e * CAP + r]; vo[h][i] = (unsigned)(tok * lda + C[i] * 2); }
        } else {
#pragma unroll
            for (int h = 0; h < 2; ++h)
#pragma unroll
                for (int i = 0; i < 2; ++i) vo[h][i] = (unsigned)((h * 128 + R[i]) * lda + C[i] * 2);
        }
    }
};

struct EpiStore {
    static constexpr bool CHAIN = false;
    bf16* O; int ldc; const float* rscale; size_t estride; bool remap160;
    __device__ __forceinline__ void operator()(const f32x4 (&acc)[2][2][4][2], const Unit& u, int wr, int wc, int fr, int fq) const {
        bf16* base = O + (estride ? (size_t)u.e * estride : (size_t)0);
        const int row0 = u.pm * 256 + wr * 64 + fr; int col0 = u.pn * 256 + wc * 32 + 8 * fq; int bjs = 128;
        if (remap160) { const int cm = col0 & 127; col0 = (col0 >> 7) * 160 + (cm < 64 ? cm : cm + 32); bjs = 160; }
        float scv[2][4];
#pragma unroll
        for (int ai = 0; ai < 2; ++ai)
#pragma unroll
            for (int m = 0; m < 4; ++m) scv[ai][m] = rscale ? rscale[row0 + ai * 128 + m * 16] : 1.f;
#pragma unroll
        for (int ai = 0; ai < 2; ++ai)
#pragma unroll
            for (int m = 0; m < 4; ++m) { const int row = row0 + ai * 128 + m * 16; const float sc = scv[ai][m]; bf16* rowp = base + (size_t)row * ldc + col0;
#pragma unroll
                for (int bj = 0; bj < 2; ++bj) { const f32x4 v0 = acc[ai][bj][m][0] * sc, v1 = acc[ai][bj][m][1] * sc;
                    u32x4 w; w.x = pk2(v0[0], v0[1]); w.y = pk2(v0[2], v0[3]); w.z = pk2(v1[0], v1[1]); w.w = pk2(v1[2], v1[3]);
                    *(u32x4*)(rowp + bj * bjs) = w; } }
    }
};
struct EpiRope {
    static constexpr bool CHAIN = false;
    bf16* O; const float* CS;
    __device__ __forceinline__ void operator()(const f32x4 (&acc)[2][2][4][2], const Unit& u, int wr, int wc, int fr, int fq) const {
        const int row0 = u.pm * 256 + wr * 64 + fr, col0 = u.pn * 256 + wc * 32 + 8 * fq;
        int i0v[2]; bool rp[2];
#pragma unroll
        for (int bj = 0; bj < 2; ++bj) { const int cm = (col0 + bj * 128) % 96; rp[bj] = cm >= 64; i0v[bj] = rp[bj] ? (cm - 64) >> 1 : 0; }
#pragma unroll
        for (int ai = 0; ai < 2; ++ai)
#pragma unroll
            for (int mp = 0; mp < 2; ++mp) {
                f32x4 ca[2][2], cb[2][2];
#pragma unroll
                for (int mm = 0; mm < 2; ++mm)
#pragma unroll
                    for (int bj = 0; bj < 2; ++bj) { const int pos = (row0 + ai * 128 + (2 * mp + mm) * 16) & (S - 1); const f32x4* cs = (const f32x4*)(CS + ((size_t)pos * 16 + i0v[bj]) * 2);
                        ca[mm][bj] = cs[0]; cb[mm][bj] = cs[1]; }
#pragma unroll
                for (int mm = 0; mm < 2; ++mm) { const int m = 2 * mp + mm; const int row = row0 + ai * 128 + m * 16; bf16* rowp = O + (size_t)row * 768 + col0;
#pragma unroll
                    for (int bj = 0; bj < 2; ++bj) { f32x4 v[2] = {acc[ai][bj][m][0], acc[ai][bj][m][1]};
                        if (rp[bj]) {
                            const f32x4 a = ca[mm][bj], b = cb[mm][bj];
                            f32x4 r0, r1;
                            r0[0] = v[0][0] * a[0] - v[0][1] * a[1]; r0[1] = v[0][0] * a[1] + v[0][1] * a[0];
                            r0[2] = v[0][2] * a[2] - v[0][3] * a[3]; r0[3] = v[0][2] * a[3] + v[0][3] * a[2];
                            r1[0] = v[1][0] * b[0] - v[1][1] * b[1]; r1[1] = v[1][0] * b[1] + v[1][1] * b[0];
                            r1[2] = v[1][2] * b[2] - v[1][3] * b[3]; r1[3] = v[1][2] * b[3] + v[1][3] * b[2];
                            v[0] = r0; v[1] = r1; }
                        u32x4 w; w.x = pk2(v[0][0], v[0][1]); w.y = pk2(v[0][2], v[0][3]); w.z = pk2(v[1][0], v[1][1]); w.w = pk2(v[1][2], v[1][3]);
                        *(u32x4*)(rowp + bj * 128) = w; } }
            }
    }
};
struct EpiGate {
    static constexpr bool CHAIN = false;
    bf16* GS;
    __device__ __forceinline__ void operator()(const f32x4 (&acc)[2][2][4][2], const Unit& u, int wr, int wc, int fr, int fq) const {
        bf16* base = GS + (size_t)u.e * 65536; const int row0 = wr * 64 + fr, col0 = wc * 32 + 8 * fq;
#pragma unroll
        for (int ai = 0; ai < 2; ++ai)
#pragma unroll
            for (int m = 0; m < 4; ++m) { bf16* rowp = base + (row0 + ai * 128 + m * 16) * 256 + col0;
#pragma unroll
                for (int bj = 0; bj < 2; ++bj) { const f32x4 v0 = acc[ai][bj][m][0], v1 = acc[ai][bj][m][1];
#define SG_(x) fmaxf(sigmoidf_(x), 1.0e-30f)
                    u32x4 w; w.x = pk2(SG_(v0[0]), SG_(v0[1])); w.y = pk2(SG_(v0[2]), SG_(v0[3])); w.z = pk2(SG_(v1[0]), SG_(v1[1])); w.w = pk2(SG_(v1[2]), SG_(v1[3]));
#undef SG_
                    *(u32x4*)(rowp + bj * 128) = w; } }
    }
};
struct EpiBranch {
    static constexpr bool CHAIN = false;
    bf16* Y; const bf16* GS; bool first;
    __device__ __forceinline__ void operator()(const f32x4 (&acc)[2][2][4][2], const Unit& u, int wr, int wc, int fr, int fq) const {
        const bf16* gbase = GS + (size_t)u.e * 65536; const int lrow0 = wr * 64 + fr, lcol0 = wc * 32 + 8 * fq;
#pragma unroll
        for (int ai = 0; ai < 2; ++ai)
#pragma unroll
            for (int mp = 0; mp < 2; ++mp) {
                u32x4 gwv[2][2], yov[2][2];
#pragma unroll
                for (int mm = 0; mm < 2; ++mm)
#pragma unroll
                    for (int bj = 0; bj < 2; ++bj) { const int lrow = lrow0 + ai * 128 + (2 * mp + mm) * 16;
                        gwv[mm][bj] = *(const u32x4*)(gbase + lrow * 256 + lcol0 + bj * 128);
                        if (!first) yov[mm][bj] = *(const u32x4*)(Y + (size_t)(u.pm * 256 + lrow) * DM + u.pn * 256 + lcol0 + bj * 128); }
#pragma unroll
                for (int mm = 0; mm < 2; ++mm) { const int m = 2 * mp + mm; const int lrow = lrow0 + ai * 128 + m * 16; bf16* yrow = Y + (size_t)(u.pm * 256 + lrow) * DM + u.pn * 256 + lcol0;
#pragma unroll
                    for (int bj = 0; bj < 2; ++bj) { const f32x4 v0 = acc[ai][bj][m][0], v1 = acc[ai][bj][m][1]; const u32x4 gw = gwv[mm][bj];
                        float r[8] = {v0[0] * bflo(gw.x), v0[1] * bfhi(gw.x), v0[2] * bflo(gw.y), v0[3] * bfhi(gw.y), v1[0] * bflo(gw.z), v1[1] * bfhi(gw.z), v1[2] * bflo(gw.w), v1[3] * bfhi(gw.w)};
                        if (!first) { const u32x4 yo = yov[mm][bj];
                            r[0] += bflo(yo.x); r[1] += bfhi(yo.x); r[2] += bflo(yo.y); r[3] += bfhi(yo.y); r[4] += bflo(yo.z); r[5] += bfhi(yo.z); r[6] += bflo(yo.w); r[7] += bfhi(yo.w); }
                        u32x4 w; w.x = pk2(r[0], r[1]); w.y = pk2(r[2], r[3]); w.z = pk2(r[4], r[5]); w.w = pk2(r[6], r[7]);
                        *(u32x4*)(yrow + bj * 128) = w; } }
            }
    }
};
struct EpiResid {
    static constexpr bool CHAIN = false;
    bf16* Z; const bf16* H;
    __device__ __forceinline__ void operator()(const f32x4 (&acc)[2][2][4][2], const Unit& u, int wr, int wc, int fr, int fq) const {
        const int row0 = u.pm * 256 + wr * 64 + fr, col0 = u.pn * 256 + wc * 32 + 8 * fq;
#pragma unroll
        for (int ai = 0; ai < 2; ++ai) {
            u32x4 hv[4][2];
#pragma unroll
            for (int m = 0; m < 4; ++m)
#pragma unroll
                for (int bj = 0; bj < 2; ++bj) hv[m][bj] = *(const u32x4*)(H + (size_t)(row0 + ai * 128 + m * 16) * DM + col0 + bj * 128);
#pragma unroll
            for (int m = 0; m < 4; ++m) { const size_t off = (size_t)(row0 + ai * 128 + m * 16) * DM + col0;
#pragma unroll
                for (int bj = 0; bj < 2; ++bj) { const u32x4 hw = hv[m][bj];
                    const f32x4 o0 = acc[ai][bj][m][0], o1 = acc[ai][bj][m][1];
                    u32x4 w; w.x = pk2(o0[0] + ALPHA * bflo(hw.x), o0[1] + ALPHA * bfhi(hw.x)); w.y = pk2(o0[2] + ALPHA * bflo(hw.y), o0[3] + ALPHA * bfhi(hw.y));
                    w.z = pk2(o1[0] + ALPHA * bflo(hw.z), o1[1] + ALPHA * bfhi(hw.z)); w.w = pk2(o1[2] + ALPHA * bflo(hw.w), o1[3] + ALPHA * bfhi(hw.w));
                    *(u32x4*)(Z + off + bj * 128) = w; } }
        }
    }
};
struct EpiSwiglu {
    static constexpr bool CHAIN = false;
    bf16* HS;
    __device__ __forceinline__ void operator()(const f32x4 (&acc)[2][2][4][2], const Unit& u, int wr, int wc, int fr, int fq) const {
        const int row0 = u.pm * 256 + wr * 64 + fr, col0 = u.pn * 128 + wc * 32 + 8 * fq;
#pragma unroll
        for (int ai = 0; ai < 2; ++ai)
#pragma unroll
            for (int m = 0; m < 4; ++m) { bf16* rowp = HS + (size_t)(row0 + ai * 128 + m * 16) * DFF + col0;
                float r[8];
#pragma unroll
                for (int n = 0; n < 2; ++n)
#pragma unroll
                    for (int q = 0; q < 4; ++q) { const float a = acc[ai][0][m][n][q], b = acc[ai][1][m][n][q]; r[n * 4 + q] = a * sigmoidf_(a) * b; }
                u32x4 w; w.x = pk2(r[0], r[1]); w.y = pk2(r[2], r[3]); w.z = pk2(r[4], r[5]); w.w = pk2(r[6], r[7]);
                *(u32x4*)rowp = w; }
    }
};

struct GateSched {
    static constexpr bool AOFF_CHEAP = false;
    static constexpr bool PER_UNIT_AOFF = false, VAR_KSTEP = false;
    const char* A; const char* Wg; int pm, pn; bool valid;
    __device__ __forceinline__ bool next(int i, Unit& u) const { if (!valid || i >= 3) return false; u.pm = pm; u.pn = pn; u.e = i; return true; }
    __device__ __forceinline__ void ptrs(const Unit& u, const char*& cA, const char*& cB) const { cA = A + (size_t)pm * 256 * 2048; cB = Wg + ((size_t)u.e * 1024 + (size_t)pn * 256) * 2048; }
    __device__ __forceinline__ void aoff(const Unit&, const int (&R)[2], const int (&C)[2], unsigned (&vo)[2][2]) const {
#pragma unroll
        for (int h = 0; h < 2; ++h)
#pragma unroll
            for (int i = 0; i < 2; ++i) vo[h][i] = (unsigned)((h * 128 + R[i]) * 2048 + C[i] * 2);
    }
};
struct ChainSched {
    static constexpr bool AOFF_CHEAP = true;
    static constexpr bool PER_UNIT_AOFF = true, VAR_KSTEP = true;
    const char* Pn; const char* Pd; const char* Qm; const char* Wbr; int pm, pn; bool valid;
    __device__ __forceinline__ bool next(int i, Unit& u) const { if (!valid || i >= 3) return false; u.pm = pm; u.pn = pn; u.e = i; return true; }
    __device__ __forceinline__ int lda(const Unit& u) const { return u.e == 2 ? 1536 : PW * 2; }
    __device__ __forceinline__ unsigned kstep(const Unit& u) const { return u.e == 2 ? 192u : 128u; }
    __device__ __forceinline__ void ptrs(const Unit& u, const char*& cA, const char*& cB) const {
        cA = (u.e == 0 ? Pn : (u.e == 1 ? Pd : Qm)) + (size_t)pm * 256 * lda(u); cB = Wbr + (size_t)u.e * (1024 * 512 * 2) + (size_t)pn * 256 * 1024; }
    __device__ __forceinline__ void aoff(const Unit& u, const int (&R)[2], const int (&C)[2], unsigned (&vo)[2][2]) const { const int ld = lda(u);
#pragma unroll
        for (int h = 0; h < 2; ++h)
#pragma unroll
            for (int i = 0; i < 2; ++i) vo[h][i] = (unsigned)((h * 128 + R[i]) * ld + C[i] * 2);
    }
};
struct EpiChain {
    static constexpr bool CHAIN = true;
    bf16* Y; const bf16* GS;
    __device__ __forceinline__ bool keep(const Unit& u) const { return u.e < 2; }
    __device__ __forceinline__ void operator()(f32x4 (&acc)[2][2][4][2], const Unit& u, int wr, int wc, int fr, int fq) const {
        const int j = u.e; const bf16* ga = GS + (size_t)j * 65536; const bf16* gb = GS + (size_t)(j < 2 ? j + 1 : j) * 65536; const int lrow0 = wr * 64 + fr, lcol0 = wc * 32 + 8 * fq;
#pragma unroll
        for (int ai = 0; ai < 2; ++ai)
#pragma unroll
            for (int m = 0; m < 4; ++m) {
#pragma unroll
                for (int bj = 0; bj < 2; ++bj) { const int off = (lrow0 + ai * 128 + m * 16) * 256 + lcol0 + bj * 128;
                    const u32x4 a = *(const u32x4*)(ga + off); float f[8] = {bflo(a.x), bfhi(a.x), bflo(a.y), bfhi(a.y), bflo(a.z), bfhi(a.z), bflo(a.w), bfhi(a.w)};
                    if (j < 2) { const u32x4 b = *(const u32x4*)(gb + off); const float d[8] = {bflo(b.x), bfhi(b.x), bflo(b.y), bfhi(b.y), bflo(b.z), bfhi(b.z), bflo(b.w), bfhi(b.w)};
#pragma unroll
                        for (int q = 0; q < 8; ++q) f[q] *= __builtin_amdgcn_rcpf(d[q]); }
                    f32x4& v0 = acc[ai][bj][m][0]; f32x4& v1 = acc[ai][bj][m][1];
                    v0[0] *= f[0]; v0[1] *= f[1]; v0[2] *= f[2]; v0[3] *= f[3]; v1[0] *= f[4]; v1[1] *= f[5]; v1[2] *= f[6]; v1[3] *= f[7];
                    if (j == 2) { u32x4 w; w.x = pk2(v0[0], v0[1]); w.y = pk2(v0[2], v0[3]); w.z = pk2(v1[0], v1[1]); w.w = pk2(v1[2], v1[3]);
                        *(u32x4*)(Y + (size_t)(u.pm * 256 + lrow0 + ai * 128 + m * 16) * DM + u.pn * 256 + lcol0 + bj * 128) = w; } }
                asm volatile("" ::: "memory");
            }
    }
};
}

namespace fa {
constexpr float NEG = -1.0e30f;
__device__ __forceinline__ int crow(int i, int hb) { return (i & 3) + 8 * (i >> 2) + 4 * hb; }
__device__ __forceinline__ s16x4 vtr(const LAS char* p) { return __builtin_bit_cast(s16x4, __builtin_amdgcn_ds_read_tr16_b64_v4i16((LAS v4i16_t*)p)); }

template <int DQK>
__device__ __forceinline__ void qk_tile(const LAS char* kl, const bf16x8 (&qf)[DQK / 16], f32x16& s0, f32x16& s1, int r32, int hb) {
    constexpr int KSTR = DQK * 2 + 16, KS = DQK / 16;
    const LAS char* kp = kl + r32 * KSTR + hb * 16;
    bf16x8 k0[KS], k1[KS];
#pragma unroll
    for (int s = 0; s < KS; ++s) { k0[s] = *(const LAS bf16x8*)(kp + s * 32); k1[s] = *(const LAS bf16x8*)(kp + 32 * KSTR + s * 32); }
    __builtin_amdgcn_sched_barrier(0);
    const f32x16 z = {0.f, 0.f, 0.f, 0.f, 0.f, 0.f, 0.f, 0.f, 0.f, 0.f, 0.f, 0.f, 0.f, 0.f, 0.f, 0.f};
    s0 = __builtin_amdgcn_mfma_f32_32x32x16_bf16(k0[0], qf[0], z, 0, 0, 0);
    s1 = __builtin_amdgcn_mfma_f32_32x32x16_bf16(k1[0], qf[0], z, 0, 0, 0);
#pragma unroll
    for (int s = 1; s < KS; ++s) {
        s0 = __builtin_amdgcn_mfma_f32_32x32x16_bf16(k0[s], qf[s], s0, 0, 0, 0);
        s1 = __builtin_amdgcn_mfma_f32_32x32x16_bf16(k1[s], qf[s], s1, 0, 0, 0);
    }
}
template <bool CHECK>
__device__ __forceinline__ void score_tile(f32x16& s0, f32x16& s1, float d0, float kstep, float c1, float slope2, float wlim, bool lanevalid, int hb) {
#pragma unroll
    for (int i = 0; i < 16; ++i) {
        const float k0 = (float)crow(i, hb) * kstep;
        const float da = d0 - k0, db = d0 - k0 - 32.f * kstep;
        float va = __builtin_fmaf(s0[i], c1, -slope2 * da), vb = __builtin_fmaf(s1[i], c1, -slope2 * db);
        if (CHECK) { va = (da >= 0.f && da < wlim && lanevalid) ? va : NEG; vb = (db >= 0.f && db < wlim && lanevalid) ? vb : NEG; }
        s0[i] = va; s1[i] = vb;
    }
}
__device__ __forceinline__ float tile_max(const f32x16& s0, const f32x16& s1) {
    float a = fmaxf(fmaxf(s0[0], s0[1]), s1[0]), b = fmaxf(fmaxf(s0[2], s0[3]), s1[1]);
    a = fmaxf(fmaxf(a, s1[2]), s1[3]);
#pragma unroll
    for (int i = 4; i < 16; i += 4) { a = fmaxf(fmaxf(a, s0[i]), s0[i + 1]); b = fmaxf(fmaxf(b, s0[i + 2]), s0[i + 3]); a = fmaxf(fmaxf(a, s1[i]), s1[i + 1]); b = fmaxf(fmaxf(b, s1[i + 2]), s1[i + 3]); }
    return hmax(fmaxf(a, b));
}
__device__ __forceinline__ void pack_p(const f32x16& s0, const f32x16& s1, bf16x8 (&pa)[4]) {
#pragma unroll
    for (int sp = 0; sp < 2; ++sp) {
        u32x4 w0, w1;
        w0.x = pk2(s0[8 * sp + 0], s0[8 * sp + 1]); w0.y = pk2(s0[8 * sp + 2], s0[8 * sp + 3]); w0.z = pk2(s0[8 * sp + 4], s0[8 * sp + 5]); w0.w = pk2(s0[8 * sp + 6], s0[8 * sp + 7]);
        w1.x = pk2(s1[8 * sp + 0], s1[8 * sp + 1]); w1.y = pk2(s1[8 * sp + 2], s1[8 * sp + 3]); w1.z = pk2(s1[8 * sp + 4], s1[8 * sp + 5]); w1.w = pk2(s1[8 * sp + 6], s1[8 * sp + 7]);
        pa[sp] = __builtin_bit_cast(bf16x8, w0); pa[2 + sp] = __builtin_bit_cast(bf16x8, w1);
    }
}
__device__ __forceinline__ float softmax_step(f32x16& s0, f32x16& s1, float& m, float& l) {
    const float mx = tile_max(s0, s1);
    const float mn = fmaxf(m, mx);
    const float alpha = fexp2(m - mn);
    m = mn;
    float ra = 0.f, rb = 0.f;
#pragma unroll
    for (int i = 0; i < 16; ++i) { s0[i] = fexp2(s0[i] - mn); s1[i] = fexp2(s1[i] - mn); ra += s0[i]; rb += s1[i]; }
    l = l * alpha + hsum(ra + rb);
    return alpha;
}
template <int DV>
__device__ __forceinline__ int v_swz(int key) { return DV == 64 ? (((key >> 1) & 1) << 6) : ((key & 3) << 6); }
template <int DV>
__device__ __forceinline__ void v_load(const LAS char* vl, int lane, int dvb0, bf16x8 (&vf)[2][4]) {
    constexpr int VSTR = DV * 2;
    const int g16 = lane >> 4, i16 = lane & 15, q = i16 >> 2, p = i16 & 3, hb = lane >> 5;
    const int f = (DV == 64) ? ((q >> 1) & 1) : q;
    const int rowb = (4 * hb + q) * VSTR + 2 * (16 * (g16 & 1) + 4 * p);
#pragma unroll
    for (int d = 0; d < 2; ++d) {
        unsigned vba = (unsigned)(uintptr_t)vl + (unsigned)(rowb + (((dvb0 + d) ^ f) << 6));
        asm volatile("" : "+v"(vba));
        const LAS char* vb = (const LAS char*)vba;
#pragma unroll
        for (int ks = 0; ks < 4; ++ks) {
            const s16x4 lo = vtr(vb + (16 * ks) * VSTR), hi = vtr(vb + (16 * ks + 8) * VSTR);
            vf[d][ks] = (bf16x8){lo[0], lo[1], lo[2], lo[3], hi[0], hi[1], hi[2], hi[3]};
        }
    }
}
__device__ __forceinline__ void pv_mma(const bf16x8 (&vf)[2][4], const bf16x8 (&pa)[4], f32x16& oa, f32x16& ob) {
#pragma unroll
    for (int ks = 0; ks < 4; ++ks) {
        oa = __builtin_amdgcn_mfma_f32_32x32x16_bf16(vf[0][ks], pa[ks], oa, 0, 0, 0);
        ob = __builtin_amdgcn_mfma_f32_32x32x16_bf16(vf[1][ks], pa[ks], ob, 0, 0, 0);
    }
}
template <int DV>
__device__ __forceinline__ void pv_tile(const LAS char* vl, const bf16x8 (&pa)[4], f32x16 (&o)[DV / 32], int lane) {
#pragma unroll
    for (int d0 = 0; d0 < DV / 32; d0 += 2) { bf16x8 vf[2][4]; v_load<DV>(vl, lane, d0, vf); __builtin_amdgcn_sched_barrier(0); pv_mma(vf, pa, o[d0], o[d0 + 1]); }
}
}

constexpr int A_KB = 13312, A_VB0 = 26624, A_VB = 16384;
constexpr int A_SC = 61440, A_SM = 129920, A_UN = 130944;
__device__ __forceinline__ float alibi_slope(int idx) { return fexp2(-8.0f * (float)(idx + 1) / 12.0f); }
__device__ __forceinline__ unsigned getw(const u32x4& w, int i) { return i == 0 ? w.x : (i == 1 ? w.y : (i == 2 ? w.z : w.w)); }
__device__ __forceinline__ int next_bit(const u32x4& w, int from) {
    int res = 128;
#pragma unroll
    for (int wi = 3; wi >= 0; --wi) { unsigned x = getw(w, wi); const int lo = wi * 32;
        if (from > lo + 31) x = 0u; else if (from > lo) x &= (~0u) << (from - lo);
        if (x) res = lo + __builtin_ctz(x); }
    return res;
}

struct Ld64 {
    const char* kp; const char* vp; int kstr, vstr; u32x4 rk, rv;
    __device__ __forceinline__ void issue(int key0, int tid, bool withV) { const int row = tid >> 3, ch = tid & 7;
        rk = *(const u32x4*)(kp + (size_t)(key0 + row) * kstr + ch * 16); if (withV) rv = *(const u32x4*)(vp + (size_t)(key0 + row) * vstr + ch * 16); }
    __device__ __forceinline__ void commit(LAS char* kl, LAS char* vl, int tid, bool withV) { const int row = tid >> 3, ch = tid & 7;
        *(LAS u32x4*)(kl + row * 144 + ch * 16) = rk; if (withV) *(LAS u32x4*)(vl + row * 128 + ((ch * 16) ^ fa::v_swz<64>(row))) = rv; }
};
struct LdDiff {
    const char* kp; const char* vp; u32x4 rk, rv0, rv1;
    __device__ __forceinline__ void issue(int key0, int tid) {
        rk = *(const u32x4*)(kp + (size_t)(key0 + (tid >> 3)) * (PW * 2) + (tid & 7) * 16);
        const char* v = vp + (size_t)(key0 + (tid >> 4)) * (PW * 2) + (tid & 15) * 16; rv0 = *(const u32x4*)v; rv1 = *(const u32x4*)(v + (size_t)32 * PW * 2); }
    __device__ __forceinline__ void commit(LAS char* kl, LAS char* vl, int tid) {
        *(LAS u32x4*)(kl + (tid >> 3) * 144 + (tid & 7) * 16) = rk;
        const int row = tid >> 4, off = ((tid & 15) * 16) ^ fa::v_swz<128>(row);
        *(LAS u32x4*)(vl + row * 256 + off) = rv0; *(LAS u32x4*)(vl + (row + 32) * 256 + off) = rv1; }
};
struct LdMla {
    const char* knp; const char* krp; const char* vp; u32x4 rk0, rk1, rv;
    __device__ __forceinline__ const char* ksrc(int key0, int c) const { const int row = c / 12, ch = c - row * 12;
        return ch < 8 ? knp + (size_t)(key0 + row) * 2048 + ch * 16 : krp + (size_t)(key0 + row) * (PW * 2) + (ch - 8) * 16; }
    __device__ __forceinline__ void issue(int key0, int tid) {
        rk0 = *(const u32x4*)ksrc(key0, tid); if (tid < 256) rk1 = *(const u32x4*)ksrc(key0, tid + 512);
        rv = *(const u32x4*)(vp + (size_t)(key0 + (tid >> 3)) * 2048 + (tid & 7) * 16); }
    __device__ __forceinline__ void commit(LAS char* kl, LAS char* vl, int tid) {
        { const int row = tid / 12, ch = tid - row * 12; *(LAS u32x4*)(kl + row * 208 + ch * 16) = rk0; }
        if (tid < 256) { const int c = tid + 512, row = c / 12, ch = c - row * 12; *(LAS u32x4*)(kl + row * 208 + ch * 16) = rk1; }
        const int row = tid >> 3; *(LAS u32x4*)(vl + row * 128 + (((tid & 7) * 16) ^ fa::v_swz<64>(row))) = rv; }
};

template <int DQK, int DV, class Ld>
__device__ __forceinline__ void flash_causal(LAS char* lds, Ld& ld, const bf16x8 (&qf)[DQK / 16], f32x16 (&o)[DV / 32], float& m, float& l,
                                             int q0, int wq0, int t, float c1, float slope2, int tid, int lane, int r32, int hb) {
    const int nt = (q0 + 256) >> 6;
    ld.issue(0, tid); ld.commit(lds, lds + A_VB0, tid); __syncthreads();
    for (int kt = 0; kt < nt; ++kt) {
        const int buf = kt & 1, key0 = 64 * kt;
        if (kt + 1 < nt) ld.issue(key0 + 64, tid);
        if (key0 <= wq0 + 31) {
            f32x16 s0, s1; fa::qk_tile<DQK>(lds + buf * A_KB, qf, s0, s1, r32, hb);
            if (key0 + 63 > wq0) fa::score_tile<true>(s0, s1, (float)(t - key0), 1.f, c1, slope2, 1.0e9f, true, hb);
            else fa::score_tile<false>(s0, s1, (float)(t - key0), 1.f, c1, slope2, 1.0e9f, true, hb);
            const float alpha = fa::softmax_step(s0, s1, m, l);
#pragma unroll
            for (int d = 0; d < DV / 32; ++d) o[d] = o[d] * alpha;
            bf16x8 pa[4]; fa::pack_p(s0, s1, pa);
            fa::pv_tile<DV>(lds + A_VB0 + buf * A_VB, pa, o, lane);
        }
        if (kt + 1 < nt) ld.commit(lds + (buf ^ 1) * A_KB, lds + A_VB0 + (buf ^ 1) * A_VB, tid);
        __syncthreads();
    }
}


#ifndef DIFF_PIPE
#define DIFF_PIPE false
#endif
#ifndef MLA_PIPE
#define MLA_PIPE false
#endif
#ifndef PROBE_VAR
#define PROBE_VAR 0
#endif
namespace fr {
template <int DQK, int DV> struct Geo {
    static constexpr int KS = DQK / 16, NDV = DV / 32;
    static constexpr int KROWB = (DQK == 64) ? 128 : 256;
    static constexpr int KSLOT = 64 * KROWB, VSLOT = 64 * DV * 2;
    static constexpr int KBASE = 0, VBASE = 3 * KSLOT;
    static constexpr int PK = KSLOT / 8192, PV = VSLOT / 8192;
};
template <int DQK> __device__ __forceinline__ void k_offsets(unsigned* vo, int wid, int lane, int strideB) {
    if constexpr (DQK == 64) { const int row = 8 * wid + (lane >> 3), cp = lane & 7, c = cp ^ ((row >> 1) & 7); vo[0] = (unsigned)(row * strideB + c * 16); }
    else {
#pragma unroll
        for (int j = 0; j < 2; ++j) { const int p = wid + 8 * j, row = 4 * p + (lane >> 4), cp = lane & 15; int c = cp ^ (row & 15); if (c >= 12) c = 0; vo[j] = (unsigned)(row * strideB + c * 16); }
    }
}
template <int DV> __device__ __forceinline__ void v_offsets(unsigned* vo, int wid, int lane, int strideB) {
    if constexpr (DV == 64) { const int row = 8 * wid + (lane >> 3), pp = lane & 7, lg = ((((pp >> 2) ^ ((row >> 1) & 1))) << 2) | (pp & 3); vo[0] = (unsigned)(row * strideB + lg * 16); }
    else {
#pragma unroll
        for (int j = 0; j < 2; ++j) { const int p = wid + 8 * j, row = 4 * p + (lane >> 4), pp = lane & 15, lg = (((pp >> 2) ^ (row & 3)) << 2) | (pp & 3); vo[j] = (unsigned)(row * strideB + lg * 16); }
    }
}
template <int DQK, bool BATCH = true>
__device__ __forceinline__ void qk_ring(const LAS char* kl, const int (&ka)[DQK / 16], const bf16x8 (&qf)[DQK / 16], f32x16& s0, f32x16& s1) {
    constexpr int KROWB = (DQK == 64) ? 128 : 256, KS = DQK / 16;
    bf16x8 k0[KS], k1[KS];
#pragma unroll
    for (int s = 0; s < KS; ++s) { unsigned a = (unsigned)(uintptr_t)kl + (unsigned)ka[s]; asm volatile("" : "+v"(a)); const LAS char* kp = (const LAS char*)a;
        k0[s] = *(const LAS bf16x8*)kp; k1[s] = *(const LAS bf16x8*)(kp + 32 * KROWB); }
    if constexpr (BATCH) __builtin_amdgcn_sched_barrier(0);
    const f32x16 z = {0.f, 0.f, 0.f, 0.f, 0.f, 0.f, 0.f, 0.f, 0.f, 0.f, 0.f, 0.f, 0.f, 0.f, 0.f, 0.f};
    s0 = __builtin_amdgcn_mfma_f32_32x32x16_bf16(k0[0], qf[0], z, 0, 0, 0);
    s1 = __builtin_amdgcn_mfma_f32_32x32x16_bf16(k1[0], qf[0], z, 0, 0, 0);
#pragma unroll
    for (int s = 1; s < KS; ++s) {
        s0 = __builtin_amdgcn_mfma_f32_32x32x16_bf16(k0[s], qf[s], s0, 0, 0, 0);
        s1 = __builtin_amdgcn_mfma_f32_32x32x16_bf16(k1[s], qf[s], s1, 0, 0, 0);
    }
}
template <bool ALIBI, bool CHECK, int NDV>
__device__ __forceinline__ void soft_tile(f32x16& s0, f32x16& s1, float c1, float slope2, float d0, int hb, float& m, float& l, f32x16 (&o)[NDV], bf16x8 (&pa)[4]) {
    const float dh = d0 - (float)(4 * hb);
    if constexpr (ALIBI) {
        const float e0 = -slope2 * dh, e1 = e0 + 32.f * slope2;
#pragma unroll
        for (int i = 0; i < 16; ++i) { const float ci = (float)((i & 3) + 8 * (i >> 2)); s0[i] = __builtin_fmaf(s0[i], c1, __builtin_fmaf(slope2, ci, e0)); s1[i] = __builtin_fmaf(s1[i], c1, __builtin_fmaf(slope2, ci, e1)); }
    }
    if constexpr (CHECK) {
#pragma unroll
        for (int i = 0; i < 16; ++i) { const float ci = (float)((i & 3) + 8 * (i >> 2)); if (ci > dh) s0[i] = fa::NEG; if (ci + 32.f > dh) s1[i] = fa::NEG; }
    }
    const float mx = fa::tile_max(s0, s1);
    const float mn = fmaxf(m, mx);
    if (NDV > 2 || __builtin_amdgcn_ballot_w64(mn > m) != 0ull) {
        const float alpha = fexp2(m - mn); l *= alpha;
#pragma unroll
        for (int d = 0; d < NDV; ++d) o[d] = o[d] * alpha;
    }
    m = mn;
    float ra = 0.f, rb = 0.f;
#pragma unroll
    for (int i = 0; i < 16; ++i) {
        s0[i] = fexp2(s0[i] - mn); s1[i] = fexp2(s1[i] - mn);
        ra += s0[i]; rb += s1[i]; }
    l += hsum(ra + rb);
    fa::pack_p(s0, s1, pa);
}
#define FR_WAITBAR(N) asm volatile("s_waitcnt vmcnt(" #N ") lgkmcnt(0)\n\ts_barrier" ::: "memory")
template <int DQK, int DV, bool ALIBI, bool PIPE, int VAR = 0>
__device__ __forceinline__ void flash_ring(LAS char* lds, const char* kbase, const char* vbase, const int strideB, const bf16x8 (&qf)[DQK / 16], f32x16 (&o)[DV / 32], float& m, float& l,
                                           const int q0, const int wq0, const int t, const float c1, const float slope2, const int wid, const int lane) {
    typedef Geo<DQK, DV> GG;
    constexpr int PK = GG::PK, PV = GG::PV, NDV = DV / 32;
    const int r32 = lane & 31, hb = lane >> 5;
    const int nt = (q0 + 256) >> 6, tmax = (wq0 + 31) >> 6;
    const int iskip = nt - 1 - tmax;
    unsigned voK[PK], voV[PV];
    k_offsets<DQK>(voK, wid, lane, strideB); v_offsets<DV>(voV, wid, lane, strideB);
    int ka[DQK / 16];
    { const int f = (DQK == 64) ? ((r32 >> 1) & 7) : (r32 & 15);
#pragma unroll
      for (int s = 0; s < DQK / 16; ++s) ka[s] = r32 * GG::KROWB + (((2 * s + hb) ^ f) << 4); }
    const unsigned ldsb = (unsigned)(uintptr_t)lds + (unsigned)wid * 1024u;
#define FR_ISSUE_K(it) do { const int it_ = (it); const char* b_ = kbase + (size_t)(nt - 1 - it_) * 64 * strideB; const unsigned d_ = ldsb + GG::KBASE + (unsigned)(it_ % 3) * GG::KSLOT; \
        _Pragma("unroll") for (int j_ = 0; j_ < PK; ++j_) pg8::glds16_s(b_, voK[j_], d_ + j_ * 8192); } while (0)
#define FR_ISSUE_V(it) do { const int it_ = (it); const char* b_ = vbase + (size_t)(nt - 1 - it_) * 64 * strideB; const unsigned d_ = ldsb + GG::VBASE + (unsigned)(it_ % 3) * GG::VSLOT; \
        _Pragma("unroll") for (int j_ = 0; j_ < PV; ++j_) pg8::glds16_s(b_, voV[j_], d_ + j_ * 8192); } while (0)
    constexpr int KA = PIPE ? 1 : 0;
#define FR_ISSUE(i_) do { if ((i_) + 2 + KA < nt) FR_ISSUE_K((i_) + 2 + KA); if ((i_) + 2 < nt) FR_ISSUE_V((i_) + 2); } while (0)
#define FR_END(i_) do { if ((i_) + 2 + KA < nt) { if constexpr (PK + PV == 2) FR_WAITBAR(2); else FR_WAITBAR(3); } \
        else if ((i_) + 2 < nt) { if constexpr (PV == 1) FR_WAITBAR(1); else FR_WAITBAR(2); } else FR_WAITBAR(0); } while (0)
#define FR_KSLOT(i_) (lds + GG::KBASE + ((i_) % 3) * GG::KSLOT)
#define FR_VSLOT(i_) (lds + GG::VBASE + ((i_) % 3) * GG::VSLOT)
    FR_ISSUE_K(0); if constexpr (PIPE) FR_ISSUE_K(1); FR_ISSUE_V(0);
    FR_ISSUE_K(1 + KA); FR_ISSUE_V(1);
    if constexpr (PK + PV == 2) FR_WAITBAR(2); else FR_WAITBAR(3);
    int i = 0;
    for (; i < iskip; ++i) { FR_ISSUE(i); FR_END(i); }
    f32x16 sc0, sc1;
    {
        FR_ISSUE(i);
        bf16x8 pa[4], vf[2][4];
        qk_ring<DQK>(FR_KSLOT(i), ka, qf, sc0, sc1);
        soft_tile<ALIBI, true, NDV>(sc0, sc1, c1, slope2, (float)(t - 64 * (nt - 1 - i)), hb, m, l, o, pa);
#pragma unroll
        for (int d0 = 0; d0 < NDV; d0 += 2) { fa::v_load<DV>(FR_VSLOT(i), lane, d0, vf); __builtin_amdgcn_sched_barrier(0); fa::pv_mma(vf, pa, o[d0], o[d0 + 1]); }
        if (PIPE && i + 1 < nt) qk_ring<DQK>(FR_KSLOT(i + 1), ka, qf, sc0, sc1);
        FR_END(i); ++i;
    }
#define FR_PV(i_) do { _Pragma("unroll") for (int d0 = 0; d0 < NDV; d0 += 2) { fa::v_load<DV>(FR_VSLOT(i_), lane, d0, vf); __builtin_amdgcn_sched_barrier(0); fa::pv_mma(vf, pa, o[d0], o[d0 + 1]); } } while (0)
    if constexpr (PIPE) {
        f32x16 sb0, sb1;
        bool curA = true;
#define FR_BODY(C0, C1, N0, N1) do { FR_ISSUE(i); bf16x8 pa[4], vf[2][4]; const float d0f = (float)(t - 64 * (nt - 1 - i)); \
            qk_ring<DQK, false>(FR_KSLOT(i + 1), ka, qf, N0, N1); \
            if constexpr (VAR != 1) soft_tile<ALIBI, false, NDV>(C0, C1, c1, slope2, d0f, hb, m, l, o, pa); else fa::pack_p(C0, C1, pa); \
            FR_PV(i); FR_END(i); ++i; } while (0)
        while (i + 1 < nt) {
            FR_BODY(sc0, sc1, sb0, sb1);
            if (i + 1 >= nt) { curA = false; break; }
            FR_BODY(sb0, sb1, sc0, sc1);
        }
#undef FR_BODY
        if (i < nt) {
            FR_ISSUE(i); bf16x8 pa[4], vf[2][4]; const float d0f = (float)(t - 64 * (nt - 1 - i));
            if (curA) soft_tile<ALIBI, false, NDV>(sc0, sc1, c1, slope2, d0f, hb, m, l, o, pa); else soft_tile<ALIBI, false, NDV>(sb0, sb1, c1, slope2, d0f, hb, m, l, o, pa);
            FR_PV(i); FR_END(i); ++i;
        }
    } else {
        for (; i < nt; ++i) {
            FR_ISSUE(i);
            bf16x8 pa[4], vf[2][4];
            const float d0f = (float)(t - 64 * (nt - 1 - i));
            qk_ring<DQK>(FR_KSLOT(i), ka, qf, sc0, sc1);
            if constexpr (DV == 64) { fa::v_load<DV>(FR_VSLOT(i), lane, 0, vf); __builtin_amdgcn_sched_barrier(0); }
            if constexpr (VAR != 1) soft_tile<ALIBI, false, NDV>(sc0, sc1, c1, slope2, d0f, hb, m, l, o, pa); else fa::pack_p(sc0, sc1, pa);
#pragma unroll
            for (int d0 = 0; d0 < NDV; d0 += 2) { if (DV != 64 || d0 != 0) { fa::v_load<DV>(FR_VSLOT(i), lane, d0, vf); __builtin_amdgcn_sched_barrier(0); } fa::pv_mma(vf, pa, o[d0], o[d0 + 1]); }
            FR_END(i);
        }
    }
#undef FR_PV
#undef FR_ISSUE_K
#undef FR_ISSUE_V
#undef FR_ISSUE
#undef FR_END
#undef FR_KSLOT
#undef FR_VSLOT
}
}

__device__ __forceinline__ void diff_unit(LAS char* lds, int b, int h, int qt, bf16* P, float lam, float lam_init, const float* subg, bf16* scratch, int wid, bool dry = false) {
    const int lane = lane_id_v(), r32 = lane & 31, hb = lane >> 5;
    const int q0 = 256 * qt, wq0 = q0 + 32 * wid, t = wq0 + r32;
    bf16* prow = P + ((size_t)b * S + t) * PW;
    const char* pb = (const char*)(P + (size_t)b * S * PW);
    const float slope2 = alibi_slope(8 + h) * LOG2E, c1 = 0.125f * LOG2E;
    u32x4* o1g = (u32x4*)scratch + wid * 64 + lane;
    f32x16 o[4]; float m = 0.f, l = 0.f;
    for (int map = 0; map < 2; ++map) {
        bf16x8 qf[4];
#pragma unroll
        for (int s = 0; s < 4; ++s) qf[s] = *(const bf16x8*)(prow + PC_DQ + h * 128 + map * 64 + 16 * s + 8 * hb);
#pragma unroll
        for (int d = 0; d < 4; ++d)
#pragma unroll
            for (int i = 0; i < 16; ++i) o[d][i] = 0.f;
        m = fa::NEG; l = 0.f;
        fr::flash_ring<64, 128, true, DIFF_PIPE>(lds, pb + (PC_DK + h * 128 + map * 64) * 2, pb + (PC_DV + h * 128) * 2, PW * 2, qf, o, m, l, q0, wq0, t, c1, slope2, wid, lane);
        if (map == 0) { const float inv = 1.f / l;
#pragma unroll
            for (int d = 0; d < 4; ++d)
#pragma unroll
                for (int k = 0; k < 2; ++k) { u32x4 w; w.x = pk2(o[d][8 * k] * inv, o[d][8 * k + 1] * inv); w.y = pk2(o[d][8 * k + 2] * inv, o[d][8 * k + 3] * inv);
                    w.z = pk2(o[d][8 * k + 4] * inv, o[d][8 * k + 5] * inv); w.w = pk2(o[d][8 * k + 6] * inv, o[d][8 * k + 7] * inv); o1g[512 * (2 * d + k)] = w; } }
    }
    const float inv2 = lam / l; float ss = 0.f;
#pragma unroll
    for (int d = 0; d < 4; ++d)
#pragma unroll
        for (int k = 0; k < 2; ++k) { u32x4 w;
            { const unsigned long long* p64 = (const unsigned long long*)(o1g + 512 * (2 * d + k));
              const unsigned long long x0 = __hip_atomic_load(p64, __ATOMIC_RELAXED, __HIP_MEMORY_SCOPE_AGENT), x1 = __hip_atomic_load(p64 + 1, __ATOMIC_RELAXED, __HIP_MEMORY_SCOPE_AGENT);
              w.x = (unsigned)x0; w.y = (unsigned)(x0 >> 32); w.z = (unsigned)x1; w.w = (unsigned)(x1 >> 32); }
            const float a0 = bflo(w.x) - o[d][8 * k] * inv2, a1 = bfhi(w.x) - o[d][8 * k + 1] * inv2, a2 = bflo(w.y) - o[d][8 * k + 2] * inv2, a3 = bfhi(w.y) - o[d][8 * k + 3] * inv2;
            const float a4 = bflo(w.z) - o[d][8 * k + 4] * inv2, a5 = bfhi(w.z) - o[d][8 * k + 5] * inv2, a6 = bflo(w.w) - o[d][8 * k + 6] * inv2, a7 = bfhi(w.w) - o[d][8 * k + 7] * inv2;
            o[d][8 * k] = a0; o[d][8 * k + 1] = a1; o[d][8 * k + 2] = a2; o[d][8 * k + 3] = a3; o[d][8 * k + 4] = a4; o[d][8 * k + 5] = a5; o[d][8 * k + 6] = a6; o[d][8 * k + 7] = a7;
            ss += (a0 * a0 + a1 * a1) + (a2 * a2 + a3 * a3) + (a4 * a4 + a5 * a5) + (a6 * a6 + a7 * a7); }
    ss = hsum(ss);
    const float rs = __builtin_amdgcn_rsqf(ss * (1.f / 128.f) + 1e-6f) * (1.f - lam_init);
#pragma unroll
    for (int d = 0; d < 4; ++d)
#pragma unroll
        for (int k = 0; k < 4; ++k) { const int dv = 32 * d + 8 * k + 4 * hb; const f32x4 g = *(const f32x4*)(subg + dv);
            u32x2 w; w.x = pk2(o[d][4 * k] * rs * g[0], o[d][4 * k + 1] * rs * g[1]); w.y = pk2(o[d][4 * k + 2] * rs * g[2], o[d][4 * k + 3] * rs * g[3]);
            if (!dry) *(u32x2*)(prow + PC_DQ + h * 128 + dv) = w; }
}

constexpr int KVW = 1280;
__device__ __forceinline__ void mla_unit(LAS char* lds, int b, int h, int qt, bf16* QM, const bf16* KVM, const float* rsq, int wid, bool dry = false) {
    const int lane = lane_id_v(), r32 = lane & 31, hb = lane >> 5;
    const int q0 = 256 * qt, wq0 = q0 + 32 * wid, t = wq0 + r32; const size_t mrow = (size_t)b * S + t;
    bf16* qrow = QM + mrow * 768 + h * 96;
    bf16x8 qf[6];
#pragma unroll
    for (int s = 0; s < 6; ++s) qf[s] = *(const bf16x8*)(qrow + 16 * s + 8 * hb);
    const float c1 = 0.10206207261596575f * LOG2E * rsq[mrow];
#pragma unroll
    for (int s = 0; s < 6; ++s) { const u32x4 w = __builtin_bit_cast(u32x4, qf[s]); u32x4 r;
        r.x = pk2(bflo(w.x) * c1, bfhi(w.x) * c1); r.y = pk2(bflo(w.y) * c1, bfhi(w.y) * c1); r.z = pk2(bflo(w.z) * c1, bfhi(w.z) * c1); r.w = pk2(bflo(w.w) * c1, bfhi(w.w) * c1);
        qf[s] = __builtin_bit_cast(bf16x8, r); }
    const char* kb = (const char*)(KVM + (size_t)b * S * KVW + h * 160);
    f32x16 o[2];
#pragma unroll
    for (int d = 0; d < 2; ++d)
#pragma unroll
        for (int i = 0; i < 16; ++i) o[d][i] = 0.f;
    float m = fa::NEG, l = 0.f;
    if (PROBE_VAR != 0 && dry) fr::flash_ring<96, 64, false, MLA_PIPE, PROBE_VAR>(lds, kb, kb + 192, KVW * 2, qf, o, m, l, q0, wq0, t, c1, 0.f, wid, lane); else
    fr::flash_ring<96, 64, false, MLA_PIPE>(lds, kb, kb + 192, KVW * 2, qf, o, m, l, q0, wq0, t, c1, 0.f, wid, lane);
    const float inv = 1.f / l;
#pragma unroll
    for (int d = 0; d < 2; ++d)
#pragma unroll
        for (int k = 0; k < 4; ++k) { u32x2 w; w.x = pk2(o[d][4 * k] * inv, o[d][4 * k + 1] * inv); w.y = pk2(o[d][4 * k + 2] * inv, o[d][4 * k + 3] * inv);
            if (!dry) *(u32x2*)(qrow + 32 * d + 8 * k + 4 * hb) = w; }
}

#define LAUNDER(x) asm volatile("" : "+v"(x))
#define NSA_IDS const int lane = lane_id_v(), tid = wid * 64 + lane, r32 = lane & 31, hb = lane >> 5, h4 = r32 >> 3, qi = r32 & 7; (void)h4; (void)qi; (void)hb; (void)r32;
__device__ __forceinline__ void nsa_unit(LAS char* lds, int b, int g, int j, bf16* P, const bf16* KCMP, const bf16* VCMP, int wid, bool dry = false) {
    const int lane = lane_id_v(), r32 = lane & 31, hb = lane >> 5, h4 = r32 >> 3, qi = r32 & 7;
    const int head = 4 * g + h4, t0 = 64 * j, t = t0 + 8 * wid + qi;
    bf16* prow = P + ((size_t)b * S + t) * PW;
    const char* pb = (const char*)(P + (size_t)b * S * PW);
    bf16x8 qf[4];
#pragma unroll
    for (int s = 0; s < 4; ++s) qf[s] = *(const bf16x8*)(prow + PC_NQ + head * 64 + 16 * s + 8 * hb);
    const float slope2 = alibi_slope(head) * LOG2E, c1 = 0.125f * LOG2E;
    const float gc = sigmoidf_(bf2f(prow[PC_NG + head * 3 + 0])), gs = sigmoidf_(bf2f(prow[PC_NG + head * 3 + 1])), gw = sigmoidf_(bf2f(prow[PC_NG + head * 3 + 2]));
    LAS float* sc = (LAS float*)(lds + A_SC + wid * 4096);
    { float z = 0.f; LAUNDER(z);
#pragma unroll
    for (int k = 0; k < 4; ++k) *(LAS f32x4*)(sc + lane * 16 + 4 * k) = (f32x4){z, z, z, z}; }
    f32x16 ob[2];
#pragma unroll
    for (int d = 0; d < 2; ++d)
#pragma unroll
        for (int i = 0; i < 16; ++i) ob[d][i] = 0.f;
    {
        NSA_IDS
        const int ntc = (4 * j + 3 + 63) >> 6;
        Ld64 ld; ld.kp = (const char*)(KCMP + (size_t)(b * 2 + g) * 512 * 64); ld.vp = (const char*)(VCMP + (size_t)(b * 2 + g) * 512 * 64); ld.kstr = 128; ld.vstr = 128;
        float mc = fa::NEG, lc = 0.f;
        ld.issue(0, tid, false); ld.commit(lds, lds + A_VB0, tid, false); __syncthreads();
        for (int kt = 0; kt < ntc; ++kt) {
            const int buf = kt & 1;
            if (kt + 1 < ntc) ld.issue(64 * (kt + 1), tid, false);
            f32x16 s0, s1; fa::qk_tile<64>(lds + buf * A_KB, qf, s0, s1, r32, hb);
            fa::score_tile<true>(s0, s1, (float)(t - 31 - 1024 * kt), 16.f, c1, slope2, 1.0e9f, true, hb);
            (void)fa::softmax_step(s0, s1, mc, lc);
            if (kt + 1 < ntc) ld.commit(lds + (buf ^ 1) * A_KB, lds + A_VB0, tid, false);
            __syncthreads();
        }
        const float inv = (mc > -1.0e29f) ? 1.f / lc : 0.f;
        float carry = 0.f;
        ld.issue(0, tid, true); ld.commit(lds, lds + A_VB0, tid, true); __syncthreads();
        for (int kt = 0; kt < ntc; ++kt) {
            const int buf = kt & 1;
            if (kt + 1 < ntc) ld.issue(64 * (kt + 1), tid, true);
            f32x16 s0, s1; fa::qk_tile<64>(lds + buf * A_KB, qf, s0, s1, r32, hb);
            fa::score_tile<true>(s0, s1, (float)(t - 31 - 1024 * kt), 16.f, c1, slope2, 1.0e9f, true, hb);
#pragma unroll
            for (int i = 0; i < 16; ++i) { s0[i] = fexp2(s0[i] - mc) * inv; s1[i] = fexp2(s1[i] - mc) * inv; }
            { float mainv[8], ps[8];
#pragma unroll
              for (int gq = 0; gq < 8; ++gq) { const int kb = gq >> 2, k = gq & 3;
                  const float p0 = kb ? s1[4 * k] : s0[4 * k], p1 = kb ? s1[4 * k + 1] : s0[4 * k + 1], p2 = kb ? s1[4 * k + 2] : s0[4 * k + 2], p3 = kb ? s1[4 * k + 3] : s0[4 * k + 3];
                  float mv = 2.f * (p0 + p1 + p2) + p3, sv = p3;
                  mv += __shfl_xor(mv, 8); mv += __shfl_xor(mv, 16); sv += __shfl_xor(sv, 8); sv += __shfl_xor(sv, 16);
                  mainv[gq] = mv;
                  auto rr = __builtin_amdgcn_permlane32_swap(__float_as_uint(sv), __float_as_uint(sv), false, false);
                  ps[gq] = __uint_as_float(hb ? rr[0] : rr[1]); }
#pragma unroll
              for (int gq = 0; gq < 8; ++gq) { const float prev = gq ? ps[gq - 1] : carry; const float fin = mainv[gq] + (hb ? ps[gq] : prev);
                  if (h4 == 0) sc[qi * 128 + 16 * kt + 8 * (gq >> 2) + 2 * (gq & 3) + hb] = fin; }
              carry = ps[7]; }
            bf16x8 pa[4]; fa::pack_p(s0, s1, pa);
            fa::pv_tile<64>(lds + A_VB0 + buf * A_VB, pa, ob, lane);
            if (kt + 1 < ntc) ld.commit(lds + (buf ^ 1) * A_KB, lds + A_VB0 + (buf ^ 1) * A_VB, tid, true);
            __syncthreads();
        }
#pragma unroll
        for (int d = 0; d < 2; ++d)
#pragma unroll
            for (int i = 0; i < 16; ++i) ob[d][i] = gc * ob[d][i];
    }
    {
        NSA_IDS
        asm volatile("s_waitcnt lgkmcnt(0)" ::: "memory");
        const int qq = lane >> 3, sub = lane & 7, cur = j;
        float v[16];
#pragma unroll
        for (int k = 0; k < 4; ++k) { const f32x4 x = *(const LAS f32x4*)(sc + qq * 128 + 16 * sub + 4 * k); v[4 * k] = x[0]; v[4 * k + 1] = x[1]; v[4 * k + 2] = x[2]; v[4 * k + 3] = x[3]; }
        unsigned bits = 0u;
        if (cur < 16) {
#pragma unroll
            for (int jj = 0; jj < 16; ++jj) if (16 * sub + jj <= cur) bits |= 1u << jj;
        } else {
#pragma unroll
            for (int jj = 0; jj < 16; ++jj) { const int blk = 16 * sub + jj; if (!(blk >= 1 && blk <= cur - 2)) v[jj] = -1.f; }
            for (int round = 0; round < 13; ++round) {
                float bm = v[0]; int bi = 0;
#pragma unroll
                for (int jj = 1; jj < 16; ++jj) if (v[jj] > bm) { bm = v[jj]; bi = jj; }
                int gi = 16 * sub + bi;
#pragma unroll
                for (int st = 1; st < 8; st <<= 1) { const float ov = __shfl_xor(bm, st); const int oi = __shfl_xor(gi, st); if (ov > bm || (ov == bm && oi < gi)) { bm = ov; gi = oi; } }
                const bool own = (gi >> 4) == sub; const int wj = gi & 15;
#pragma unroll
                for (int jj = 0; jj < 16; ++jj) if (own && jj == wj) { v[jj] = -1.f; bits |= 1u << jj; }
            }
#pragma unroll
            for (int jj = 0; jj < 16; ++jj) { const int blk = 16 * sub + jj; if (blk == 0 || blk == cur || blk == cur - 1) bits |= 1u << jj; }
        }
        ((LAS unsigned short*)(lds + A_SM + wid * 128))[qq * 8 + sub] = (unsigned short)bits;
        unsigned ub = bits; ub |= __shfl_xor(ub, 8); ub |= __shfl_xor(ub, 16); ub |= __shfl_xor(ub, 32);
        if (lane < 8) ((LAS unsigned short*)(lds + A_UN))[wid * 8 + lane] = (unsigned short)ub;
    }
    __syncthreads();
    LAS float* otl = (LAS float*)(lds + A_SC + wid * 8192) + lane;
#pragma unroll
    for (int d = 0; d < 2; ++d)
#pragma unroll
        for (int i = 0; i < 16; ++i) { otl[64 * (16 * d + i)] = ob[d][i]; ob[d][i] = 0.f; }
    {
        NSA_IDS
        u32x4 un = (u32x4){0u, 0u, 0u, 0u};
#pragma unroll
        for (int w = 0; w < 8; ++w) { const u32x4 x = *(const LAS u32x4*)(lds + A_UN + w * 16); un.x |= x.x; un.y |= x.y; un.z |= x.z; un.w |= x.w; }
        un.x = __builtin_amdgcn_readfirstlane(un.x); un.y = __builtin_amdgcn_readfirstlane(un.y); un.z = __builtin_amdgcn_readfirstlane(un.z); un.w = __builtin_amdgcn_readfirstlane(un.w);
        u32x4 wv = *(const LAS u32x4*)(lds + A_UN + wid * 16);
        wv.x = __builtin_amdgcn_readfirstlane(wv.x); wv.y = __builtin_amdgcn_readfirstlane(wv.y); wv.z = __builtin_amdgcn_readfirstlane(wv.z); wv.w = __builtin_amdgcn_readfirstlane(wv.w);
        const u32x4 mq = *(const LAS u32x4*)(lds + A_SM + wid * 128 + qi * 16);
        Ld64 ld; ld.kp = pb + (PC_KS + g * 64) * 2; ld.vp = pb + (PC_VS + g * 64) * 2; ld.kstr = PW * 2; ld.vstr = PW * 2;
        float ms = fa::NEG, ls = 0.f;
        int blk = next_bit(un, 0), buf = 0;
        ld.issue(64 * blk, tid, true); ld.commit(lds, lds + A_VB0, tid, true); __syncthreads();
        while (blk < 128) {
            const int nblk = next_bit(un, blk + 1);
            if (nblk < 128) ld.issue(64 * nblk, tid, true);
            if ((getw(wv, blk >> 5) >> (blk & 31)) & 1u) {
                f32x16 s0, s1; fa::qk_tile<64>(lds + buf * A_KB, qf, s0, s1, r32, hb);
                const bool lsel = ((getw(mq, blk >> 5) >> (blk & 31)) & 1u) != 0u;
                fa::score_tile<true>(s0, s1, (float)(t - 64 * blk), 1.f, c1, slope2, 1.0e9f, lsel, hb);
                const float alpha = fa::softmax_step(s0, s1, ms, ls);
                ob[0] = ob[0] * alpha; ob[1] = ob[1] * alpha;
                bf16x8 pa[4]; fa::pack_p(s0, s1, pa);
                fa::pv_tile<64>(lds + A_VB0 + buf * A_VB, pa, ob, lane);
            }
            if (nblk < 128) ld.commit(lds + (buf ^ 1) * A_KB, lds + A_VB0 + (buf ^ 1) * A_VB, tid, true);
            __syncthreads(); buf ^= 1; blk = nblk;
        }
        const float f = (ms > -1.0e29f) ? gs / ls : 0.f;
#pragma unroll
        for (int d = 0; d < 2; ++d)
#pragma unroll
            for (int i = 0; i < 16; ++i) { otl[64 * (16 * d + i)] += f * ob[d][i]; ob[d][i] = 0.f; }
    }
    {
        NSA_IDS
        Ld64 ld; ld.kp = pb + (PC_KW + g * 64) * 2; ld.vp = pb + (PC_VW + g * 64) * 2; ld.kstr = PW * 2; ld.vstr = PW * 2;
        float mw = fa::NEG, lw = 0.f;
        const int b0 = j >= 8 ? j - 8 : 0; int buf = 0;
        ld.issue(64 * b0, tid, true); ld.commit(lds, lds + A_VB0, tid, true); __syncthreads();
        for (int blk = b0; blk <= j; ++blk) {
            if (blk < j) ld.issue(64 * (blk + 1), tid, true);
            f32x16 s0, s1; fa::qk_tile<64>(lds + buf * A_KB, qf, s0, s1, r32, hb);
            if (blk == j || blk == j - 8) fa::score_tile<true>(s0, s1, (float)(t - 64 * blk), 1.f, c1, slope2, 512.f, true, hb);
            else fa::score_tile<false>(s0, s1, (float)(t - 64 * blk), 1.f, c1, slope2, 512.f, true, hb);
            const float alpha = fa::softmax_step(s0, s1, mw, lw);
            ob[0] = ob[0] * alpha; ob[1] = ob[1] * alpha;
            bf16x8 pa[4]; fa::pack_p(s0, s1, pa);
            fa::pv_tile<64>(lds + A_VB0 + buf * A_VB, pa, ob, lane);
            if (blk < j) ld.commit(lds + (buf ^ 1) * A_KB, lds + A_VB0 + (buf ^ 1) * A_VB, tid, true);
            __syncthreads(); buf ^= 1;
        }
        const float f = (mw > -1.0e29f) ? gw / lw : 0.f;
#pragma unroll
        for (int d = 0; d < 2; ++d)
#pragma unroll
            for (int i = 0; i < 16; ++i) ob[d][i] = otl[64 * (16 * d + i)] + f * ob[d][i];
    }
#pragma unroll
    for (int d = 0; d < 2; ++d)
#pragma unroll
        for (int k = 0; k < 4; ++k) { u32x2 w; w.x = pk2(ob[d][4 * k], ob[d][4 * k + 1]); w.y = pk2(ob[d][4 * k + 2], ob[d][4 * k + 3]);
            if (!dry) *(u32x2*)(prow + PC_NQ + head * 64 + 32 * d + 8 * k + 4 * hb) = w; }
    __syncthreads();
}

__device__ __forceinline__ int srccol(int mode, int n) {
    if (mode == 0) return n;
    if (mode == 1) {
        if (n < 1280) return n;
        if (n < 2816) return n - 1280 + 1304;
        if (n < 3200) return n - 2816 + 2840;
        if (n < 3232) { const int i = n - 3200; return 3224 + (i & 1) * 16 + (i >> 1); }
        if (n < 3256) return 1280 + (n - 3232);
        return -1; }
    { const int h = n / 96, c = n - h * 96; if (c < 64) return n; const int i = c - 64; return h * 96 + 64 + (i & 1) * 16 + (i >> 1); }
}
__device__ __forceinline__ void tconv_item(const float* W, int ldw, const float* kscale, bf16* WT, int K, int N, int mode, int item, LAS float* scr, int lane) {
    const int nblk = N / 32, kb = item / nblk, nb = item - kb * nblk, k0 = 64 * kb, n0 = 32 * nb;
    if (mode == 0 || (mode == 1 && n0 + 31 < 3200)) {
        const int c0 = srccol(mode, n0), kq = lane >> 3, n4 = (lane & 7) * 4;
        f32x4 x[8];
#pragma unroll
        for (int i = 0; i < 8; ++i) x[i] = *(const f32x4*)(W + (size_t)(k0 + kq + 8 * i) * ldw + c0 + n4);
#pragma unroll
        for (int i = 0; i < 8; ++i) { const int kk = kq + 8 * i; const float ksc = kscale ? kscale[k0 + kk] : 1.f; LAS float* d = scr + kk * 33 + n4;
            d[0] = x[i][0] * ksc; d[1] = x[i][1] * ksc; d[2] = x[i][2] * ksc; d[3] = x[i][3] * ksc; }
    } else {
    const int sc = srccol(mode, n0 + (lane & 31));
#pragma unroll 8
    for (int i = 0; i < 32; ++i) { const int kk = 2 * i + (lane >> 5); float x = 0.f; if (sc >= 0) { x = W[(size_t)(k0 + kk) * ldw + sc]; if (kscale) x *= kscale[k0 + kk]; } scr[kk * 33 + (lane & 31)] = x; }
    }
    asm volatile("s_waitcnt lgkmcnt(0)" ::: "memory");
    const int c = lane & 7;
#pragma unroll
    for (int j = 0; j < 4; ++j) { const int n = (lane >> 3) + 8 * j; const LAS float* s = scr + (8 * c) * 33 + n;
        u32x4 o; o.x = pk2(s[0 * 33], s[1 * 33]); o.y = pk2(s[2 * 33], s[3 * 33]); o.z = pk2(s[4 * 33], s[5 * 33]); o.w = pk2(s[6 * 33], s[7 * 33]);
        *(u32x4*)(WT + (size_t)(n0 + n) * K + k0 + 8 * c) = o; }
    asm volatile("s_waitcnt lgkmcnt(0)" ::: "memory");
}
struct TJob { const float* W; const float* ks; bf16* WT; int ldw, K, N, mode, item; };
__device__ __forceinline__ bool tjob_fast(const TJob& j) { const int nblk = j.N / 32, kb = j.item / nblk, n0 = 32 * (j.item - kb * nblk); return j.mode == 0 || (j.mode == 1 && n0 + 31 < 3200); }
__device__ __forceinline__ void tconv_load(const TJob& j, f32x4 (&x)[8], int lane) {
    if (!tjob_fast(j)) return;
    const int nblk = j.N / 32, kb = j.item / nblk, nb = j.item - kb * nblk, k0 = 64 * kb, n0 = 32 * nb;
    const int c0 = srccol(j.mode, n0), kq = lane >> 3, n4 = (lane & 7) * 4;
#pragma unroll
    for (int i = 0; i < 8; ++i) x[i] = *(const f32x4*)(j.W + (size_t)(k0 + kq + 8 * i) * j.ldw + c0 + n4);
}
__device__ __forceinline__ void tconv_finish(const TJob& j, const f32x4 (&x)[8], LAS float* scr, int lane) {
    if (!tjob_fast(j)) { tconv_item(j.W, j.ldw, j.ks, j.WT, j.K, j.N, j.mode, j.item, scr, lane); return; }
    const int nblk = j.N / 32, kb = j.item / nblk, nb = j.item - kb * nblk, k0 = 64 * kb, n0 = 32 * nb;
    const int kq = lane >> 3, n4 = (lane & 7) * 4;
#pragma unroll
    for (int i = 0; i < 8; ++i) { const int kk = kq + 8 * i; const float ksc = j.ks ? j.ks[k0 + kk] : 1.f; LAS float* d = scr + kk * 33 + n4;
        d[0] = x[i][0] * ksc; d[1] = x[i][1] * ksc; d[2] = x[i][2] * ksc; d[3] = x[i][3] * ksc; }
    asm volatile("s_waitcnt lgkmcnt(0)" ::: "memory");
    const int c = lane & 7;
#pragma unroll
    for (int q = 0; q < 4; ++q) { const int n = (lane >> 3) + 8 * q; const LAS float* sp = scr + (8 * c) * 33 + n;
        u32x4 o; o.x = pk2(sp[0 * 33], sp[1 * 33]); o.y = pk2(sp[2 * 33], sp[3 * 33]); o.z = pk2(sp[4 * 33], sp[5 * 33]); o.w = pk2(sp[6 * 33], sp[7 * 33]);
        *(u32x4*)(j.WT + (size_t)(n0 + n) * j.K + k0 + 8 * c) = o; }
    asm volatile("s_waitcnt lgkmcnt(0)" ::: "memory");
}
#define TCONV_LOOP(NITEMS, DECODE) do { int it_ = gw; if (it_ < (NITEMS)) { TJob cur_; f32x4 xc_[8]; DECODE(it_, cur_); tconv_load(cur_, xc_, lane); \
        for (;;) { const int nit_ = it_ + NGW; const bool hn_ = nit_ < (NITEMS); TJob nx_ = cur_; f32x4 xn_[8]; \
            _Pragma("unroll") for (int q_ = 0; q_ < 8; ++q_) xn_[q_] = xc_[q_]; \
            if (hn_) { DECODE(nit_, nx_); tconv_load(nx_, xn_, lane); } \
            tconv_finish(cur_, xc_, scr, lane); if (!hn_) break; cur_ = nx_; it_ = nit_; \
            _Pragma("unroll") for (int q_ = 0; q_ < 8; ++q_) xc_[q_] = xn_[q_]; } } } while (0)
__device__ __forceinline__ void ln_row(f32x4 (&v)[4], const float* g, const float* b, int lane) {
    float s = 0.f;
#pragma unroll
    for (int j = 0; j < 4; ++j) s += (v[j][0] + v[j][1]) + (v[j][2] + v[j][3]);
    const float mean = wave_sum(s) * (1.f / 1024.f); float s2 = 0.f;
#pragma unroll
    for (int j = 0; j < 4; ++j) { v[j] = v[j] - mean; s2 += (v[j][0] * v[j][0] + v[j][1] * v[j][1]) + (v[j][2] * v[j][2] + v[j][3] * v[j][3]); }
    const float rstd = 1.f / sqrtf(wave_sum(s2) * (1.f / 1024.f) + 1e-5f);
#pragma unroll
    for (int j = 0; j < 4; ++j) { const f32x4 gg = *(const f32x4*)(g + 4 * lane + 256 * j), bb = *(const f32x4*)(b + 4 * lane + 256 * j); v[j] = v[j] * rstd * gg + bb; }
}
__device__ __forceinline__ void store_row_bf16(bf16* row, const f32x4 (&v)[4], int lane) {
#pragma unroll
    for (int j = 0; j < 4; ++j) { u32x2 w; w.x = pk2(v[j][0], v[j][1]); w.y = pk2(v[j][2], v[j][3]); *(u32x2*)(row + 4 * lane + 256 * j) = w; }
}

struct InPtrs { const float* const* p; __device__ __forceinline__ const float* operator[](int i) const { return (const float*)(GAS const float*)p[i]; } };
#define PHASE_IDS int wid_l_ = wid_k; asm volatile("" : "+s"(wid_l_)); const int lane_l_ = lane_id_v(); \
    const int wid = wid_l_, lane = lane_l_, tid = wid * 64 + lane, gw = c * 8 + wid; (void)lane; (void)gw; (void)wid; (void)tid; \
    GAS unsigned char* ws_l_ = (GAS unsigned char*)ws_k; GAS unsigned char* dout_l_ = (GAS unsigned char*)dout_k; asm volatile("" : "+s"(ws_l_), "+s"(dout_l_)); \
    unsigned char* const ws = (unsigned char*)ws_l_; unsigned char* const dout = (unsigned char*)dout_l_; (void)dout;
struct Args { const float* in[29]; float* out; unsigned char* ws; int ph_lo, ph_hi; };

__global__ void __launch_bounds__(512, 2) fwd(Args a) {
    extern __shared__ __attribute__((aligned(16))) unsigned char lds_[];
    LAS unsigned char* lds = (LAS unsigned char*)lds_;
    LAS char* ldc = (LAS char*)lds_;
    const int wid_k = __builtin_amdgcn_readfirstlane((int)threadIdx.x >> 6);
    const int G = gridDim.x, c = blockIdx.x, v = (G % 8 == 0) ? (c % 8) * (G / 8) + c / 8 : c;
    const int NGW = G * 8;
    volatile LAS unsigned* MISC = (volatile LAS unsigned*)(lds + LDS_MISC);
    if (threadIdx.x < 256) MISC[threadIdx.x] = 0u;
    __syncthreads();
    const InPtrs INP{a.in};
    unsigned char* const ws_k = a.ws;
    unsigned* ctl = (unsigned*)(ws_k + WS_CTL);
#if !MK_PER_PHASE
    XcdBarrier bar = xcd_barrier_post(ctl + CW_BAR, MISC + 8);
#define GRID_BAR() do { xcd_barrier(bar); if (PROBE_REPEAT == 17) xcd_barrier(bar); } while (0)
#else
#define GRID_BAR() do {} while (0)
#endif
    const int lo = a.ph_lo, hi = a.ph_hi;
#define IN(k) (lo <= (k) && (k) < hi)
#define BOTH(k) (IN(k) && IN((k) + 1))
    unsigned char* const dout_k = (unsigned char*)a.out;
#define CS ((float*)(ws + WS_CS))
#define MISCF ((float*)(ws + WS_MISC))
#define RSQ ((float*)(ws + WS_RSQ))
#define RSKV ((float*)(ws + WS_RSKV))
#define RTE ((int*)(ws + WS_RTE))
#define RTP ((int*)(ws + WS_RTP))
#define RTG ((float*)(ws + WS_RTG))
#define ROWIDX ((int*)(ws + WS_ROWIDX))
#define KCMP ((bf16*)(ws + WS_KCMP))
#define VCMP ((bf16*)(ws + WS_VCMP))
#define UL ((bf16*)(ws + WS_UL))
#define Hb ((bf16*)(ws + WS_HB))
#define P ((bf16*)(ws + WS_P))
#define Z ((bf16*)(ws + WS_P))
#define YS ((bf16*)(ws + WS_P))
#define HS ((bf16*)(ws + WS_HS))
#define GSwg ((bf16*)(ws + WS_GS) + (size_t)c * 3 * 65536)
#define QM ((bf16*)(dout + DO_QM))
#define KVM ((bf16*)(dout + DO_KVM))
#define Y ((bf16*)(dout + DO_KVM))
#define W13T ((bf16*)(dout + DO_W13))
#define W2T ((bf16*)(dout + DO_W2))
#define LAYER_W unsigned char* wl = ws + WS_WTS + (size_t)l * WL_STRIDE; \
        const bf16* WinT = (const bf16*)(wl + WL_WIN); const bf16* WgT = (const bf16*)(wl + WL_WG); const bf16* WbrT = (const bf16*)(wl + WL_WBR); const bf16* WoutT = (const bf16*)(wl + WL_WOUT); \
        const bf16* WuqT = (const bf16*)(wl + WL_WUQ); const bf16* WukvT = (const bf16*)(wl + WL_WUKV); const bf16* Wc1T = (const bf16*)(wl + WL_WC1); \
        unsigned* gcnt = (unsigned*)(ws + WS_CTL) + CW_CNT + l * 16 * 64; (void)WinT; (void)WgT; (void)WbrT; (void)WoutT; (void)WuqT; (void)WukvT; (void)Wc1T; (void)gcnt;
    if (PHON(0) && IN(0)) { PHASE_IDS
        for (int rep_ = (PROBE_REPEAT == 15 ? 0 : 1); rep_ < 2; ++rep_) {
        LAS float* scr = (LAS float*)(lds + wid * 8704);
#define DEC_PRO(it, J) do { const int l_ = (it) / 5152; int r_ = (it) - l_ * 5152; unsigned char* wl_ = ws + WS_WTS + (size_t)l_ * WL_STRIDE; \
            if (r_ < 1664) { J = TJob{INP[3] + (size_t)l_ * 1024 * IN_W, nullptr, (bf16*)(wl_ + WL_WIN), IN_W, 1024, 3328, 1, r_}; } \
            else if ((r_ -= 1664) < 1536) { J = TJob{INP[3] + (size_t)l_ * 1024 * IN_W + 3256, nullptr, (bf16*)(wl_ + WL_WG), IN_W, 1024, 3072, 0, r_}; } \
            else if ((r_ -= 1536) < 768) { const int jb_ = r_ / 256; J = TJob{INP[16 + jb_] + (size_t)l_ * 512 * 1024, nullptr, (bf16*)(wl_ + WL_WBR) + (size_t)jb_ * 1024 * 512, 1024, 512, 1024, 0, r_ - jb_ * 256}; } \
            else if ((r_ -= 768) < 512) { J = TJob{INP[19] + (size_t)l_ * 1024 * 1024, nullptr, (bf16*)(wl_ + WL_WOUT), 1024, 1024, 1024, 0, r_}; } \
            else if ((r_ -= 512) < 96) { J = TJob{INP[14] + (size_t)l_ * 256 * 768, INP[12] + l_ * 256, (bf16*)(wl_ + WL_WUQ), 768, 256, 768, 2, r_}; } \
            else if ((r_ -= 96) < 64) { J = TJob{INP[15] + (size_t)l_ * 128 * 1024, INP[13] + l_ * 128, (bf16*)(wl_ + WL_WUKV), 1024, 128, 1024, 0, r_}; } \
            else { r_ -= 64; const int job_ = r_ / 128, kv_ = job_ >> 1, half_ = job_ & 1; \
                J = TJob{INP[kv_ ? 8 : 5] + (size_t)l_ * 2048 * 256 + (size_t)half_ * 1024 * 256, nullptr, (bf16*)(wl_ + WL_WC1) + (size_t)kv_ * 512 * 1024 + (size_t)half_ * 256 * 1024, 256, 1024, 256, 0, r_ - job_ * 128}; } } while (0)
        TCONV_LOOP(2 * 5152, DEC_PRO);
#undef DEC_PRO
        for (int i = c * 512 + tid; i < S * 16; i += G * 512) { const int pos = i >> 4, k = i & 15;
            const float freq = fexp2(-(float)k * (13.287712379549449f / 16.f)); const float ang = (float)pos * freq;
            const double rev = (double)ang * 0.15915494309189535; const float fr = (float)(rev - __builtin_rint(rev));
            CS[2 * i] = __builtin_amdgcn_cosf(fr); CS[2 * i + 1] = __builtin_amdgcn_sinf(fr); }
        for (int jt = c * 512 + tid; jt < 32768; jt += G * 512) { const int i = jt & 1023, ch = jt >> 10; const int l = i >> 9, kv = (i >> 8) & 1, n = i & 255;
            const float* pos = INP[kv ? 7 : 4] + l * 2048 + ch * 64; const float* w1 = INP[kv ? 8 : 5] + (size_t)l * 2048 * 256 + (size_t)ch * 64 * 256 + n; float s = 0.f;
#pragma unroll 8
            for (int k = 0; k < 64; ++k) s += pos[k] * w1[(size_t)k * 256];
            MISCF[2048 + ch * 1024 + i] = s; }
        if (c == 0 && tid < 2) { const float* lp = INP[10] + tid * 256; float s1 = 0.f, s2 = 0.f;
            for (int k = 0; k < 64; ++k) { s1 += lp[k] * lp[64 + k]; s2 += lp[128 + k] * lp[192 + k]; }
            const float li = 0.8f - 0.6f * __expf(-0.3f * (float)tid); MISCF[1024 + tid] = __expf(s1) - __expf(s2) + li; MISCF[1026 + tid] = li; }
        { f32x4 xn[4];
          if (gw < T) {
#pragma unroll
              for (int j = 0; j < 4; ++j) xn[j] = *(const f32x4*)(INP[0] + (size_t)gw * 1024 + 4 * lane + 256 * j); }
          for (int m = gw; m < T; m += NGW) { f32x4 x[4];
#pragma unroll
            for (int j = 0; j < 4; ++j) x[j] = xn[j];
            const int mn_ = m + NGW < T ? m + NGW : m;
#pragma unroll
            for (int j = 0; j < 4; ++j) xn[j] = *(const f32x4*)(INP[0] + (size_t)mn_ * 1024 + 4 * lane + 256 * j);
            ln_row(x, INP[1], INP[2], lane); store_row_bf16(Hb + (size_t)m * 1024, x, lane); } }
        }
        if (BOTH(0)) GRID_BAR();
    }

    for (int l = 0; l < NLAYER; ++l) {
        const int pbase = 1 + 11 * l;
        if (PHON(1) && IN(pbase + 0)) { PHASE_IDS LAYER_W
            for (int rep_ = (PROBE_REPEAT == 1 ? 0 : 1); rep_ < 2; ++rep_) {
            pg8::TileSched Sd{(const char*)Hb, (const char*)WinT, 2048, 1024, 13, 128 * 13, G, v}; pg8::EpiStore E{P, PW, nullptr, 0, false};
            pg8::gemm_phase<pg8::EpiStore, pg8::TileSched, true>(lds, wid, 1024, 128u, Sd, E);
            }
            if (BOTH(pbase + 0)) GRID_BAR();
        }
        if (PHON(2) && IN(pbase + 1)) { PHASE_IDS LAYER_W
            for (int i = c * 512 + tid; i < 512; i += G * 512) { float sacc = 0.f;
                for (int ch = 0; ch < 32; ++ch) sacc += MISCF[2048 + ch * 1024 + l * 512 + i];
                MISCF[l * 512 + i] = sacc; }
            for (int rep_ = (PROBE_REPEAT == 2 ? 0 : 1); rep_ < 2; ++rep_)
            for (int m = gw; m < T; m += NGW) { bf16* pr = P + (size_t)m * PW; float ss = 0.f;
                if (lane < 48) { const u32x4 w = *(const u32x4*)(pr + (lane < 32 ? PC_CQ + lane * 8 : PC_CKV + (lane - 32) * 8));
                    ss = bflo(w.x) * bflo(w.x) + bfhi(w.x) * bfhi(w.x) + bflo(w.y) * bflo(w.y) + bfhi(w.y) * bfhi(w.y) + bflo(w.z) * bflo(w.z) + bfhi(w.z) * bfhi(w.z) + bflo(w.w) * bflo(w.w) + bfhi(w.w) * bfhi(w.w); }
                else if (lane < 52) { const int i0 = (lane - 48) * 4, pos = m & (S - 1); u32x4 w = *(const u32x4*)(pr + PC_KR + i0 * 2);
                    const f32x4* cs = (const f32x4*)(CS + ((size_t)pos * 16 + i0) * 2); const f32x4 ca = cs[0], cb = cs[1];
                    u32x4 o;
                    o.x = pk2(bflo(w.x) * ca[0] - bfhi(w.x) * ca[1], bflo(w.x) * ca[1] + bfhi(w.x) * ca[0]);
                    o.y = pk2(bflo(w.y) * ca[2] - bfhi(w.y) * ca[3], bflo(w.y) * ca[3] + bfhi(w.y) * ca[2]);
                    o.z = pk2(bflo(w.z) * cb[0] - bfhi(w.z) * cb[1], bflo(w.z) * cb[1] + bfhi(w.z) * cb[0]);
                    o.w = pk2(bflo(w.w) * cb[2] - bfhi(w.w) * cb[3], bflo(w.w) * cb[3] + bfhi(w.w) * cb[2]);
                    bf16* kr = KVM + (size_t)m * KVW + 64 + i0 * 2;
#pragma unroll
                    for (int hh = 0; hh < 8; ++hh) *(u32x4*)(kr + hh * 160) = o; }
                const float sq = wave_sum(lane < 32 ? ss : 0.f), skv = wave_sum((lane >= 32 && lane < 48) ? ss : 0.f);
                if (lane == 0) { RSQ[m] = 1.f / sqrtf(sq * (1.f / 256.f) + 1e-6f); RSKV[m] = 1.f / sqrtf(skv * (1.f / 128.f) + 1e-6f); } }
            if (BOTH(pbase + 1)) GRID_BAR();
        }
        if (PHON(3) && IN(pbase + 2)) { PHASE_IDS LAYER_W
            for (int rep_ = (PROBE_REPEAT == 3 ? 0 : 1); rep_ < 2; ++rep_) {
            { pg8::TileSched Sd{(const char*)(P + PC_CQ), (const char*)WuqT, PW * 2, 256, 3, 384, G, v}; pg8::EpiRope E{QM, CS};
              pg8::gemm_phase<pg8::EpiRope, pg8::TileSched, true>(lds, wid, 256, 128u, Sd, E); }
            { pg8::TileSched Sd{(const char*)(P + PC_CKV), (const char*)WukvT, PW * 2, 128, 4, 512, G, v}; pg8::EpiStore E{KVM, KVW, RSKV, 0, true};
              pg8::gemm_phase<pg8::EpiStore, pg8::TileSched, true>(lds, wid, 128, 128u, Sd, E); }
            { pg8::CmpSched Sd{(const char*)P, (const char*)Wc1T, G, v >= G - 64 ? v - (G - 64) : 64 + v}; pg8::EpiStore E{UL, 512, nullptr, (size_t)512 * 512, false};
              pg8::gemm_phase<pg8::EpiStore, pg8::CmpSched, true>(lds, wid, 1024, (unsigned)(PW * 2), Sd, E); }
            }
            if (BOTH(pbase + 2)) GRID_BAR();
        }
        if (PHON(4) && IN(pbase + 3)) { PHASE_IDS LAYER_W
            for (int rep_ = (PROBE_REPEAT == 4 ? 0 : 1); rep_ < 2; ++rep_) {
            LAS float* hid = (LAS float*)(lds + wid * 1024);
            for (int r = gw; r < 2 * 8 * 512; r += NGW) { const int kv = r >> 12, bg = (r >> 9) & 7, i = r & 511;
                bf16* out = (kv ? VCMP : KCMP) + ((size_t)bg * 512 + i) * 64;
                if (i == 511) { out[lane] = 0; continue; }
                const bf16* u = UL + ((size_t)(kv * 8 + bg) * 512 + i) * 512; const float* pbv = MISCF + l * 512 + kv * 256;
#pragma unroll
                for (int q = 0; q < 4; ++q) { const int n = lane + 64 * q; const float x = bf2f(u[n]) + bf2f(u[512 + 256 + n]) + pbv[n];
                    const float y = 0.7978845608028654f * (x + 0.044715f * x * x * x); const float th = 1.f - 2.f / (__expf(2.f * y) + 1.f);
                    hid[n] = 0.5f * x * (1.f + th); }
                asm volatile("s_waitcnt lgkmcnt(0)" ::: "memory");
                const float* w2 = INP[kv ? 9 : 6] + (size_t)l * 256 * 64 + lane; float acc = 0.f;
#pragma unroll 8
                for (int n = 0; n < 256; ++n) acc += hid[n] * w2[n * 64];
                out[lane] = (bf16)f2bf(acc);
                asm volatile("s_waitcnt lgkmcnt(0)" ::: "memory"); }
            }
            if (BOTH(pbase + 3)) GRID_BAR();
        }
        if (PHON(5) && IN(pbase + 4)) { PHASE_IDS LAYER_W
            const int xcd = c & 7, ii = c >> 3;
            if (G == 256) {
                for (int rep = (PROBE_REPEAT == 11 ? 0 : 1); rep < 2; ++rep)
                if (PHON(11)) for (int k = 0; k < 4; ++k) { const int bh = xcd + 8 * k; mla_unit(ldc, bh >> 3, bh & 7, (k & 1) ? ii : 31 - ii, QM, KVM, RSQ, wid, rep == 0); }
                for (int rep = (PROBE_REPEAT == 12 ? 0 : 1); rep < 2; ++rep)
                if (PHON(12)) for (int k = 0; k < 2; ++k) { const int bh = xcd + 8 * k; diff_unit(ldc, bh >> 2, bh & 3, k ? ii : 31 - ii, P, MISCF[1024 + l], MISCF[1026 + l], INP[11] + l * 128, GSwg, wid, rep == 0); }
                if (PHON(13)) for (int k = (PROBE_REPEAT == 13 ? -4 : 0); k < 4; ++k) { const int kk = k & 3; const int tile = (kk == 0) ? ii : (kk == 1) ? 63 - ii : (kk == 2) ? 64 + ii : 127 - ii; nsa_unit(ldc, xcd >> 1, xcd & 1, tile, P, KCMP, VCMP, wid, k < 0); }
            } else {
                if (PHON(11)) for (int u = c; u < 1024; u += G) { const int bh = u & 31; mla_unit(ldc, bh >> 3, bh & 7, 31 - (u >> 5), QM, KVM, RSQ, wid); }
                if (PHON(12)) for (int u = c; u < 512; u += G) { const int bh = u & 15; diff_unit(ldc, bh >> 2, bh & 3, 31 - (u >> 4), P, MISCF[1024 + l], MISCF[1026 + l], INP[11] + l * 128, GSwg, wid); }
                if (PHON(13)) for (int u = c; u < 1024; u += G) { const int bg = u & 7; nsa_unit(ldc, bg >> 1, bg & 1, 127 - (u >> 3), P, KCMP, VCMP, wid); }
            }
            if (BOTH(pbase + 4)) GRID_BAR();
        }
        if (PHON(6) && IN(pbase + 5)) { PHASE_IDS LAYER_W
            for (int rep_ = (PROBE_REPEAT == 6 ? 0 : 1); rep_ < 2; ++rep_) {
            for (int tl = v; tl < 512; tl += G) {
                const int pm = tl >> 2, pn = tl & 3;
                { pg8::GateSched Sd{(const char*)Hb, (const char*)WgT, pm, pn, true}; pg8::EpiGate E{GSwg};
                  pg8::gemm_phase<pg8::EpiGate, pg8::GateSched, true>(lds, wid, 1024, 128u, Sd, E); }
                { pg8::ChainSched Sd{(const char*)(P + PC_NQ), (const char*)(P + PC_DQ), (const char*)QM, (const char*)WbrT, pm, pn, true}; pg8::EpiChain E{Y, GSwg};
                  pg8::gemm_phase<pg8::EpiChain, pg8::ChainSched, true>(lds, wid, 512, 128u, Sd, E); }
            }
            }
            if (BOTH(pbase + 5)) GRID_BAR();
        }
        if (PHON(7) && IN(pbase + 6)) { PHASE_IDS LAYER_W
            for (int rep_ = (PROBE_REPEAT == 7 ? 0 : 1); rep_ < 2; ++rep_) {
            pg8::TileSched Sd{(const char*)Y, (const char*)WoutT, 2048, 1024, 4, 512, G, v}; pg8::EpiResid E{Z, Hb};
            pg8::gemm_phase<pg8::EpiResid, pg8::TileSched, true>(lds, wid, 1024, 128u, Sd, E);
            }
            if (BOTH(pbase + 6)) GRID_BAR();
        }
        if (PHON(8) && IN(pbase + 7)) { PHASE_IDS LAYER_W
            LAS float* rwT = (LAS float*)lds;
            for (int i = tid; i < 16384; i += 512) rwT[(i & 15) * 1024 + (i >> 4)] = INP[22][i];
            volatile LAS int* cntL = (volatile LAS int*)(MISC + 16); volatile LAS int* cbase = (volatile LAS int*)(MISC + 32);
            const float* g1 = INP[20] + l * 1024; const float* b1 = INP[21] + l * 1024; const float* rb = INP[23];
            const int nit = (T + G * 128 - 1) / (G * 128);
            for (int rep_ = (PROBE_REPEAT == 8 ? 0 : 1); rep_ < 2; ++rep_)
            for (int it = 0; it < nit; ++it) {
                if (tid < 16) cntL[tid] = 0;
                __syncthreads();
                const int base = (it * G + c) * 128 + wid * 16;
                int e0 = -1, e1 = -1; float g0 = 0.f, g1v = 0.f;
                u32x2 zn[4];
                { const int m0_ = base < T ? base : T - 1;
#pragma unroll
                  for (int j = 0; j < 4; ++j) zn[j] = *(const u32x2*)(Z + (size_t)m0_ * 1024 + 4 * lane + 256 * j); }
                for (int i = 0; i < 16; ++i) { const int m = base + i; if (m >= T) break;
                    f32x4 x[4];
#pragma unroll
                    for (int j = 0; j < 4; ++j) { const u32x2 zw = zn[j]; x[j] = (f32x4){bflo(zw.x), bfhi(zw.x), bflo(zw.y), bfhi(zw.y)}; }
                    { const int mn_ = (i + 1 < 16 && m + 1 < T) ? m + 1 : m;
#pragma unroll
                      for (int j = 0; j < 4; ++j) zn[j] = *(const u32x2*)(Z + (size_t)mn_ * 1024 + 4 * lane + 256 * j); }
                    ln_row(x, g1, b1, lane); store_row_bf16(Hb + (size_t)m * 1024, x, lane);
                    float sel[16], aff[16];
                    { float acc[16];
#pragma unroll
                      for (int e = 0; e < 16; ++e) { float a_ = 0.f;
#pragma unroll
                          for (int j = 0; j < 4; ++j) { const f32x4 w = *(const LAS f32x4*)(rwT + e * 1024 + 4 * lane + 256 * j); a_ += x[j][0] * w[0] + x[j][1] * w[1] + x[j][2] * w[2] + x[j][3] * w[3]; }
                          acc[e] = a_; }
                      float v8[8], v4[4], v2[2], v1;
                      { const bool hi = (lane & 32) != 0;
#pragma unroll
                        for (int e = 0; e < 8; ++e) { const float rcv = __shfl_xor(hi ? acc[e] : acc[e + 8], 32); v8[e] = (hi ? acc[e + 8] : acc[e]) + rcv; } }
                      { const bool hi = (lane & 16) != 0;
#pragma unroll
                        for (int e = 0; e < 4; ++e) { const float rcv = __shfl_xor(hi ? v8[e] : v8[e + 4], 16); v4[e] = (hi ? v8[e + 4] : v8[e]) + rcv; } }
                      { const bool hi = (lane & 8) != 0;
#pragma unroll
                        for (int e = 0; e < 2; ++e) { const float rcv = __shfl_xor(hi ? v4[e] : v4[e + 2], 8); v2[e] = (hi ? v4[e + 2] : v4[e]) + rcv; } }
                      { const bool hi = (lane & 4) != 0; const float rcv = __shfl_xor(hi ? v2[0] : v2[1], 4); v1 = (hi ? v2[1] : v2[0]) + rcv; }
                      v1 += __shfl_xor(v1, 2); v1 += __shfl_xor(v1, 1);
#pragma unroll
                      for (int e = 0; e < 16; ++e) { const float lg = __uint_as_float(__builtin_amdgcn_readlane(__float_as_uint(v1), 32 * (e >> 3) + 16 * ((e >> 2) & 1) + 8 * ((e >> 1) & 1) + 4 * (e & 1)));
                          aff[e] = sigmoidf_(lg); sel[e] = aff[e] + rb[e]; } }
                    int grp = 0; float best = -1e30f;
#pragma unroll
                    for (int gq = 0; gq < 4; ++gq) { float m1 = sel[4 * gq], m2 = -1e30f;
#pragma unroll
                        for (int q = 1; q < 4; ++q) { const float s = sel[4 * gq + q]; if (s > m1) { m2 = m1; m1 = s; } else if (s > m2) m2 = s; }
                        const float sc = m1 + m2; if (sc > best) { best = sc; grp = gq; } }
                    float s4[4], a4[4];
#pragma unroll
                    for (int q = 0; q < 4; ++q) { s4[q] = grp == 0 ? sel[q] : grp == 1 ? sel[4 + q] : grp == 2 ? sel[8 + q] : sel[12 + q]; a4[q] = grp == 0 ? aff[q] : grp == 1 ? aff[4 + q] : grp == 2 ? aff[8 + q] : aff[12 + q]; }
                    int i1 = 0;
#pragma unroll
                    for (int q = 1; q < 4; ++q) if (s4[q] > s4[i1 == 0 ? 0 : i1 == 1 ? 1 : i1 == 2 ? 2 : 3]) i1 = q;
                    int i2 = -1; float b2 = -1e30f;
#pragma unroll
                    for (int q = 0; q < 4; ++q) if (q != i1 && s4[q] > b2) { b2 = s4[q]; i2 = q; }
                    const float a1 = i1 == 0 ? a4[0] : i1 == 1 ? a4[1] : i1 == 2 ? a4[2] : a4[3], a2 = i2 == 0 ? a4[0] : i2 == 1 ? a4[1] : i2 == 2 ? a4[2] : a4[3];
                    const float inv = 1.f / (a1 + a2);
                    if (lane == i) { e0 = grp * 4 + i1; e1 = grp * 4 + i2; g0 = a1 * inv; g1v = a2 * inv; } }
                int p0 = 0, p1 = 0, mycount = 0; const unsigned long long lt = (1ull << lane) - 1ull;
#pragma unroll
                for (int e = 0; e < 16; ++e) { const unsigned long long b0 = __ballot(e0 == e), bb1 = __ballot(e1 == e); const int c0 = __popcll(b0);
                    if (lane == e) mycount = c0 + __popcll(bb1); if (e0 == e) p0 = __popcll(b0 & lt); if (e1 == e) p1 = c0 + __popcll(bb1 & lt); }
                int woff = 0; if (lane < 16) woff = __hip_atomic_fetch_add((LAS int*)(MISC + 16) + lane, mycount, __ATOMIC_RELAXED, __HIP_MEMORY_SCOPE_WORKGROUP);
                __syncthreads();
                if (tid < 16 && rep_) cbase[tid] = (int)xb_add(gcnt + tid * 64, (unsigned)cntL[tid]);
                __syncthreads();
                const int wo0 = __shfl(woff, e0 < 0 ? 0 : e0), wo1 = __shfl(woff, e1 < 0 ? 0 : e1);
                if (e0 >= 0 && rep_) { const int m = base + lane; const int q0 = cbase[e0] + wo0 + p0, q1 = cbase[e1] + wo1 + p1;
                    ROWIDX[e0 * CAP + q0] = m; ROWIDX[e1 * CAP + q1] = m; RTE[2 * m] = e0; RTE[2 * m + 1] = e1; RTP[2 * m] = q0; RTP[2 * m + 1] = q1; RTG[2 * m] = g0; RTG[2 * m + 1] = g1v; }
                __syncthreads();
            }
            LAS float* scr = (LAS float*)(lds + wid * 8704);
#define DEC_MOE(it, J) do { const int e_ = (it) / 768; const int r_ = (it) - e_ * 768; \
                if (r_ < 512) { const int job_ = r_ >> 6, pn_ = job_ >> 1, half_ = job_ & 1; \
                    J = TJob{INP[half_ ? 25 : 24] + ((size_t)l * 16 + e_) * 1024 * 512 + pn_ * 128, nullptr, W13T + (size_t)e_ * 1024 * 1024 + (size_t)(pn_ * 256 + half_ * 128) * 1024, 512, 1024, 128, 0, r_ & 63}; } \
                else { J = TJob{INP[26] + ((size_t)l * 16 + e_) * 512 * 1024, nullptr, W2T + (size_t)e_ * 1024 * 512, 1024, 512, 1024, 0, r_ - 512}; } } while (0)
            for (int rep_ = (PROBE_REPEAT == 16 ? 0 : 1); rep_ < 2; ++rep_) TCONV_LOOP(16 * 768, DEC_MOE);
#undef DEC_MOE
            if (BOTH(pbase + 7)) GRID_BAR();
        }
        if (PHON(9) && (IN(pbase + 8) || IN(pbase + 9))) { PHASE_IDS LAYER_W
            volatile LAS int* TP = (volatile LAS int*)(MISC + 64); volatile LAS int* CNT = (volatile LAS int*)(MISC + 96);
            if (tid == 0) { int acc = 0; for (int e = 0; e < 16; ++e) { const int cn = (int)xb_ld(gcnt + e * 64); CNT[e] = cn; TP[e] = acc; acc += (cn + 255) >> 8; } TP[16] = acc; }
            __syncthreads();
            if (IN(pbase + 8)) {
                pg8::MoeSched Sd{(const char*)Hb, (const char*)W13T, ROWIDX, TP, CNT, 2048, 1024, (size_t)1024 * 1024 * 2, true, G, v}; pg8::EpiSwiglu E{HS};
                for (int rep_ = (PROBE_REPEAT == 9 ? 0 : 1); rep_ < 2; ++rep_)
                pg8::gemm_phase<pg8::EpiSwiglu, pg8::MoeSched, true>(lds, wid, 1024, 128u, Sd, E);
                if (BOTH(pbase + 8)) GRID_BAR();
            }
            if (IN(pbase + 9)) {
                pg8::MoeSched Sd{(const char*)HS, (const char*)W2T, ROWIDX, TP, CNT, 1024, 512, (size_t)1024 * 512 * 2, false, G, v}; pg8::EpiStore E{YS, 1024, nullptr, 0, false};
                for (int rep_ = (PROBE_REPEAT == 14 ? 0 : 1); rep_ < 2; ++rep_)
                pg8::gemm_phase<pg8::EpiStore, pg8::MoeSched, true>(lds, wid, 512, 128u, Sd, E);
                if (BOTH(pbase + 9)) GRID_BAR();
            }
        }
        if (PHON(10) && IN(pbase + 10)) { PHASE_IDS LAYER_W
            int tp = 0;
            { const int cn = lane < 16 ? (int)xb_ld(gcnt + lane * 64) : 0; const int tl = (cn + 255) >> 8; int inc = tl;
#pragma unroll
              for (int o = 1; o < 16; o <<= 1) { const int n = __shfl_up(inc, o); if (lane >= o) inc += n; }
              tp = inc - tl; }
            const float* g2 = INP[27] + l * 1024; const float* b2 = INP[28] + l * 1024;
            for (int rep_ = (PROBE_REPEAT == 10 ? 0 : 1); rep_ < 2; ++rep_)
            for (int m = gw; m < T; m += NGW) {
                const int e0 = RTE[2 * m], e1 = RTE[2 * m + 1];
                const int r0 = __shfl(tp, e0) * 256 + RTP[2 * m], r1 = __shfl(tp, e1) * 256 + RTP[2 * m + 1]; const float g0 = RTG[2 * m], g1v = RTG[2 * m + 1];
                f32x4 x[4];
#pragma unroll
                for (int j = 0; j < 4; ++j) { const int col = 4 * lane + 256 * j;
                    const u32x2 hw = *(const u32x2*)(Hb + (size_t)m * 1024 + col), y0 = *(const u32x2*)(YS + (size_t)r0 * 1024 + col), y1 = *(const u32x2*)(YS + (size_t)r1 * 1024 + col);
                    x[j][0] = ALPHA * bflo(hw.x) + g0 * bflo(y0.x) + g1v * bflo(y1.x); x[j][1] = ALPHA * bfhi(hw.x) + g0 * bfhi(y0.x) + g1v * bfhi(y1.x);
                    x[j][2] = ALPHA * bflo(hw.y) + g0 * bflo(y0.y) + g1v * bflo(y1.y); x[j][3] = ALPHA * bfhi(hw.y) + g0 * bfhi(y0.y) + g1v * bfhi(y1.y); }
                ln_row(x, g2, b2, lane);
                if (!rep_) continue;
                if (l == NLAYER - 1) {
#pragma unroll
                    for (int j = 0; j < 4; ++j) *(f32x4*)((float*)dout + (size_t)m * 1024 + 4 * lane + 256 * j) = x[j];
                } else store_row_bf16(Hb + (size_t)m * 1024, x, lane);
            }
            if (BOTH(pbase + 10)) GRID_BAR();
        }
    }
#undef IN
#undef BOTH
}

extern "C" void kernel_launch(void* const* d_in, const int* in_sizes, int n_in, void* d_out, int out_size, void* d_ws, size_t ws_size, hipStream_t stream) {
    static int grid = 0;
    if (grid == 0) {
        if (n_in != 29 || out_size != T * DM || ws_size < WS_END) { fprintf(stderr, "kernel_launch: unexpected shapes (n_in %d out %d ws %zu)\n", n_in, out_size, ws_size); grid = -1; return; }
        int dev = 0, cus = 0, per_cu = 0;
        if (hipGetDevice(&dev) != hipSuccess || hipDeviceGetAttribute(&cus, hipDeviceAttributeMultiprocessorCount, dev) != hipSuccess) { grid = -1; return; }
        if (hipFuncSetAttribute((const void*)fwd, hipFuncAttributeMaxDynamicSharedMemorySize, LDS_BYTES) != hipSuccess) { fprintf(stderr, "kernel_launch: hipFuncSetAttribute failed\n"); grid = -1; return; }
        if (hipOccupancyMaxActiveBlocksPerMultiprocessor(&per_cu, (const void*)fwd, 512, LDS_BYTES) != hipSuccess || per_cu < 1) fprintf(stderr, "kernel_launch: occupancy query reports %d\n", per_cu);
        (void)hipGetLastError();
        grid = cus;
    }
    if (grid < 0) return;
    (void)hipMemsetAsync((char*)d_ws + WS_CTL, 0, CTL_BYTES, stream);
    Args a{};
    for (int i = 0; i < 29; ++i) a.in[i] = (const float*)d_in[i];
    a.out = (float*)d_out; a.ws = (unsigned char*)d_ws;
#if MK_PER_PHASE
    for (int p = 0; p < NPHASE; ++p) { a.ph_lo = p; a.ph_hi = p + 1; hipLaunchKernelGGL(fwd, dim3(grid), dim3(512), LDS_BYTES, stream, a); }
#else
    a.ph_lo = 0; a.ph_hi = NPHASE; hipLaunchKernelGGL(fwd, dim3(grid), dim3(512), LDS_BYTES, stream, a);
#endif
}
```

```cpp
#include <hip/hip_runtime.h>
#include <cstdio>
#include <cstdint>

#ifndef MK_PER_PHASE
#define MK_PER_PHASE 0
#endif

#ifndef PROBE_REPEAT
#define PROBE_REPEAT 0
#endif
#ifndef PHMASK
#define PHMASK 0xFFFF
#endif
#define PHON(i) (((PHMASK) >> (i)) & 1)
#define LAS __attribute__((address_space(3)))
#define GAS __attribute__((address_space(1)))
typedef unsigned short bf16;
typedef short bf16x8 __attribute__((ext_vector_type(8)));
typedef short s16x4 __attribute__((ext_vector_type(4)));
typedef float f32x2 __attribute__((ext_vector_type(2)));
typedef float f32x4 __attribute__((ext_vector_type(4)));
typedef float f32x16 __attribute__((ext_vector_type(16)));
typedef unsigned u32x2 __attribute__((ext_vector_type(2)));
typedef unsigned u32x4 __attribute__((ext_vector_type(4)));
typedef __bf16 bf16x2_t __attribute__((ext_vector_type(2)));
typedef short v4i16_t __attribute__((ext_vector_type(4)));

constexpr int T = 32768, S = 8192, NB = 4, DM = 1024, NLAYER = 2;
constexpr int IN_W = 6328;
constexpr int PW = 3328;
constexpr int PC_NQ = 0, PC_KC = 512, PC_VC = 640, PC_KS = 768, PC_VS = 896, PC_KW = 1024, PC_VW = 1152, PC_DQ = 1280, PC_DK = 1792, PC_DV = 2304,
              PC_CQ = 2816, PC_CKV = 3072, PC_KR = 3200, PC_NG = 3232;
constexpr float LOG2E = 1.4426950408889634f;
constexpr float ALPHA = 1.4142135623730951f;
constexpr int NEXP = 16, CAP = 32768, DFF = 512;

constexpr size_t MiB = 1u << 20;
constexpr size_t WS_CTL = 0, CTL_BYTES = 1 * MiB;
constexpr size_t WS_CS = 1 * MiB;
constexpr size_t WS_MISC = 2 * MiB;
constexpr size_t WS_RSQ = 3 * MiB;
constexpr size_t WS_RSKV = WS_RSQ + 256 * 1024;
constexpr size_t WS_RTE = 4 * MiB;
constexpr size_t WS_RTP = WS_RTE + 512 * 1024;
constexpr size_t WS_RTG = WS_RTP + 512 * 1024;
constexpr size_t WS_ROWIDX = 6 * MiB;
constexpr size_t WS_KCMP = 8 * MiB;
constexpr size_t WS_VCMP = WS_KCMP + 512 * 1024;
constexpr size_t WS_UL = 10 * MiB;
constexpr size_t WS_WTS = 32 * MiB;
constexpr size_t WL_WIN = 0, WL_WG = 7 * MiB, WL_WBR = 13 * MiB, WL_WOUT = 16 * MiB, WL_WUQ = 18 * MiB, WL_WUKV = 18 * MiB + 512 * 1024, WL_WC1 = 19 * MiB, WL_STRIDE = 22 * MiB;
constexpr size_t WS_HB = 76 * MiB;
constexpr size_t WS_P = 140 * MiB;
constexpr size_t WS_HS = WS_P + 136 * MiB;
constexpr size_t WS_GS = 348 * MiB;
constexpr size_t WS_END = 444 * MiB;
constexpr size_t DO_QM = 0, DO_KVM = 48 * MiB, DO_W13 = 0, DO_W2 = 32 * MiB;

constexpr int CW_BAR = 4096;
constexpr int CW_CNT = 16384;

constexpr int LDS_RING = 131072, LDS_MISC = 131072, LDS_BYTES = 147456;
constexpr int NPHASE = 1 + 11 * NLAYER;

__device__ __forceinline__ int lane_id_v() { int l; asm volatile("v_mbcnt_lo_u32_b32 %0, -1, 0\n\tv_mbcnt_hi_u32_b32 %0, -1, %0" : "=v"(l)); return l; }
__device__ __forceinline__ unsigned f2bf(float f) { unsigned u = __builtin_bit_cast(unsigned, f); return (u + 0x7fffu + ((u >> 16) & 1u)) >> 16; }
__device__ __forceinline__ unsigned pk2(float lo, float hi) { f32x2 v = {lo, hi}; bf16x2_t b = __builtin_convertvector(v, bf16x2_t); return __builtin_bit_cast(unsigned, b); }
__device__ __forceinline__ float bflo(unsigned w) { return __uint_as_float(w << 16); }
__device__ __forceinline__ float bfhi(unsigned w) { return __uint_as_float(w & 0xffff0000u); }
__device__ __forceinline__ float bf2f(bf16 v) { return __uint_as_float(((unsigned)v) << 16); }
__device__ __forceinline__ float fexp2(float x) { return __builtin_amdgcn_exp2f(x); }
__device__ __forceinline__ float sigmoidf_(float x) { return 1.0f / (1.0f + __expf(-x)); }
__device__ __forceinline__ float wave_sum(float v) {
#pragma unroll
    for (int o = 1; o < 64; o <<= 1) v += __shfl_xor(v, o);
    return v;
}
__device__ __forceinline__ float hmax(float v) { auto rr = __builtin_amdgcn_permlane32_swap(__float_as_uint(v), __float_as_uint(v), false, false); return fmaxf(__uint_as_float(rr[0]), __uint_as_float(rr[1])); }
__device__ __forceinline__ float hsum(float v) { auto rr = __builtin_amdgcn_permlane32_swap(__float_as_uint(v), __float_as_uint(v), false, false); return __uint_as_float(rr[0]) + __uint_as_float(rr[1]); }

#define XB_TMO      128
#define XB_XCNT(j)  (256  + 64 * (j))
#define XB_XSUB(j)  (1280 + 64 * (j))
#define XB_XGEN(j)  (2304 + 64 * (j))
#define XB_TOP      3328
#define XB_TOPGEN   3392
#define XCD_BAR_WORDS 3456
#define XB_SPIN_CAP (1u << 23)
__device__ __forceinline__ unsigned xb_ld(unsigned* p)              { return __hip_atomic_load(p, __ATOMIC_RELAXED, __HIP_MEMORY_SCOPE_AGENT); }
__device__ __forceinline__ unsigned xb_add(unsigned* p, unsigned v) { return __hip_atomic_fetch_add(p, v, __ATOMIC_RELAXED, __HIP_MEMORY_SCOPE_AGENT); }
__device__ __forceinline__ unsigned xb_xcc_id() { return (unsigned)__builtin_amdgcn_s_getreg((3 << 11) | 20) & 0xFu; }
#define XB_SPIN(cond, bar) do { unsigned _sp = 0; while (cond) { __builtin_amdgcn_s_sleep(1); \
    if ((++_sp & 255u) == 0u) { if (xb_ld(&(bar)[XB_TMO])) break; if (_sp > XB_SPIN_CAP) { atomicAdd(&(bar)[XB_TMO], 1u); break; } } } } while (0)
struct XcdBarrier { unsigned* bar; unsigned x; volatile LAS unsigned* st; };
__device__ __forceinline__ XcdBarrier xcd_barrier_post(unsigned* bar, volatile LAS unsigned* st) {
    XcdBarrier b; b.bar = bar; b.x = xb_xcc_id(); b.st = st;
    if (threadIdx.x == 0) (void)xb_add(&bar[XB_XCNT(b.x)], 1u);
    return b;
}
__device__ __forceinline__ void xcd_barrier_complete(unsigned* bar, unsigned x, unsigned& nloc, unsigned& nx) {
    const unsigned G = gridDim.x * gridDim.y * gridDim.z;
    unsigned sum, cnt, mine, sp = 0u;
    for (;;) {
        sum = 0u; cnt = 0u; mine = 0u;
#pragma unroll
        for (unsigned j = 0; j < 16; ++j) { const unsigned c = xb_ld(&bar[XB_XCNT(j)]); sum += c; cnt += (c > 0u) ? 1u : 0u; mine = (j == x) ? c : mine; }
        if (sum == G) break;
        __builtin_amdgcn_s_sleep(1);
        if ((++sp & 255u) == 0u) { if (xb_ld(&bar[XB_TMO])) break; if (sp > XB_SPIN_CAP) { atomicAdd(&bar[XB_TMO], 1u); break; } }
    }
    nloc = mine > 0u ? mine : 1u; nx = cnt > 0u ? cnt : 1u;
}
__device__ __forceinline__ void xcd_barrier(const XcdBarrier& b) {
    asm volatile("s_waitcnt vmcnt(0)" ::: "memory");
    __syncthreads();
    if (threadIdx.x == 0) {
        unsigned* bar = b.bar;
        __builtin_amdgcn_s_waitcnt(0);
        unsigned nloc = b.st[0], nx = b.st[1];
        if (nloc == 0u) { xcd_barrier_complete(bar, b.x, nloc, nx); b.st[0] = nloc; b.st[1] = nx; }
        const unsigned old = xb_add(&bar[XB_XSUB(b.x)], 1u);
        const unsigned gen = old / nloc;
        if (old + 1u == (gen + 1u) * nloc) {
            __builtin_amdgcn_fence(__ATOMIC_RELEASE, "agent");
            asm volatile("s_waitcnt vmcnt(0)" ::: "memory");
            const unsigned og = xb_add(&bar[XB_TOP], 1u);
            const unsigned tg = og / nx;
            if (og + 1u == (tg + 1u) * nx) xb_add(&bar[XB_TOPGEN], 1u);
            else XB_SPIN(xb_ld(&bar[XB_TOPGEN]) == tg, bar);
            __builtin_amdgcn_fence(__ATOMIC_ACQUIRE, "agent");
            xb_add(&bar[XB_XGEN(b.x)], 1u);
            asm volatile("s_waitcnt vmcnt(0)" ::: "memory");
        } else {
            XB_SPIN(xb_ld(&bar[XB_XGEN(b.x)]) == gen, bar);
            __builtin_amdgcn_fence(__ATOMIC_ACQUIRE, "agent");
            asm volatile("s_waitcnt vmcnt(0)" ::: "memory");
        }
    }
    __syncthreads();
}

namespace pg8 {
constexpr int BM = 256, BK = 64, HALF = 128, HTB = HALF * BK * 2, STAGE_BYTES = 8 * HTB;
__device__ __forceinline__ int lds_byte(int r, int c) { const int st = (r >> 4) * 2 + (c >> 5), rr = r & 15, cc = c & 31, ob = rr * 64 + cc * 2; return st * 1024 + (ob ^ (((ob >> 9) & 1) << 5)); }
__device__ __forceinline__ void stage_rc(int b, int& R, int& C) { const int st = b / 1024, sb = b % 1024, swz = sb ^ (((sb >> 9) & 1) << 5); R = (st >> 1) * 16 + swz / 64; C = (st & 1) * 32 + (swz % 64) / 2; }
__device__ __forceinline__ int perm32(int rho) { const int n = rho >> 4, i = rho & 15; return 8 * (i >> 2) + 4 * n + (i & 3); }
struct Unit { int pm, pn, e; };
__device__ __forceinline__ void glds16_s(const void* sbase, unsigned voff, unsigned lds_dst) { unsigned keep;
    asm volatile("s_mov_b32 %0, m0\n\ts_mov_b32 m0, %3\n\ts_nop 0\n\tglobal_load_lds_dwordx4 %1, %2\n\ts_mov_b32 m0, %0" : "=&s"(keep) : "v"(voff), "s"(sbase), "s"(lds_dst) : "memory"); }
template <class Epi, class Sched, bool ALIGN_EPI>
__device__ __forceinline__ void gemm_phase(LAS unsigned char* lds, const int wid_in, const int K, const unsigned kstepA, const Sched& S, const Epi& E) {
    const int wid = wid_in, lane = lane_id_v(), tid = wid * 64 + lane, wr = wid >> 2, wc = wid & 3, fr = lane & 15, fq = lane >> 4;
    const int nt = K / BK;
    int Rr[2], Cc[2]; unsigned voffB[2];
#pragma unroll
    for (int i = 0; i < 2; ++i) { int R, C; stage_rc(tid * 16 + i * 8192, R, C); Rr[i] = R; Cc[i] = C; const int Rb = (R & ~31) + perm32(R & 31); voffB[i] = (unsigned)(Rb * K + C) * 2u; }
    const size_t kstepB = (size_t)(BK * 2);
    const size_t hstepB = (size_t)HALF * K * 2;
    const unsigned ldsb = (unsigned)(uintptr_t)lds + (unsigned)wid * 1024u;
    const int aoff = lds_byte(wr * 64 + fr, fq * 8), boff = lds_byte(wc * 32 + fr, fq * 8);
#define PG8_SA(b, h) (((b) * 2 + (h)) * HTB)
#define PG8_SB(b, h) ((4 + (b) * 2 + (h)) * HTB)
#define PG8_STAGE(bufoff, gbase, voff) do { _Pragma("unroll") for (int _i = 0; _i < 2; ++_i) \
        glds16_s((const void*)(gbase), (voff)[_i], ldsb + (unsigned)((bufoff) + _i * 8192)); } while (0)
#define PG8_LDA(dst, b, h) do { _Pragma("unroll") for (int m = 0; m < 4; ++m) _Pragma("unroll") for (int k = 0; k < 2; ++k) dst[m][k] = *(const LAS bf16x8*)(lds + PG8_SA(b, h) + aoff + m * 2048 + k * 1024); } while (0)
#define PG8_LDB(dst, b, h) do { _Pragma("unroll") for (int n = 0; n < 2; ++n) _Pragma("unroll") for (int k = 0; k < 2; ++k) dst[n][k] = *(const LAS bf16x8*)(lds + PG8_SB(b, h) + boff + n * 2048 + k * 1024); } while (0)
#define PG8_MMA(ai, bj, At, Bt) do { __builtin_amdgcn_s_setprio(1); _Pragma("unroll") for (int m = 0; m < 4; ++m) _Pragma("unroll") for (int n = 0; n < 2; ++n) _Pragma("unroll") for (int k = 0; k < 2; ++k) \
        acc[ai][bj][m][n] = __builtin_amdgcn_mfma_f32_16x16x32_bf16(Bt[n][k], At[m][k], acc[ai][bj][m][n], 0, 0, 0); __builtin_amdgcn_s_setprio(0); } while (0)
#define PG8_WAIT_V(n) asm volatile("s_waitcnt vmcnt(" #n ")" ::: "memory")
#define PG8_WAIT_L(n) asm volatile("s_waitcnt lgkmcnt(" #n ")" ::: "memory")
#define PG8_BAR __builtin_amdgcn_s_barrier()
#define PG8_SCHED __builtin_amdgcn_sched_barrier(0)
    Unit cur, nxt; int ui = 0;
    if (!S.next(0, cur)) return;
    f32x4 acc[2][2][4][2];
#pragma unroll
    for (int a = 0; a < 2; ++a)
#pragma unroll
        for (int b = 0; b < 2; ++b)
#pragma unroll
            for (int m = 0; m < 4; ++m)
#pragma unroll
                for (int n = 0; n < 2; ++n) acc[a][b][m][n] = (f32x4){0.f, 0.f, 0.f, 0.f};
    bf16x8 At[4][2], B0[2][2], B1[2][2];
    const char* cA; const char* cB; unsigned vc[2][2], vn[2][2];
    S.ptrs(cur, cA, cB); S.aoff(cur, Rr, Cc, vc);
    unsigned ksA = kstepA, ksN = kstepA;
    if constexpr (Sched::VAR_KSTEP) { ksA = S.kstep(cur); ksN = ksA; }
    PG8_STAGE(PG8_SB(0, 0), cB, voffB); PG8_STAGE(PG8_SB(0, 1), cB + hstepB, voffB); PG8_STAGE(PG8_SA(0, 0), cA, vc[0]); PG8_STAGE(PG8_SA(0, 1), cA, vc[1]);
    if (wr == 1) PG8_BAR;
    PG8_WAIT_V(2); PG8_BAR;
    PG8_STAGE(PG8_SB(1, 0), cB + kstepB, voffB); PG8_STAGE(PG8_SA(1, 0), cA + ksA, vc[0]); PG8_STAGE(PG8_SB(1, 1), cB + hstepB + kstepB, voffB);
    PG8_WAIT_V(6); PG8_BAR;
    for (;;) {
        const bool has_next = S.next(ui + 1, nxt);
        const char* nA = cA; const char* nB = cB;
        if (has_next) { S.ptrs(nxt, nA, nB); if constexpr (Sched::PER_UNIT_AOFF && !Sched::AOFF_CHEAP) S.aoff(nxt, Rr, Cc, vn); if constexpr (Sched::VAR_KSTEP) ksN = S.kstep(nxt); }
        else if constexpr (Sched::PER_UNIT_AOFF) {
            if constexpr (Sched::AOFF_CHEAP) nxt = cur;
#pragma unroll
            for (int h = 0; h < 2; ++h)
#pragma unroll
                for (int i = 0; i < 2; ++i) vn[h][i] = vc[h][i];
        }
        for (int t = 0; t < nt; t += 2) {
            const bool last = (t == nt - 2);
            const char* a1 = cA + (size_t)(t + 1) * ksA;
            const char* a2 = last ? nA : cA + (size_t)(t + 2) * ksA; const char* b2 = last ? nB : cB + (size_t)(t + 2) * kstepB;
            const char* a3 = a2 + (last ? ksN : ksA); const char* b3 = b2 + kstepB;
#define PG8_STAGE_A2(bufoff, gbase, h) do { if constexpr (Sched::PER_UNIT_AOFF) { if (last) { if constexpr (Sched::AOFF_CHEAP) { unsigned vt_[2][2]; S.aoff(nxt, Rr, Cc, vt_); PG8_STAGE(bufoff, gbase, vt_[h]); } else PG8_STAGE(bufoff, gbase, vn[h]); } else PG8_STAGE(bufoff, gbase, vc[h]); } else PG8_STAGE(bufoff, gbase, vc[h]); } while (0)
            PG8_LDB(B0, 0, 0); PG8_LDB(B1, 0, 1); PG8_SCHED; PG8_LDA(At, 0, 0); PG8_STAGE(PG8_SA(1, 1), a1, vc[1]);
            PG8_WAIT_V(8); PG8_WAIT_L(0); PG8_BAR; PG8_MMA(0, 0, At, B0); PG8_MMA(0, 1, At, B1); PG8_BAR; PG8_SCHED;
            PG8_LDA(At, 0, 1); PG8_STAGE(PG8_SB(0, 0), b2, voffB); PG8_STAGE(PG8_SB(0, 1), b2 + hstepB, voffB); PG8_STAGE_A2(PG8_SA(0, 0), a2, 0);
            PG8_WAIT_V(8); PG8_WAIT_L(0); PG8_BAR; PG8_MMA(1, 0, At, B0); PG8_MMA(1, 1, At, B1); PG8_BAR; PG8_SCHED;
            PG8_LDB(B0, 1, 0); PG8_LDB(B1, 1, 1); PG8_SCHED; PG8_LDA(At, 1, 0); PG8_STAGE_A2(PG8_SA(0, 1), a2, 1);
            PG8_WAIT_V(8); PG8_WAIT_L(0); PG8_BAR; PG8_MMA(0, 0, At, B0); PG8_MMA(0, 1, At, B1); PG8_BAR; PG8_SCHED;
            PG8_LDA(At, 1, 1); PG8_STAGE(PG8_SB(1, 0), b3, voffB); PG8_STAGE(PG8_SB(1, 1), b3 + hstepB, voffB); PG8_STAGE_A2(PG8_SA(1, 0), a3, 0);
            PG8_WAIT_V(8); PG8_WAIT_L(0); PG8_BAR; PG8_MMA(1, 0, At, B0); PG8_MMA(1, 1, At, B1); PG8_BAR; PG8_SCHED;
        }
        if constexpr (ALIGN_EPI) { if (wr == 0) PG8_BAR; }
        E(acc, cur, wr, wc, fr, fq);
        if (!has_next) break;
        bool keep = false; if constexpr (Epi::CHAIN) keep = E.keep(cur);
        if (!keep) {
#pragma unroll
        for (int a = 0; a < 2; ++a)
#pragma unroll
            for (int b = 0; b < 2; ++b)
#pragma unroll
                for (int m = 0; m < 4; ++m)
#pragma unroll
                    for (int n = 0; n < 2; ++n) acc[a][b][m][n] = (f32x4){0.f, 0.f, 0.f, 0.f};
        }
        cur = nxt; cA = nA; cB = nB; ++ui; ksA = ksN;
        if constexpr (Sched::PER_UNIT_AOFF) {
            if constexpr (Sched::AOFF_CHEAP) S.aoff(cur, Rr, Cc, vc);
            else {
#pragma unroll
            for (int h = 0; h < 2; ++h)
#pragma unroll
                for (int i = 0; i < 2; ++i) vc[h][i] = vn[h][i];
            }
        }
        if constexpr (ALIGN_EPI) { if (wr == 1) PG8_BAR; }
    }
    PG8_WAIT_V(0);
    if constexpr (!ALIGN_EPI) { if (wr == 0) PG8_BAR; }
    PG8_BAR;
#undef PG8_SA
#undef PG8_SB
#undef PG8_STAGE
#undef PG8_STAGE_A2
#undef PG8_LDA
#undef PG8_LDB
#undef PG8_MMA
#undef PG8_WAIT_V
#undef PG8_WAIT_L
#undef PG8_BAR
#undef PG8_SCHED
}

struct TileSched {
    static constexpr bool AOFF_CHEAP = false;
    static constexpr bool VAR_KSTEP = false;
    static constexpr bool PER_UNIT_AOFF = false;
    const char* A; const char* Bt; int lda; int K; int nN; int ntot; int G; int v;
    __device__ __forceinline__ bool next(int i, Unit& u) const { const int L = i * G + v; if (L >= ntot) return false; u.pm = L / nN; u.pn = L % nN; u.e = i; return true; }
    __device__ __forceinline__ void ptrs(const Unit& u, const char*& cA, const char*& cB) const { cA = A + (size_t)u.pm * 256 * lda; cB = Bt + (size_t)u.pn * 256 * K * 2; }
    __device__ __forceinline__ void aoff(const Unit&, const int (&R)[2], const int (&C)[2], unsigned (&vo)[2][2]) const {
#pragma unroll
        for (int h = 0; h < 2; ++h)
#pragma unroll
            for (int i = 0; i < 2; ++i) vo[h][i] = (unsigned)((h * 128 + R[i]) * lda + C[i] * 2);
    }
};
struct CmpSched {
    static constexpr bool AOFF_CHEAP = false;
    static constexpr bool VAR_KSTEP = false;
    static constexpr bool PER_UNIT_AOFF = false;
    const char* P; const char* W; int G; int v;
    __device__ __forceinline__ bool next(int i, Unit& u) const { const int L = i * G + v; if (L >= 64) return false; u.pm = (L >> 1) & 1; u.pn = L & 1; u.e = L >> 2; return true; }
    __device__ __forceinline__ void ptrs(const Unit& u, const char*& cA, const char*& cB) const {
        const int kv = u.e >> 3, b = (u.e >> 1) & 3, g = u.e & 1;
        cA = P + ((size_t)(b * S + u.pm * 4096) * PW + PC_KC + kv * 128 + g * 64) * 2; cB = W + (size_t)kv * (512 * 1024 * 2) + (size_t)u.pn * 256 * 2048; }
    __device__ __forceinline__ void aoff(const Unit&, const int (&R)[2], const int (&C)[2], unsigned (&vo)[2][2]) const {
#pragma unroll
        for (int h = 0; h < 2; ++h)
#pragma unroll
            for (int i = 0; i < 2; ++i) vo[h][i] = (unsigned)((h * 128 + R[i]) * (16 * PW * 2) + C[i] * 2);
    }
};
struct MoeSched {
    static constexpr bool VAR_KSTEP = false, AOFF_CHEAP = false;
    static constexpr bool PER_UNIT_AOFF = true;
    const char* A; const char* W; const int* rowidx; const volatile LAS int* TP; const volatile LAS int* CNT; int lda; int K; size_t wstride; bool gather; int G; int v;
    __device__ __forceinline__ bool next(int i, Unit& u) const {
        const int L = i * G + v; const int rt = L >> 2; if (rt >= __builtin_amdgcn_readfirstlane(TP[16])) return false;
        int e = 0;
#pragma unroll
        for (int j = 1; j < 16; ++j) e += (rt >= TP[j]) ? 1 : 0;
        u.pm = rt; u.pn = L & 3; u.e = __builtin_amdgcn_readfirstlane(e); return true; }
    __device__ __forceinline__ void ptrs(const Unit& u, const char*& cA, const char*& cB) const {
        cA = gather ? A : A + (size_t)u.pm * 256 * lda; cB = W + (size_t)u.e * wstride + (size_t)u.pn * 256 * K * 2; }
    __device__ __forceinline__ void aoff(const Unit& u, const int (&R)[2], const int (&C)[2], unsigned (&vo)[2][2]) const {
        if (gather) {
            const int r0 = (u.pm - __builtin_amdgcn_readfirstlane(TP[u.e])) * 256, cnt = __builtin_amdgcn_readfirstlane(CNT[u.e]);
#pragma unroll
            for (int h = 0; h < 2; ++h)
#pragma unroll
                for (int i = 0; i < 2; ++i) { int r = r0 + h * 128 + R[i]; r = r < cnt ? r : 0; const int tok = rowidx[u.e * CAP + r]; vo[h][i] = (unsigned)(tok * lda + C[i] * 2); }
        } else {
#pragma unroll
            for (int h = 0; h < 2; ++h)
#pragma unroll
                for (int i = 0; i < 2; ++i) vo[h][i] = (unsigned)((h * 128 + R[i]) * lda + C[i] * 2);
        }
    }
};

struct EpiStore {
    static constexpr bool CHAIN = false;
    bf16* O; int ldc; const float* rscale; size_t estride; bool remap160;
    __device__ __forceinline__ void operator()(const f32x4 (&acc)[2][2][4][2], const Unit& u, int wr, int wc, int fr, int fq) const {
        bf16* base = O + (estride ? (size_t)u.e * estride : (size_t)0);
        const int row0 = u.pm * 256 + wr * 64 + fr; int col0 = u.pn * 256 + wc * 32 + 8 * fq; int bjs = 128;
        if (remap160) { const int cm = col0 & 127; col0 = (col0 >> 7) * 160 + (cm < 64 ? cm : cm + 32); bjs = 160; }
#pragma unroll
        for (int ai = 0; ai < 2; ++ai)
#pragma unroll
            for (int m = 0; m < 4; ++m) { const int row = row0 + ai * 128 + m * 16; const float sc = rscale ? rscale[row] : 1.f; bf16* rowp = base + (size_t)row * ldc + col0;
#pragma unroll
                for (int bj = 0; bj < 2; ++bj) { const f32x4 v0 = acc[ai][bj][m][0] * sc, v1 = acc[ai][bj][m][1] * sc;
                    u32x4 w; w.x = pk2(v0[0], v0[1]); w.y = pk2(v0[2], v0[3]); w.z = pk2(v1[0], v1[1]); w.w = pk2(v1[2], v1[3]);
                    *(u32x4*)(rowp + bj * bjs) = w; } }
    }
};
struct EpiRope {
    static constexpr bool CHAIN = false;
    bf16* O; const float* CS;
    __device__ __forceinline__ void operator()(const f32x4 (&acc)[2][2][4][2], const Unit& u, int wr, int wc, int fr, int fq) const {
        const int row0 = u.pm * 256 + wr * 64 + fr, col0 = u.pn * 256 + wc * 32 + 8 * fq;
        int i0v[2]; bool rp[2];
#pragma unroll
        for (int bj = 0; bj < 2; ++bj) { const int cm = (col0 + bj * 128) % 96; rp[bj] = cm >= 64; i0v[bj] = rp[bj] ? (cm - 64) >> 1 : 0; }
#pragma unroll
        for (int ai = 0; ai < 2; ++ai)
#pragma unroll
            for (int m = 0; m < 4; ++m) {
                f32x4 ca[2], cb[2];
                const int row = row0 + ai * 128 + m * 16; const int pos = row & (S - 1);
#pragma unroll
                for (int bj = 0; bj < 2; ++bj) { const f32x4* cs = (const f32x4*)(CS + ((size_t)pos * 16 + i0v[bj]) * 2); ca[bj] = cs[0]; cb[bj] = cs[1]; }
                bf16* rowp = O + (size_t)row * 768 + col0;
#pragma unroll
                for (int bj = 0; bj < 2; ++bj) { f32x4 v[2] = {acc[ai][bj][m][0], acc[ai][bj][m][1]};
                    if (rp[bj]) {
                        const f32x4 a = ca[bj], b = cb[bj];
                        f32x4 r0, r1;
                        r0[0] = v[0][0] * a[0] - v[0][1] * a[1]; r0[1] = v[0][0] * a[1] + v[0][1] * a[0];
                        r0[2] = v[0][2] * a[2] - v[0][3] * a[3]; r0[3] = v[0][2] * a[3] + v[0][3] * a[2];
                        r1[0] = v[1][0] * b[0] - v[1][1] * b[1]; r1[1] = v[1][0] * b[1] + v[1][1] * b[0];
                        r1[2] = v[1][2] * b[2] - v[1][3] * b[3]; r1[3] = v[1][2] * b[3] + v[1][3] * b[2];
                        v[0] = r0; v[1] = r1; }
                    u32x4 w; w.x = pk2(v[0][0], v[0][1]); w.y = pk2(v[0][2], v[0][3]); w.z = pk2(v[1][0], v[1][1]); w.w = pk2(v[1][2], v[1][3]);
                    *(u32x4*)(rowp + bj * 128) = w; }
                asm volatile("" ::: "memory");
            }
    }
};
struct EpiGate {
    static constexpr bool CHAIN = false;
    bf16* GS;
    __device__ __forceinline__ void operator()(const f32x4 (&acc)[2][2][4][2], const Unit& u, int wr, int wc, int fr, int fq) const {
        bf16* base = GS + (size_t)u.e * 65536; const int row0 = wr * 64 + fr, col0 = wc * 32 + 8 * fq;
#pragma unroll
        for (int ai = 0; ai < 2; ++ai)
#pragma unroll
            for (int m = 0; m < 4; ++m) { bf16* rowp = base + (row0 + ai * 128 + m * 16) * 256 + col0;
#pragma unroll
                for (int bj = 0; bj < 2; ++bj) { const f32x4 v0 = acc[ai][bj][m][0], v1 = acc[ai][bj][m][1];
#define SG_(x) fmaxf(sigmoidf_(x), 1.0e-30f)
                    u32x4 w; w.x = pk2(SG_(v0[0]), SG_(v0[1])); w.y = pk2(SG_(v0[2]), SG_(v0[3])); w.z = pk2(SG_(v1[0]), SG_(v1[1])); w.w = pk2(SG_(v1[2]), SG_(v1[3]));
#undef SG_
                    *(u32x4*)(rowp + bj * 128) = w; } }
    }
};
struct EpiBranch {
    static constexpr bool CHAIN = false;
    bf16* Y; const bf16* GS; bool first;
    __device__ __forceinline__ void operator()(const f32x4 (&acc)[2][2][4][2], const Unit& u, int wr, int wc, int fr, int fq) const {
        const bf16* gbase = GS + (size_t)u.e * 65536; const int lrow0 = wr * 64 + fr, lcol0 = wc * 32 + 8 * fq;
#pragma unroll
        for (int ai = 0; ai < 2; ++ai)
#pragma unroll
            for (int mp = 0; mp < 2; ++mp) {
                u32x4 gwv[2][2], yov[2][2];
#pragma unroll
                for (int mm = 0; mm < 2; ++mm)
#pragma unroll
                    for (int bj = 0; bj < 2; ++bj) { const int lrow = lrow0 + ai * 128 + (2 * mp + mm) * 16;
                        gwv[mm][bj] = *(const u32x4*)(gbase + lrow * 256 + lcol0 + bj * 128);
                        if (!first) yov[mm][bj] = *(const u32x4*)(Y + (size_t)(u.pm * 256 + lrow) * DM + u.pn * 256 + lcol0 + bj * 128); }
#pragma unroll
                for (int mm = 0; mm < 2; ++mm) { const int m = 2 * mp + mm; const int lrow = lrow0 + ai * 128 + m * 16; bf16* yrow = Y + (size_t)(u.pm * 256 + lrow) * DM + u.pn * 256 + lcol0;
#pragma unroll
                    for (int bj = 0; bj < 2; ++bj) { const f32x4 v0 = acc[ai][bj][m][0], v1 = acc[ai][bj][m][1]; const u32x4 gw = gwv[mm][bj];
                        float r[8] = {v0[0] * bflo(gw.x), v0[1] * bfhi(gw.x), v0[2] * bflo(gw.y), v0[3] * bfhi(gw.y), v1[0] * bflo(gw.z), v1[1] * bfhi(gw.z), v1[2] * bflo(gw.w), v1[3] * bfhi(gw.w)};
                        if (!first) { const u32x4 yo = yov[mm][bj];
                            r[0] += bflo(yo.x); r[1] += bfhi(yo.x); r[2] += bflo(yo.y); r[3] += bfhi(yo.y); r[4] += bflo(yo.z); r[5] += bfhi(yo.z); r[6] += bflo(yo.w); r[7] += bfhi(yo.w); }
                        u32x4 w; w.x = pk2(r[0], r[1]); w.y = pk2(r[2], r[3]); w.z = pk2(r[4], r[5]); w.w = pk2(r[6], r[7]);
                        *(u32x4*)(yrow + bj * 128) = w; } }
            }
    }
};
struct EpiResid {
    static constexpr bool CHAIN = false;
    bf16* Z; const bf16* H;
    __device__ __forceinline__ void operator()(const f32x4 (&acc)[2][2][4][2], const Unit& u, int wr, int wc, int fr, int fq) const {
        const int row0 = u.pm * 256 + wr * 64 + fr, col0 = u.pn * 256 + wc * 32 + 8 * fq;
#pragma unroll
        for (int ai = 0; ai < 2; ++ai) {
            u32x4 hv[4][2];
#pragma unroll
            for (int m = 0; m < 4; ++m)
#pragma unroll
                for (int bj = 0; bj < 2; ++bj) hv[m][bj] = *(const u32x4*)(H + (size_t)(row0 + ai * 128 + m * 16) * DM + col0 + bj * 128);
#pragma unroll
            for (int m = 0; m < 4; ++m) { const size_t off = (size_t)(row0 + ai * 128 + m * 16) * DM + col0;
#pragma unroll
                for (int bj = 0; bj < 2; ++bj) { const u32x4 hw = hv[m][bj];
                    const f32x4 o0 = acc[ai][bj][m][0], o1 = acc[ai][bj][m][1];
                    u32x4 w; w.x = pk2(o0[0] + ALPHA * bflo(hw.x), o0[1] + ALPHA * bfhi(hw.x)); w.y = pk2(o0[2] + ALPHA * bflo(hw.y), o0[3] + ALPHA * bfhi(hw.y));
                    w.z = pk2(o1[0] + ALPHA * bflo(hw.z), o1[1] + ALPHA * bfhi(hw.z)); w.w = pk2(o1[2] + ALPHA * bflo(hw.w), o1[3] + ALPHA * bfhi(hw.w));
                    *(u32x4*)(Z + off + bj * 128) = w; } }
        }
    }
};
struct EpiSwiglu {
    static constexpr bool CHAIN = false;
    bf16* HS;
    __device__ __forceinline__ void operator()(const f32x4 (&acc)[2][2][4][2], const Unit& u, int wr, int wc, int fr, int fq) const {
        const int row0 = u.pm * 256 + wr * 64 + fr, col0 = u.pn * 128 + wc * 32 + 8 * fq;
#pragma unroll
        for (int ai = 0; ai < 2; ++ai)
#pragma unroll
            for (int m = 0; m < 4; ++m) { bf16* rowp = HS + (size_t)(row0 + ai * 128 + m * 16) * DFF + col0;
                float r[8];
#pragma unroll
                for (int n = 0; n < 2; ++n)
#pragma unroll
                    for (int q = 0; q < 4; ++q) { const float a = acc[ai][0][m][n][q], b = acc[ai][1][m][n][q]; r[n * 4 + q] = a * sigmoidf_(a) * b; }
                u32x4 w; w.x = pk2(r[0], r[1]); w.y = pk2(r[2], r[3]); w.z = pk2(r[4], r[5]); w.w = pk2(r[6], r[7]);
                *(u32x4*)rowp = w; }
    }
};

struct GateSched {
    static constexpr bool AOFF_CHEAP = false;
    static constexpr bool PER_UNIT_AOFF = false, VAR_KSTEP = false;
    const char* A; const char* Wg; int pm, pn; bool valid;
    __device__ __forceinline__ bool next(int i, Unit& u) const { if (!valid || i >= 3) return false; u.pm = pm; u.pn = pn; u.e = i; return true; }
    __device__ __forceinline__ void ptrs(const Unit& u, const char*& cA, const char*& cB) const { cA = A + (size_t)pm * 256 * 2048; cB = Wg + ((size_t)u.e * 1024 + (size_t)pn * 256) * 2048; }
    __device__ __forceinline__ void aoff(const Unit&, const int (&R)[2], const int (&C)[2], unsigned (&vo)[2][2]) const {
#pragma unroll
        for (int h = 0; h < 2; ++h)
#pragma unroll
            for (int i = 0; i < 2; ++i) vo[h][i] = (unsigned)((h * 128 + R[i]) * 2048 + C[i] * 2);
    }
};
struct ChainSched {
    static constexpr bool AOFF_CHEAP = true;
    static constexpr bool PER_UNIT_AOFF = true, VAR_KSTEP = true;
    const char* Pn; const char* Pd; const char* Qm; const char* Wbr; int pm, pn; bool valid;
    __device__ __forceinline__ bool next(int i, Unit& u) const { if (!valid || i >= 3) return false; u.pm = pm; u.pn = pn; u.e = i; return true; }
    __device__ __forceinline__ int lda(const Unit& u) const { return u.e == 2 ? 1536 : PW * 2; }
    __device__ __forceinline__ unsigned kstep(const Unit& u) const { return u.e == 2 ? 192u : 128u; }
    __device__ __forceinline__ void ptrs(const Unit& u, const char*& cA, const char*& cB) const {
        cA = (u.e == 0 ? Pn : (u.e == 1 ? Pd : Qm)) + (size_t)pm * 256 * lda(u); cB = Wbr + (size_t)u.e * (1024 * 512 * 2) + (size_t)pn * 256 * 1024; }
    __device__ __forceinline__ void aoff(const Unit& u, const int (&R)[2], const int (&C)[2], unsigned (&vo)[2][2]) const { const int ld = lda(u);
#pragma unroll
        for (int h = 0; h < 2; ++h)
#pragma unroll
            for (int i = 0; i < 2; ++i) vo[h][i] = (unsigned)((h * 128 + R[i]) * ld + C[i] * 2);
    }
};
struct EpiChain {
    static constexpr bool CHAIN = true;
    bf16* Y; const bf16* GS;
    __device__ __forceinline__ bool keep(const Unit& u) const { return u.e < 2; }
    __device__ __forceinline__ void operator()(f32x4 (&acc)[2][2][4][2], const Unit& u, int wr, int wc, int fr, int fq) const {
        const int j = u.e; const bf16* ga = GS + (size_t)j * 65536; const bf16* gb = GS + (size_t)(j < 2 ? j + 1 : j) * 65536; const int lrow0 = wr * 64 + fr, lcol0 = wc * 32 + 8 * fq;
#pragma unroll
        for (int ai = 0; ai < 2; ++ai)
#pragma unroll
            for (int m = 0; m < 4; ++m) {
#pragma unroll
                for (int bj = 0; bj < 2; ++bj) { const int off = (lrow0 + ai * 128 + m * 16) * 256 + lcol0 + bj * 128;
                    const u32x4 a = *(const u32x4*)(ga + off); float f[8] = {bflo(a.x), bfhi(a.x), bflo(a.y), bfhi(a.y), bflo(a.z), bfhi(a.z), bflo(a.w), bfhi(a.w)};
                    if (j < 2) { const u32x4 b = *(const u32x4*)(gb + off); const float d[8] = {bflo(b.x), bfhi(b.x), bflo(b.y), bfhi(b.y), bflo(b.z), bfhi(b.z), bflo(b.w), bfhi(b.w)};
#pragma unroll
                        for (int q = 0; q < 8; ++q) f[q] *= __builtin_amdgcn_rcpf(d[q]); }
                    f32x4& v0 = acc[ai][bj][m][0]; f32x4& v1 = acc[ai][bj][m][1];
                    v0[0] *= f[0]; v0[1] *= f[1]; v0[2] *= f[2]; v0[3] *= f[3]; v1[0] *= f[4]; v1[1] *= f[5]; v1[2] *= f[6]; v1[3] *= f[7];
                    if (j == 2) { u32x4 w; w.x = pk2(v0[0], v0[1]); w.y = pk2(v0[2], v0[3]); w.z = pk2(v1[0], v1[1]); w.w = pk2(v1[2], v1[3]);
                        *(u32x4*)(Y + (size_t)(u.pm * 256 + lrow0 + ai * 128 + m * 16) * DM + u.pn * 256 + lcol0 + bj * 128) = w; } }
                asm volatile("" ::: "memory");
            }
    }
};
}

namespace fa {
constexpr float NEG = -1.0e30f;
__device__ __forceinline__ int crow(int i, int hb) { return (i & 3) + 8 * (i >> 2) + 4 * hb; }
__device__ __forceinline__ s16x4 vtr(const LAS char* p) { return __builtin_bit_cast(s16x4, __builtin_amdgcn_ds_read_tr16_b64_v4i16((LAS v4i16_t*)p)); }

template <int DQK>
__device__ __forceinline__ void qk_tile(const LAS char* kl, const bf16x8 (&qf)[DQK / 16], f32x16& s0, f32x16& s1, int r32, int hb) {
    constexpr int KSTR = DQK * 2 + 16, KS = DQK / 16;
    const LAS char* kp = kl + r32 * KSTR + hb * 16;
    bf16x8 k0[KS], k1[KS];
#pragma unroll
    for (int s = 0; s < KS; ++s) { k0[s] = *(const LAS bf16x8*)(kp + s * 32); k1[s] = *(const LAS bf16x8*)(kp + 32 * KSTR + s * 32); }
    __builtin_amdgcn_sched_barrier(0);
    const f32x16 z = {0.f, 0.f, 0.f, 0.f, 0.f, 0.f, 0.f, 0.f, 0.f, 0.f, 0.f, 0.f, 0.f, 0.f, 0.f, 0.f};
    s0 = __builtin_amdgcn_mfma_f32_32x32x16_bf16(k0[0], qf[0], z, 0, 0, 0);
    s1 = __builtin_amdgcn_mfma_f32_32x32x16_bf16(k1[0], qf[0], z, 0, 0, 0);
#pragma unroll
    for (int s = 1; s < KS; ++s) {
        s0 = __builtin_amdgcn_mfma_f32_32x32x16_bf16(k0[s], qf[s], s0, 0, 0, 0);
        s1 = __builtin_amdgcn_mfma_f32_32x32x16_bf16(k1[s], qf[s], s1, 0, 0, 0);
    }
}
template <bool CHECK>
__device__ __forceinline__ void score_tile(f32x16& s0, f32x16& s1, float d0, float kstep, float c1, float slope2, float wlim, bool lanevalid, int hb) {
#pragma unroll
    for (int i = 0; i < 16; ++i) {
        const float k0 = (float)crow(i, hb) * kstep;
        const float da = d0 - k0, db = d0 - k0 - 32.f * kstep;
        float va = __builtin_fmaf(s0[i], c1, -slope2 * da), vb = __builtin_fmaf(s1[i], c1, -slope2 * db);
        if (CHECK) { va = (da >= 0.f && da < wlim && lanevalid) ? va : NEG; vb = (db >= 0.f && db < wlim && lanevalid) ? vb : NEG; }
        s0[i] = va; s1[i] = vb;
    }
}
__device__ __forceinline__ float tile_max(const f32x16& s0, const f32x16& s1) {
    float a = fmaxf(fmaxf(s0[0], s0[1]), s1[0]), b = fmaxf(fmaxf(s0[2], s0[3]), s1[1]);
    a = fmaxf(fmaxf(a, s1[2]), s1[3]);
#pragma unroll
    for (int i = 4; i < 16; i += 4) { a = fmaxf(fmaxf(a, s0[i]), s0[i + 1]); b = fmaxf(fmaxf(b, s0[i + 2]), s0[i + 3]); a = fmaxf(fmaxf(a, s1[i]), s1[i + 1]); b = fmaxf(fmaxf(b, s1[i + 2]), s1[i + 3]); }
    return hmax(fmaxf(a, b));
}
__device__ __forceinline__ void pack_p(const f32x16& s0, const f32x16& s1, bf16x8 (&pa)[4]) {
#pragma unroll
    for (int sp = 0; sp < 2; ++sp) {
        u32x4 w0, w1;
        w0.x = pk2(s0[8 * sp + 0], s0[8 * sp + 1]); w0.y = pk2(s0[8 * sp + 2], s0[8 * sp + 3]); w0.z = pk2(s0[8 * sp + 4], s0[8 * sp + 5]); w0.w = pk2(s0[8 * sp + 6], s0[8 * sp + 7]);
        w1.x = pk2(s1[8 * sp + 0], s1[8 * sp + 1]); w1.y = pk2(s1[8 * sp + 2], s1[8 * sp + 3]); w1.z = pk2(s1[8 * sp + 4], s1[8 * sp + 5]); w1.w = pk2(s1[8 * sp + 6], s1[8 * sp + 7]);
        pa[sp] = __builtin_bit_cast(bf16x8, w0); pa[2 + sp] = __builtin_bit_cast(bf16x8, w1);
    }
}
__device__ __forceinline__ float softmax_step(f32x16& s0, f32x16& s1, float& m, float& l) {
    const float mx = tile_max(s0, s1);
    const float mn = fmaxf(m, mx);
    const float alpha = fexp2(m - mn);
    m = mn;
    float ra = 0.f, rb = 0.f;
#pragma unroll
    for (int i = 0; i < 16; ++i) { s0[i] = fexp2(s0[i] - mn); s1[i] = fexp2(s1[i] - mn); ra += s0[i]; rb += s1[i]; }
    l = l * alpha + hsum(ra + rb);
    return alpha;
}
template <int DV>
__device__ __forceinline__ int v_swz(int key) { return DV == 64 ? (((key >> 1) & 1) << 6) : ((key & 3) << 6); }
template <int DV>
__device__ __forceinline__ void v_load(const LAS char* vl, int lane, int dvb0, bf16x8 (&vf)[2][4]) {
    constexpr int VSTR = DV * 2;
    const int g16 = lane >> 4, i16 = lane & 15, q = i16 >> 2, p = i16 & 3, hb = lane >> 5;
    const int f = (DV == 64) ? ((q >> 1) & 1) : q;
    const int rowb = (4 * hb + q) * VSTR + 2 * (16 * (g16 & 1) + 4 * p);
#pragma unroll
    for (int d = 0; d < 2; ++d) {
        unsigned vba = (unsigned)(uintptr_t)vl + (unsigned)(rowb + (((dvb0 + d) ^ f) << 6));
        asm volatile("" : "+v"(vba));
        const LAS char* vb = (const LAS char*)vba;
#pragma unroll
        for (int ks = 0; ks < 4; ++ks) {
            const s16x4 lo = vtr(vb + (16 * ks) * VSTR), hi = vtr(vb + (16 * ks + 8) * VSTR);
            vf[d][ks] = (bf16x8){lo[0], lo[1], lo[2], lo[3], hi[0], hi[1], hi[2], hi[3]};
        }
    }
}
__device__ __forceinline__ void pv_mma(const bf16x8 (&vf)[2][4], const bf16x8 (&pa)[4], f32x16& oa, f32x16& ob) {
#pragma unroll
    for (int ks = 0; ks < 4; ++ks) {
        oa = __builtin_amdgcn_mfma_f32_32x32x16_bf16(vf[0][ks], pa[ks], oa, 0, 0, 0);
        ob = __builtin_amdgcn_mfma_f32_32x32x16_bf16(vf[1][ks], pa[ks], ob, 0, 0, 0);
    }
}
template <int DV>
__device__ __forceinline__ void pv_tile(const LAS char* vl, const bf16x8 (&pa)[4], f32x16 (&o)[DV / 32], int lane) {
#pragma unroll
    for (int d0 = 0; d0 < DV / 32; d0 += 2) { bf16x8 vf[2][4]; v_load<DV>(vl, lane, d0, vf); __builtin_amdgcn_sched_barrier(0); pv_mma(vf, pa, o[d0], o[d0 + 1]); }
}
}

constexpr int A_KB = 13312, A_VB0 = 26624, A_VB = 16384;
constexpr int A_SC = 61440, A_SM = 129920, A_UN = 130944;
__device__ __forceinline__ float alibi_slope(int idx) { return fexp2(-8.0f * (float)(idx + 1) / 12.0f); }
__device__ __forceinline__ unsigned getw(const u32x4& w, int i) { return i == 0 ? w.x : (i == 1 ? w.y : (i == 2 ? w.z : w.w)); }
__device__ __forceinline__ int next_bit(const u32x4& w, int from) {
    int res = 128;
#pragma unroll
    for (int wi = 3; wi >= 0; --wi) { unsigned x = getw(w, wi); const int lo = wi * 32;
        if (from > lo + 31) x = 0u; else if (from > lo) x &= (~0u) << (from - lo);
        if (x) res = lo + __builtin_ctz(x); }
    return res;
}

struct Ld64 {
    const char* kp; const char* vp; int kstr, vstr; u32x4 rk, rv;
    __device__ __forceinline__ void issue(int key0, int tid, bool withV) { const int row = tid >> 3, ch = tid & 7;
        rk = *(const u32x4*)(kp + (size_t)(key0 + row) * kstr + ch * 16); if (withV) rv = *(const u32x4*)(vp + (size_t)(key0 + row) * vstr + ch * 16); }
    __device__ __forceinline__ void commit(LAS char* kl, LAS char* vl, int tid, bool withV) { const int row = tid >> 3, ch = tid & 7;
        *(LAS u32x4*)(kl + row * 144 + ch * 16) = rk; if (withV) *(LAS u32x4*)(vl + row * 128 + ((ch * 16) ^ fa::v_swz<64>(row))) = rv; }
};
struct LdDiff {
    const char* kp; const char* vp; u32x4 rk, rv0, rv1;
    __device__ __forceinline__ void issue(int key0, int tid) {
        rk = *(const u32x4*)(kp + (size_t)(key0 + (tid >> 3)) * (PW * 2) + (tid & 7) * 16);
        const char* v = vp + (size_t)(key0 + (tid >> 4)) * (PW * 2) + (tid & 15) * 16; rv0 = *(const u32x4*)v; rv1 = *(const u32x4*)(v + (size_t)32 * PW * 2); }
    __device__ __forceinline__ void commit(LAS char* kl, LAS char* vl, int tid) {
        *(LAS u32x4*)(kl + (tid >> 3) * 144 + (tid & 7) * 16) = rk;
        const int row = tid >> 4, off = ((tid & 15) * 16) ^ fa::v_swz<128>(row);
        *(LAS u32x4*)(vl + row * 256 + off) = rv0; *(LAS u32x4*)(vl + (row + 32) * 256 + off) = rv1; }
};
struct LdMla {
    const char* knp; const char* krp; const char* vp; u32x4 rk0, rk1, rv;
    __device__ __forceinline__ const char* ksrc(int key0, int c) const { const int row = c / 12, ch = c - row * 12;
        return ch < 8 ? knp + (size_t)(key0 + row) * 2048 + ch * 16 : krp + (size_t)(key0 + row) * (PW * 2) + (ch - 8) * 16; }
    __device__ __forceinline__ void issue(int key0, int tid) {
        rk0 = *(const u32x4*)ksrc(key0, tid); if (tid < 256) rk1 = *(const u32x4*)ksrc(key0, tid + 512);
        rv = *(const u32x4*)(vp + (size_t)(key0 + (tid >> 3)) * 2048 + (tid & 7) * 16); }
    __device__ __forceinline__ void commit(LAS char* kl, LAS char* vl, int tid) {
        { const int row = tid / 12, ch = tid - row * 12; *(LAS u32x4*)(kl + row * 208 + ch * 16) = rk0; }
        if (tid < 256) { const int c = tid + 512, row = c / 12, ch = c - row * 12; *(LAS u32x4*)(kl + row * 208 + ch * 16) = rk1; }
        const int row = tid >> 3; *(LAS u32x4*)(vl + row * 128 + (((tid & 7) * 16) ^ fa::v_swz<64>(row))) = rv; }
};

template <int DQK, int DV, class Ld>
__device__ __forceinline__ void flash_causal(LAS char* lds, Ld& ld, const bf16x8 (&qf)[DQK / 16], f32x16 (&o)[DV / 32], float& m, float& l,
                                             int q0, int wq0, int t, float c1, float slope2, int tid, int lane, int r32, int hb) {
    const int nt = (q0 + 256) >> 6;
    ld.issue(0, tid); ld.commit(lds, lds + A_VB0, tid); __syncthreads();
    for (int kt = 0; kt < nt; ++kt) {
        const int buf = kt & 1, key0 = 64 * kt;
        if (kt + 1 < nt) ld.issue(key0 + 64, tid);
        if (key0 <= wq0 + 31) {
            f32x16 s0, s1; fa::qk_tile<DQK>(lds + buf * A_KB, qf, s0, s1, r32, hb);
            if (key0 + 63 > wq0) fa::score_tile<true>(s0, s1, (float)(t - key0), 1.f, c1, slope2, 1.0e9f, true, hb);
            else fa::score_tile<false>(s0, s1, (float)(t - key0), 1.f, c1, slope2, 1.0e9f, true, hb);
            const float alpha = fa::softmax_step(s0, s1, m, l);
#pragma unroll
            for (int d = 0; d < DV / 32; ++d) o[d] = o[d] * alpha;
            bf16x8 pa[4]; fa::pack_p(s0, s1, pa);
            fa::pv_tile<DV>(lds + A_VB0 + buf * A_VB, pa, o, lane);
        }
        if (kt + 1 < nt) ld.commit(lds + (buf ^ 1) * A_KB, lds + A_VB0 + (buf ^ 1) * A_VB, tid);
        __syncthreads();
    }
}


#ifndef DIFF_PIPE
#define DIFF_PIPE false
#endif
#ifndef MLA_PIPE
#define MLA_PIPE false
#endif
#ifndef PROBE_VAR
#define PROBE_VAR 0
#endif
namespace fr {
template <int DQK, int DV> struct Geo {
    static constexpr int KS = DQK / 16, NDV = DV / 32;
    static constexpr int KROWB = (DQK == 64) ? 128 : 256;
    static constexpr int KSLOT = 64 * KROWB, VSLOT = 64 * DV * 2;
    static constexpr int KBASE = 0, VBASE = 3 * KSLOT;
    static constexpr int PK = KSLOT / 8192, PV = VSLOT / 8192;
};
template <int DQK> __device__ __forceinline__ void k_offsets(unsigned* vo, int wid, int lane, int strideB) {
    if constexpr (DQK == 64) { const int row = 8 * wid + (lane >> 3), cp = lane & 7, c = cp ^ ((row >> 1) & 7); vo[0] = (unsigned)(row * strideB + c * 16); }
    else {
#pragma unroll
        for (int j = 0; j < 2; ++j) { const int p = wid + 8 * j, row = 4 * p + (lane >> 4), cp = lane & 15; int c = cp ^ (row & 15); if (c >= 12) c = 0; vo[j] = (unsigned)(row * strideB + c * 16); }
    }
}
template <int DV> __device__ __forceinline__ void v_offsets(unsigned* vo, int wid, int lane, int strideB) {
    if constexpr (DV == 64) { const int row = 8 * wid + (lane >> 3), pp = lane & 7, lg = ((((pp >> 2) ^ ((row >> 1) & 1))) << 2) | (pp & 3); vo[0] = (unsigned)(row * strideB + lg * 16); }
    else {
#pragma unroll
        for (int j = 0; j < 2; ++j) { const int p = wid + 8 * j, row = 4 * p + (lane >> 4), pp = lane & 15, lg = (((pp >> 2) ^ (row & 3)) << 2) | (pp & 3); vo[j] = (unsigned)(row * strideB + lg * 16); }
    }
}
template <int DQK, bool BATCH = true>
__device__ __forceinline__ void qk_ring(const LAS char* kl, const int (&ka)[DQK / 16], const bf16x8 (&qf)[DQK / 16], f32x16& s0, f32x16& s1) {
    constexpr int KROWB = (DQK == 64) ? 128 : 256, KS = DQK / 16;
    bf16x8 k0[KS], k1[KS];
#pragma unroll
    for (int s = 0; s < KS; ++s) { unsigned a = (unsigned)(uintptr_t)kl + (unsigned)ka[s]; asm volatile("" : "+v"(a)); const LAS char* kp = (const LAS char*)a;
        k0[s] = *(const LAS bf16x8*)kp; k1[s] = *(const LAS bf16x8*)(kp + 32 * KROWB); }
    if constexpr (BATCH) __builtin_amdgcn_sched_barrier(0);
    const f32x16 z = {0.f, 0.f, 0.f, 0.f, 0.f, 0.f, 0.f, 0.f, 0.f, 0.f, 0.f, 0.f, 0.f, 0.f, 0.f, 0.f};
    s0 = __builtin_amdgcn_mfma_f32_32x32x16_bf16(k0[0], qf[0], z, 0, 0, 0);
    s1 = __builtin_amdgcn_mfma_f32_32x32x16_bf16(k1[0], qf[0], z, 0, 0, 0);
#pragma unroll
    for (int s = 1; s < KS; ++s) {
        s0 = __builtin_amdgcn_mfma_f32_32x32x16_bf16(k0[s], qf[s], s0, 0, 0, 0);
        s1 = __builtin_amdgcn_mfma_f32_32x32x16_bf16(k1[s], qf[s], s1, 0, 0, 0);
    }
}
template <bool ALIBI, bool CHECK, int NDV>
__device__ __forceinline__ void soft_tile(f32x16& s0, f32x16& s1, float c1, float slope2, float d0, int hb, float& m, float& l, f32x16 (&o)[NDV], bf16x8 (&pa)[4]) {
    const float dh = d0 - (float)(4 * hb);
    if constexpr (ALIBI) {
        const float e0 = -slope2 * dh, e1 = e0 + 32.f * slope2;
#pragma unroll
        for (int i = 0; i < 16; ++i) { const float ci = (float)((i & 3) + 8 * (i >> 2)); s0[i] = __builtin_fmaf(s0[i], c1, __builtin_fmaf(slope2, ci, e0)); s1[i] = __builtin_fmaf(s1[i], c1, __builtin_fmaf(slope2, ci, e1)); }
    }
    if constexpr (CHECK) {
#pragma unroll
        for (int i = 0; i < 16; ++i) { const float ci = (float)((i & 3) + 8 * (i >> 2)); if (ci > dh) s0[i] = fa::NEG; if (ci + 32.f > dh) s1[i] = fa::NEG; }
    }
    const float mx = fa::tile_max(s0, s1);
    const float mn = fmaxf(m, mx);
    if (NDV > 2 || __builtin_amdgcn_ballot_w64(mn > m) != 0ull) {
        const float alpha = fexp2(m - mn); l *= alpha;
#pragma unroll
        for (int d = 0; d < NDV; ++d) o[d] = o[d] * alpha;
    }
    m = mn;
    float ra = 0.f, rb = 0.f;
#pragma unroll
    for (int i = 0; i < 16; ++i) {
        s0[i] = fexp2(s0[i] - mn); s1[i] = fexp2(s1[i] - mn);
        ra += s0[i]; rb += s1[i]; }
    l += hsum(ra + rb);
    fa::pack_p(s0, s1, pa);
}
#define FR_WAITBAR(N) asm volatile("s_waitcnt vmcnt(" #N ") lgkmcnt(0)\n\ts_barrier" ::: "memory")
template <int DQK, int DV, bool ALIBI, bool PIPE, int VAR = 0>
__device__ __forceinline__ void flash_ring(LAS char* lds, const char* kbase, const char* vbase, const int strideB, const bf16x8 (&qf)[DQK / 16], f32x16 (&o)[DV / 32], float& m, float& l,
                                           const int q0, const int wq0, const int t, const float c1, const float slope2, const int wid, const int lane) {
    typedef Geo<DQK, DV> GG;
    constexpr int PK = GG::PK, PV = GG::PV, NDV = DV / 32;
    const int r32 = lane & 31, hb = lane >> 5;
    const int nt = (q0 + 256) >> 6, tmax = (wq0 + 31) >> 6;
    const int iskip = nt - 1 - tmax;
    unsigned voK[PK], voV[PV];
    k_offsets<DQK>(voK, wid, lane, strideB); v_offsets<DV>(voV, wid, lane, strideB);
    int ka[DQK / 16];
    { const int f = (DQK == 64) ? ((r32 >> 1) & 7) : (r32 & 15);
#pragma unroll
      for (int s = 0; s < DQK / 16; ++s) ka[s] = r32 * GG::KROWB + (((2 * s + hb) ^ f) << 4); }
    const unsigned ldsb = (unsigned)(uintptr_t)lds + (unsigned)wid * 1024u;
#define FR_ISSUE_K(it) do { const int it_ = (it); const char* b_ = kbase + (size_t)(nt - 1 - it_) * 64 * strideB; const unsigned d_ = ldsb + GG::KBASE + (unsigned)(it_ % 3) * GG::KSLOT; \
        _Pragma("unroll") for (int j_ = 0; j_ < PK; ++j_) pg8::glds16_s(b_, voK[j_], d_ + j_ * 8192); } while (0)
#define FR_ISSUE_V(it) do { const int it_ = (it); const char* b_ = vbase + (size_t)(nt - 1 - it_) * 64 * strideB; const unsigned d_ = ldsb + GG::VBASE + (unsigned)(it_ % 3) * GG::VSLOT; \
        _Pragma("unroll") for (int j_ = 0; j_ < PV; ++j_) pg8::glds16_s(b_, voV[j_], d_ + j_ * 8192); } while (0)
    constexpr int KA = PIPE ? 1 : 0;
#define FR_ISSUE(i_) do { if ((i_) + 2 + KA < nt) FR_ISSUE_K((i_) + 2 + KA); if ((i_) + 2 < nt) FR_ISSUE_V((i_) + 2); } while (0)
#define FR_END(i_) do { if ((i_) + 2 + KA < nt) { if constexpr (PK + PV == 2) FR_WAITBAR(2); else FR_WAITBAR(3); } \
        else if ((i_) + 2 < nt) { if constexpr (PV == 1) FR_WAITBAR(1); else FR_WAITBAR(2); } else FR_WAITBAR(0); } while (0)
#define FR_KSLOT(i_) (lds + GG::KBASE + ((i_) % 3) * GG::KSLOT)
#define FR_VSLOT(i_) (lds + GG::VBASE + ((i_) % 3) * GG::VSLOT)
    FR_ISSUE_K(0); if constexpr (PIPE) FR_ISSUE_K(1); FR_ISSUE_V(0);
    FR_ISSUE_K(1 + KA); FR_ISSUE_V(1);
    if constexpr (PK + PV == 2) FR_WAITBAR(2); else FR_WAITBAR(3);
    int i = 0;
    for (; i < iskip; ++i) { FR_ISSUE(i); FR_END(i); }
    f32x16 sc0, sc1;
    {
        FR_ISSUE(i);
        bf16x8 pa[4], vf[2][4];
        qk_ring<DQK>(FR_KSLOT(i), ka, qf, sc0, sc1);
        soft_tile<ALIBI, true, NDV>(sc0, sc1, c1, slope2, (float)(t - 64 * (nt - 1 - i)), hb, m, l, o, pa);
#pragma unroll
        for (int d0 = 0; d0 < NDV; d0 += 2) { fa::v_load<DV>(FR_VSLOT(i), lane, d0, vf); __builtin_amdgcn_sched_barrier(0); fa::pv_mma(vf, pa, o[d0], o[d0 + 1]); }
        if (PIPE && i + 1 < nt) qk_ring<DQK>(FR_KSLOT(i + 1), ka, qf, sc0, sc1);
        FR_END(i); ++i;
    }
#define FR_PV(i_) do { _Pragma("unroll") for (int d0 = 0; d0 < NDV; d0 += 2) { fa::v_load<DV>(FR_VSLOT(i_), lane, d0, vf); __builtin_amdgcn_sched_barrier(0); fa::pv_mma(vf, pa, o[d0], o[d0 + 1]); } } while (0)
    if constexpr (PIPE) {
        f32x16 sb0, sb1;
        bool curA = true;
#define FR_BODY(C0, C1, N0, N1) do { FR_ISSUE(i); bf16x8 pa[4], vf[2][4]; const float d0f = (float)(t - 64 * (nt - 1 - i)); \
            qk_ring<DQK, false>(FR_KSLOT(i + 1), ka, qf, N0, N1); \
            if constexpr (VAR != 1) soft_tile<ALIBI, false, NDV>(C0, C1, c1, slope2, d0f, hb, m, l, o, pa); else fa::pack_p(C0, C1, pa); \
            FR_PV(i); FR_END(i); ++i; } while (0)
        while (i + 1 < nt) {
            FR_BODY(sc0, sc1, sb0, sb1);
            if (i + 1 >= nt) { curA = false; break; }
            FR_BODY(sb0, sb1, sc0, sc1);
        }
#undef FR_BODY
        if (i < nt) {
            FR_ISSUE(i); bf16x8 pa[4], vf[2][4]; const float d0f = (float)(t - 64 * (nt - 1 - i));
            if (curA) soft_tile<ALIBI, false, NDV>(sc0, sc1, c1, slope2, d0f, hb, m, l, o, pa); else soft_tile<ALIBI, false, NDV>(sb0, sb1, c1, slope2, d0f, hb, m, l, o, pa);
            FR_PV(i); FR_END(i); ++i;
        }
    } else {
        for (; i < nt; ++i) {
            FR_ISSUE(i);
            bf16x8 pa[4], vf[2][4];
            const float d0f = (float)(t - 64 * (nt - 1 - i));
            qk_ring<DQK>(FR_KSLOT(i), ka, qf, sc0, sc1);
            if constexpr (DV == 64) { fa::v_load<DV>(FR_VSLOT(i), lane, 0, vf); __builtin_amdgcn_sched_barrier(0); }
            if constexpr (VAR != 1) soft_tile<ALIBI, false, NDV>(sc0, sc1, c1, slope2, d0f, hb, m, l, o, pa); else fa::pack_p(sc0, sc1, pa);
#pragma unroll
            for (int d0 = 0; d0 < NDV; d0 += 2) { if (DV != 64 || d0 != 0) { fa::v_load<DV>(FR_VSLOT(i), lane, d0, vf); __builtin_amdgcn_sched_barrier(0); } fa::pv_mma(vf, pa, o[d0], o[d0 + 1]); }
            FR_END(i);
        }
    }
#undef FR_PV
#undef FR_ISSUE_K
#undef FR_ISSUE_V
#undef FR_ISSUE
#undef FR_END
#undef FR_KSLOT
#undef FR_VSLOT
}
}

__device__ __forceinline__ void diff_unit(LAS char* lds, int b, int h, int qt, bf16* P, float lam, float lam_init, const float* subg, bf16* scratch, int wid, bool dry = false) {
    const int lane = lane_id_v(), r32 = lane & 31, hb = lane >> 5;
    const int q0 = 256 * qt, wq0 = q0 + 32 * wid, t = wq0 + r32;
    bf16* prow = P + ((size_t)b * S + t) * PW;
    const char* pb = (const char*)(P + (size_t)b * S * PW);
    const float slope2 = alibi_slope(8 + h) * LOG2E, c1 = 0.125f * LOG2E;
    u32x4* o1g = (u32x4*)scratch + wid * 64 + lane;
    f32x16 o[4]; float m = 0.f, l = 0.f;
    for (int map = 0; map < 2; ++map) {
        bf16x8 qf[4];
#pragma unroll
        for (int s = 0; s < 4; ++s) qf[s] = *(const bf16x8*)(prow + PC_DQ + h * 128 + map * 64 + 16 * s + 8 * hb);
#pragma unroll
        for (int d = 0; d < 4; ++d)
#pragma unroll
            for (int i = 0; i < 16; ++i) o[d][i] = 0.f;
        m = fa::NEG; l = 0.f;
        fr::flash_ring<64, 128, true, DIFF_PIPE>(lds, pb + (PC_DK + h * 128 + map * 64) * 2, pb + (PC_DV + h * 128) * 2, PW * 2, qf, o, m, l, q0, wq0, t, c1, slope2, wid, lane);
        if (map == 0) { const float inv = 1.f / l;
#pragma unroll
            for (int d = 0; d < 4; ++d)
#pragma unroll
                for (int k = 0; k < 2; ++k) { u32x4 w; w.x = pk2(o[d][8 * k] * inv, o[d][8 * k + 1] * inv); w.y = pk2(o[d][8 * k + 2] * inv, o[d][8 * k + 3] * inv);
                    w.z = pk2(o[d][8 * k + 4] * inv, o[d][8 * k + 5] * inv); w.w = pk2(o[d][8 * k + 6] * inv, o[d][8 * k + 7] * inv); o1g[512 * (2 * d + k)] = w; } }
    }
    const float inv2 = lam / l; float ss = 0.f;
#pragma unroll
    for (int d = 0; d < 4; ++d)
#pragma unroll
        for (int k = 0; k < 2; ++k) { u32x4 w;
            { const unsigned long long* p64 = (const unsigned long long*)(o1g + 512 * (2 * d + k));
              const unsigned long long x0 = __hip_atomic_load(p64, __ATOMIC_RELAXED, __HIP_MEMORY_SCOPE_AGENT), x1 = __hip_atomic_load(p64 + 1, __ATOMIC_RELAXED, __HIP_MEMORY_SCOPE_AGENT);
              w.x = (unsigned)x0; w.y = (unsigned)(x0 >> 32); w.z = (unsigned)x1; w.w = (unsigned)(x1 >> 32); }
            const float a0 = bflo(w.x) - o[d][8 * k] * inv2, a1 = bfhi(w.x) - o[d][8 * k + 1] * inv2, a2 = bflo(w.y) - o[d][8 * k + 2] * inv2, a3 = bfhi(w.y) - o[d][8 * k + 3] * inv2;
            const float a4 = bflo(w.z) - o[d][8 * k + 4] * inv2, a5 = bfhi(w.z) - o[d][8 * k + 5] * inv2, a6 = bflo(w.w) - o[d][8 * k + 6] * inv2, a7 = bfhi(w.w) - o[d][8 * k + 7] * inv2;
            o[d][8 * k] = a0; o[d][8 * k + 1] = a1; o[d][8 * k + 2] = a2; o[d][8 * k + 3] = a3; o[d][8 * k + 4] = a4; o[d][8 * k + 5] = a5; o[d][8 * k + 6] = a6; o[d][8 * k + 7] = a7;
            ss += (a0 * a0 + a1 * a1) + (a2 * a2 + a3 * a3) + (a4 * a4 + a5 * a5) + (a6 * a6 + a7 * a7); }
    ss = hsum(ss);
    const float rs = __builtin_amdgcn_rsqf(ss * (1.f / 128.f) + 1e-6f) * (1.f - lam_init);
#pragma unroll
    for (int d = 0; d < 4; ++d)
#pragma unroll
        for (int k = 0; k < 4; ++k) { const int dv = 32 * d + 8 * k + 4 * hb; const f32x4 g = *(const f32x4*)(subg + dv);
            u32x2 w; w.x = pk2(o[d][4 * k] * rs * g[0], o[d][4 * k + 1] * rs * g[1]); w.y = pk2(o[d][4 * k + 2] * rs * g[2], o[d][4 * k + 3] * rs * g[3]);
            if (!dry) *(u32x2*)(prow + PC_DQ + h * 128 + dv) = w; }
}

constexpr int KVW = 1280;
__device__ __forceinline__ void mla_unit(LAS char* lds, int b, int h, int qt, bf16* QM, const bf16* KVM, const float* rsq, int wid, bool dry = false) {
    const int lane = lane_id_v(), r32 = lane & 31, hb = lane >> 5;
    const int q0 = 256 * qt, wq0 = q0 + 32 * wid, t = wq0 + r32; const size_t mrow = (size_t)b * S + t;
    bf16* qrow = QM + mrow * 768 + h * 96;
    bf16x8 qf[6];
#pragma unroll
    for (int s = 0; s < 6; ++s) qf[s] = *(const bf16x8*)(qrow + 16 * s + 8 * hb);
    const float c1 = 0.10206207261596575f * LOG2E * rsq[mrow];
#pragma unroll
    for (int s = 0; s < 6; ++s) { const u32x4 w = __builtin_bit_cast(u32x4, qf[s]); u32x4 r;
        r.x = pk2(bflo(w.x) * c1, bfhi(w.x) * c1); r.y = pk2(bflo(w.y) * c1, bfhi(w.y) * c1); r.z = pk2(bflo(w.z) * c1, bfhi(w.z) * c1); r.w = pk2(bflo(w.w) * c1, bfhi(w.w) * c1);
        qf[s] = __builtin_bit_cast(bf16x8, r); }
    const char* kb = (const char*)(KVM + (size_t)b * S * KVW + h * 160);
    f32x16 o[2];
#pragma unroll
    for (int d = 0; d < 2; ++d)
#pragma unroll
        for (int i = 0; i < 16; ++i) o[d][i] = 0.f;
    float m = fa::NEG, l = 0.f;
    if (PROBE_VAR != 0 && dry) fr::flash_ring<96, 64, false, MLA_PIPE, PROBE_VAR>(lds, kb, kb + 192, KVW * 2, qf, o, m, l, q0, wq0, t, c1, 0.f, wid, lane); else
    fr::flash_ring<96, 64, false, MLA_PIPE>(lds, kb, kb + 192, KVW * 2, qf, o, m, l, q0, wq0, t, c1, 0.f, wid, lane);
    const float inv = 1.f / l;
#pragma unroll
    for (int d = 0; d < 2; ++d)
#pragma unroll
        for (int k = 0; k < 4; ++k) { u32x2 w; w.x = pk2(o[d][4 * k] * inv, o[d][4 * k + 1] * inv); w.y = pk2(o[d][4 * k + 2] * inv, o[d][4 * k + 3] * inv);
            if (!dry) *(u32x2*)(qrow + 32 * d + 8 * k + 4 * hb) = w; }
}

#define LAUNDER(x) asm volatile("" : "+v"(x))
#define NSA_IDS const int lane = lane_id_v(), tid = wid * 64 + lane, r32 = lane & 31, hb = lane >> 5, h4 = r32 >> 3, qi = r32 & 7; (void)h4; (void)qi; (void)hb; (void)r32;
__device__ __forceinline__ void nsa_unit(LAS char* lds, int b, int g, int j, bf16* P, const bf16* KCMP, const bf16* VCMP, int wid, bool dry = false) {
    const int lane = lane_id_v(), r32 = lane & 31, hb = lane >> 5, h4 = r32 >> 3, qi = r32 & 7;
    const int head = 4 * g + h4, t0 = 64 * j, t = t0 + 8 * wid + qi;
    bf16* prow = P + ((size_t)b * S + t) * PW;
    const char* pb = (const char*)(P + (size_t)b * S * PW);
    bf16x8 qf[4];
#pragma unroll
    for (int s = 0; s < 4; ++s) qf[s] = *(const bf16x8*)(prow + PC_NQ + head * 64 + 16 * s + 8 * hb);
    const float slope2 = alibi_slope(head) * LOG2E, c1 = 0.125f * LOG2E;
    const float gc = sigmoidf_(bf2f(prow[PC_NG + head * 3 + 0])), gs = sigmoidf_(bf2f(prow[PC_NG + head * 3 + 1])), gw = sigmoidf_(bf2f(prow[PC_NG + head * 3 + 2]));
    LAS float* sc = (LAS float*)(lds + A_SC + wid * 4096);
    { float z = 0.f; LAUNDER(z);
#pragma unroll
    for (int k = 0; k < 4; ++k) *(LAS f32x4*)(sc + lane * 16 + 4 * k) = (f32x4){z, z, z, z}; }
    f32x16 ob[2];
#pragma unroll
    for (int d = 0; d < 2; ++d)
#pragma unroll
        for (int i = 0; i < 16; ++i) ob[d][i] = 0.f;
    {
        NSA_IDS
        const int ntc = (4 * j + 3 + 63) >> 6;
        Ld64 ld; ld.kp = (const char*)(KCMP + (size_t)(b * 2 + g) * 512 * 64); ld.vp = (const char*)(VCMP + (size_t)(b * 2 + g) * 512 * 64); ld.kstr = 128; ld.vstr = 128;
        float mc = fa::NEG, lc = 0.f;
        ld.issue(0, tid, false); ld.commit(lds, lds + A_VB0, tid, false); __syncthreads();
        for (int kt = 0; kt < ntc; ++kt) {
            const int buf = kt & 1;
            if (kt + 1 < ntc) ld.issue(64 * (kt + 1), tid, false);
            f32x16 s0, s1; fa::qk_tile<64>(lds + buf * A_KB, qf, s0, s1, r32, hb);
            fa::score_tile<true>(s0, s1, (float)(t - 31 - 1024 * kt), 16.f, c1, slope2, 1.0e9f, true, hb);
            (void)fa::softmax_step(s0, s1, mc, lc);
            if (kt + 1 < ntc) ld.commit(lds + (buf ^ 1) * A_KB, lds + A_VB0, tid, false);
            __syncthreads();
        }
        const float inv = (mc > -1.0e29f) ? 1.f / lc : 0.f;
        float carry = 0.f;
        ld.issue(0, tid, true); ld.commit(lds, lds + A_VB0, tid, true); __syncthreads();
        for (int kt = 0; kt < ntc; ++kt) {
            const int buf = kt & 1;
            if (kt + 1 < ntc) ld.issue(64 * (kt + 1), tid, true);
            f32x16 s0, s1; fa::qk_tile<64>(lds + buf * A_KB, qf, s0, s1, r32, hb);
            fa::score_tile<true>(s0, s1, (float)(t - 31 - 1024 * kt), 16.f, c1, slope2, 1.0e9f, true, hb);
#pragma unroll
            for (int i = 0; i < 16; ++i) { s0[i] = fexp2(s0[i] - mc) * inv; s1[i] = fexp2(s1[i] - mc) * inv; }
            { float mainv[8], ps[8];
#pragma unroll
              for (int gq = 0; gq < 8; ++gq) { const int kb = gq >> 2, k = gq & 3;
                  const float p0 = kb ? s1[4 * k] : s0[4 * k], p1 = kb ? s1[4 * k + 1] : s0[4 * k + 1], p2 = kb ? s1[4 * k + 2] : s0[4 * k + 2], p3 = kb ? s1[4 * k + 3] : s0[4 * k + 3];
                  float mv = 2.f * (p0 + p1 + p2) + p3, sv = p3;
                  mv += __shfl_xor(mv, 8); mv += __shfl_xor(mv, 16); sv += __shfl_xor(sv, 8); sv += __shfl_xor(sv, 16);
                  mainv[gq] = mv;
                  auto rr = __builtin_amdgcn_permlane32_swap(__float_as_uint(sv), __float_as_uint(sv), false, false);
                  ps[gq] = __uint_as_float(hb ? rr[0] : rr[1]); }
#pragma unroll
              for (int gq = 0; gq < 8; ++gq) { const float prev = gq ? ps[gq - 1] : carry; const float fin = mainv[gq] + (hb ? ps[gq] : prev);
                  if (h4 == 0) sc[qi * 128 + 16 * kt + 8 * (gq >> 2) + 2 * (gq & 3) + hb] = fin; }
              carry = ps[7]; }
            bf16x8 pa[4]; fa::pack_p(s0, s1, pa);
            fa::pv_tile<64>(lds + A_VB0 + buf * A_VB, pa, ob, lane);
            if (kt + 1 < ntc) ld.commit(lds + (buf ^ 1) * A_KB, lds + A_VB0 + (buf ^ 1) * A_VB, tid, true);
            __syncthreads();
        }
#pragma unroll
        for (int d = 0; d < 2; ++d)
#pragma unroll
            for (int i = 0; i < 16; ++i) ob[d][i] = gc * ob[d][i];
    }
    {
        NSA_IDS
        asm volatile("s_waitcnt lgkmcnt(0)" ::: "memory");
        const int qq = lane >> 3, sub = lane & 7, cur = j;
        float v[16];
#pragma unroll
        for (int k = 0; k < 4; ++k) { const f32x4 x = *(const LAS f32x4*)(sc + qq * 128 + 16 * sub + 4 * k); v[4 * k] = x[0]; v[4 * k + 1] = x[1]; v[4 * k + 2] = x[2]; v[4 * k + 3] = x[3]; }
        unsigned bits = 0u;
        if (cur < 16) {
#pragma unroll
            for (int jj = 0; jj < 16; ++jj) if (16 * sub + jj <= cur) bits |= 1u << jj;
        } else {
#pragma unroll
            for (int jj = 0; jj < 16; ++jj) { const int blk = 16 * sub + jj; if (!(blk >= 1 && blk <= cur - 2)) v[jj] = -1.f; }
            for (int round = 0; round < 13; ++round) {
                float bm = v[0]; int bi = 0;
#pragma unroll
                for (int jj = 1; jj < 16; ++jj) if (v[jj] > bm) { bm = v[jj]; bi = jj; }
                int gi = 16 * sub + bi;
#pragma unroll
                for (int st = 1; st < 8; st <<= 1) { const float ov = __shfl_xor(bm, st); const int oi = __shfl_xor(gi, st); if (ov > bm || (ov == bm && oi < gi)) { bm = ov; gi = oi; } }
                const bool own = (gi >> 4) == sub; const int wj = gi & 15;
#pragma unroll
                for (int jj = 0; jj < 16; ++jj) if (own && jj == wj) { v[jj] = -1.f; bits |= 1u << jj; }
            }
#pragma unroll
            for (int jj = 0; jj < 16; ++jj) { const int blk = 16 * sub + jj; if (blk == 0 || blk == cur || blk == cur - 1) bits |= 1u << jj; }
        }
        ((LAS unsigned short*)(lds + A_SM + wid * 128))[qq * 8 + sub] = (unsigned short)bits;
        unsigned ub = bits; ub |= __shfl_xor(ub, 8); ub |= __shfl_xor(ub, 16); ub |= __shfl_xor(ub, 32);
        if (lane < 8) ((LAS unsigned short*)(lds + A_UN))[wid * 8 + lane] = (unsigned short)ub;
    }
    __syncthreads();
    LAS float* otl = (LAS float*)(lds + A_SC + wid * 8192) + lane;
#pragma unroll
    for (int d = 0; d < 2; ++d)
#pragma unroll
        for (int i = 0; i < 16; ++i) { otl[64 * (16 * d + i)] = ob[d][i]; ob[d][i] = 0.f; }
    {
        NSA_IDS
        u32x4 un = (u32x4){0u, 0u, 0u, 0u};
#pragma unroll
        for (int w = 0; w < 8; ++w) { const u32x4 x = *(const LAS u32x4*)(lds + A_UN + w * 16); un.x |= x.x; un.y |= x.y; un.z |= x.z; un.w |= x.w; }
        un.x = __builtin_amdgcn_readfirstlane(un.x); un.y = __builtin_amdgcn_readfirstlane(un.y); un.z = __builtin_amdgcn_readfirstlane(un.z); un.w = __builtin_amdgcn_readfirstlane(un.w);
        u32x4 wv = *(const LAS u32x4*)(lds + A_UN + wid * 16);
        wv.x = __builtin_amdgcn_readfirstlane(wv.x); wv.y = __builtin_amdgcn_readfirstlane(wv.y); wv.z = __builtin_amdgcn_readfirstlane(wv.z); wv.w = __builtin_amdgcn_readfirstlane(wv.w);
        const u32x4 mq = *(const LAS u32x4*)(lds + A_SM + wid * 128 + qi * 16);
        Ld64 ld; ld.kp = pb + (PC_KS + g * 64) * 2; ld.vp = pb + (PC_VS + g * 64) * 2; ld.kstr = PW * 2; ld.vstr = PW * 2;
        float ms = fa::NEG, ls = 0.f;
        int blk = next_bit(un, 0), buf = 0;
        ld.issue(64 * blk, tid, true); ld.commit(lds, lds + A_VB0, tid, true); __syncthreads();
        while (blk < 128) {
            const int nblk = next_bit(un, blk + 1);
            if (nblk < 128) ld.issue(64 * nblk, tid, true);
            if ((getw(wv, blk >> 5) >> (blk & 31)) & 1u) {
                f32x16 s0, s1; fa::qk_tile<64>(lds + buf * A_KB, qf, s0, s1, r32, hb);
                const bool lsel = ((getw(mq, blk >> 5) >> (blk & 31)) & 1u) != 0u;
                fa::score_tile<true>(s0, s1, (float)(t - 64 * blk), 1.f, c1, slope2, 1.0e9f, lsel, hb);
                const float alpha = fa::softmax_step(s0, s1, ms, ls);
                ob[0] = ob[0] * alpha; ob[1] = ob[1] * alpha;
                bf16x8 pa[4]; fa::pack_p(s0, s1, pa);
                fa::pv_tile<64>(lds + A_VB0 + buf * A_VB, pa, ob, lane);
            }
            if (nblk < 128) ld.commit(lds + (buf ^ 1) * A_KB, lds + A_VB0 + (buf ^ 1) * A_VB, tid, true);
            __syncthreads(); buf ^= 1; blk = nblk;
        }
        const float f = (ms > -1.0e29f) ? gs / ls : 0.f;
#pragma unroll
        for (int d = 0; d < 2; ++d)
#pragma unroll
            for (int i = 0; i < 16; ++i) { otl[64 * (16 * d + i)] += f * ob[d][i]; ob[d][i] = 0.f; }
    }
    {
        NSA_IDS
        Ld64 ld; ld.kp = pb + (PC_KW + g * 64) * 2; ld.vp = pb + (PC_VW + g * 64) * 2; ld.kstr = PW * 2; ld.vstr = PW * 2;
        float mw = fa::NEG, lw = 0.f;
        const int b0 = j >= 8 ? j - 8 : 0; int buf = 0;
        ld.issue(64 * b0, tid, true); ld.commit(lds, lds + A_VB0, tid, true); __syncthreads();
        for (int blk = b0; blk <= j; ++blk) {
            if (blk < j) ld.issue(64 * (blk + 1), tid, true);
            f32x16 s0, s1; fa::qk_tile<64>(lds + buf * A_KB, qf, s0, s1, r32, hb);
            if (blk == j || blk == j - 8) fa::score_tile<true>(s0, s1, (float)(t - 64 * blk), 1.f, c1, slope2, 512.f, true, hb);
            else fa::score_tile<false>(s0, s1, (float)(t - 64 * blk), 1.f, c1, slope2, 512.f, true, hb);
            const float alpha = fa::softmax_step(s0, s1, mw, lw);
            ob[0] = ob[0] * alpha; ob[1] = ob[1] * alpha;
            bf16x8 pa[4]; fa::pack_p(s0, s1, pa);
            fa::pv_tile<64>(lds + A_VB0 + buf * A_VB, pa, ob, lane);
            if (blk < j) ld.commit(lds + (buf ^ 1) * A_KB, lds + A_VB0 + (buf ^ 1) * A_VB, tid, true);
            __syncthreads(); buf ^= 1;
        }
        const float f = (mw > -1.0e29f) ? gw / lw : 0.f;
#pragma unroll
        for (int d = 0; d < 2; ++d)
#pragma unroll
            for (int i = 0; i < 16; ++i) ob[d][i] = otl[64 * (16 * d + i)] + f * ob[d][i];
    }
#pragma unroll
    for (int d = 0; d < 2; ++d)
#pragma unroll
        for (int k = 0; k < 4; ++k) { u32x2 w; w.x = pk2(ob[d][4 * k], ob[d][4 * k + 1]); w.y = pk2(ob[d][4 * k + 2], ob[d][4 * k + 3]);
            if (!dry) *(u32x2*)(prow + PC_NQ + head * 64 + 32 * d + 8 * k + 4 * hb) = w; }
    __syncthreads();
}

__device__ __forceinline__ int srccol(int mode, int n) {
    if (mode == 0) return n;
    if (mode == 1) {
        if (n < 1280) return n;
        if (n < 2816) return n - 1280 + 1304;
        if (n < 3200) return n - 2816 + 2840;
        if (n < 3232) { const int i = n - 3200; return 3224 + (i & 1) * 16 + (i >> 1); }
        if (n < 3256) return 1280 + (n - 3232);
        return -1; }
    { const int h = n / 96, c = n - h * 96; if (c < 64) return n; const int i = c - 64; return h * 96 + 64 + (i & 1) * 16 + (i >> 1); }
}
__device__ __forceinline__ void tconv_item(const float* W, int ldw, const float* kscale, bf16* WT, int K, int N, int mode, int item, LAS float* scr, int lane) {
    const int nblk = N / 32, kb = item / nblk, nb = item - kb * nblk, k0 = 64 * kb, n0 = 32 * nb;
    if (mode == 0 || (mode == 1 && n0 + 31 < 3200)) {
        const int c0 = srccol(mode, n0), kq = lane >> 3, n4 = (lane & 7) * 4;
        f32x4 x[8];
#pragma unroll
        for (int i = 0; i < 8; ++i) x[i] = *(const f32x4*)(W + (size_t)(k0 + kq + 8 * i) * ldw + c0 + n4);
#pragma unroll
        for (int i = 0; i < 8; ++i) { const int kk = kq + 8 * i; const float ksc = kscale ? kscale[k0 + kk] : 1.f; LAS float* d = scr + kk * 33 + n4;
            d[0] = x[i][0] * ksc; d[1] = x[i][1] * ksc; d[2] = x[i][2] * ksc; d[3] = x[i][3] * ksc; }
    } else {
    const int sc = srccol(mode, n0 + (lane & 31));
#pragma unroll 8
    for (int i = 0; i < 32; ++i) { const int kk = 2 * i + (lane >> 5); float x = 0.f; if (sc >= 0) { x = W[(size_t)(k0 + kk) * ldw + sc]; if (kscale) x *= kscale[k0 + kk]; } scr[kk * 33 + (lane & 31)] = x; }
    }
    asm volatile("s_waitcnt lgkmcnt(0)" ::: "memory");
    const int c = lane & 7;
#pragma unroll
    for (int j = 0; j < 4; ++j) { const int n = (lane >> 3) + 8 * j; const LAS float* s = scr + (8 * c) * 33 + n;
        u32x4 o; o.x = pk2(s[0 * 33], s[1 * 33]); o.y = pk2(s[2 * 33], s[3 * 33]); o.z = pk2(s[4 * 33], s[5 * 33]); o.w = pk2(s[6 * 33], s[7 * 33]);
        *(u32x4*)(WT + (size_t)(n0 + n) * K + k0 + 8 * c) = o; }
    asm volatile("s_waitcnt lgkmcnt(0)" ::: "memory");
}
struct TJob { const float* W; const float* ks; bf16* WT; int ldw, K, N, mode, item; };
__device__ __forceinline__ bool tjob_fast(const TJob& j) { const int nblk = j.N / 32, kb = j.item / nblk, n0 = 32 * (j.item - kb * nblk); return j.mode == 0 || (j.mode == 1 && n0 + 31 < 3200); }
__device__ __forceinline__ void tconv_load(const TJob& j, f32x4 (&x)[8], int lane) {
    if (!tjob_fast(j)) return;
    const int nblk = j.N / 32, kb = j.item / nblk, nb = j.item - kb * nblk, k0 = 64 * kb, n0 = 32 * nb;
    const int c0 = srccol(j.mode, n0), kq = lane >> 3, n4 = (lane & 7) * 4;
#pragma unroll
    for (int i = 0; i < 8; ++i) x[i] = *(const f32x4*)(j.W + (size_t)(k0 + kq + 8 * i) * j.ldw + c0 + n4);
}
__device__ __forceinline__ void tconv_finish(const TJob& j, const f32x4 (&x)[8], LAS float* scr, int lane) {
    if (!tjob_fast(j)) { tconv_item(j.W, j.ldw, j.ks, j.WT, j.K, j.N, j.mode, j.item, scr, lane); return; }
    const int nblk = j.N / 32, kb = j.item / nblk, nb = j.item - kb * nblk, k0 = 64 * kb, n0 = 32 * nb;
    const int kq = lane >> 3, n4 = (lane & 7) * 4;
#pragma unroll
    for (int i = 0; i < 8; ++i) { const int kk = kq + 8 * i; const float ksc = j.ks ? j.ks[k0 + kk] : 1.f; LAS float* d = scr + kk * 33 + n4;
        d[0] = x[i][0] * ksc; d[1] = x[i][1] * ksc; d[2] = x[i][2] * ksc; d[3] = x[i][3] * ksc; }
    asm volatile("s_waitcnt lgkmcnt(0)" ::: "memory");
    const int c = lane & 7;
#pragma unroll
    for (int q = 0; q < 4; ++q) { const int n = (lane >> 3) + 8 * q; const LAS float* sp = scr + (8 * c) * 33 + n;
        u32x4 o; o.x = pk2(sp[0 * 33], sp[1 * 33]); o.y = pk2(sp[2 * 33], sp[3 * 33]); o.z = pk2(sp[4 * 33], sp[5 * 33]); o.w = pk2(sp[6 * 33], sp[7 * 33]);
        *(u32x4*)(j.WT + (size_t)(n0 + n) * j.K + k0 + 8 * c) = o; }
    asm volatile("s_waitcnt lgkmcnt(0)" ::: "memory");
}
#define TCONV_LOOP(NITEMS, DECODE) do { int it_ = gw; if (it_ < (NITEMS)) { TJob cur_; f32x4 xc_[8]; DECODE(it_, cur_); tconv_load(cur_, xc_, lane); \
        for (;;) { const int nit_ = it_ + NGW; const bool hn_ = nit_ < (NITEMS); TJob nx_ = cur_; f32x4 xn_[8]; \
            _Pragma("unroll") for (int q_ = 0; q_ < 8; ++q_) xn_[q_] = xc_[q_]; \
            if (hn_) { DECODE(nit_, nx_); tconv_load(nx_, xn_, lane); } \
            tconv_finish(cur_, xc_, scr, lane); if (!hn_) break; cur_ = nx_; it_ = nit_; \
            _Pragma("unroll") for (int q_ = 0; q_ < 8; ++q_) xc_[q_] = xn_[q_]; } } } while (0)
__device__ __forceinline__ void ln_row(f32x4 (&v)[4], const float* g, const float* b, int lane) {
    float s = 0.f;
#pragma unroll
    for (int j = 0; j < 4; ++j) s += (v[j][0] + v[j][1]) + (v[j][2] + v[j][3]);
    const float mean = wave_sum(s) * (1.f / 1024.f); float s2 = 0.f;
#pragma unroll
    for (int j = 0; j < 4; ++j) { v[j] = v[j] - mean; s2 += (v[j][0] * v[j][0] + v[j][1] * v[j][1]) + (v[j][2] * v[j][2] + v[j][3] * v[j][3]); }
    const float rstd = 1.f / sqrtf(wave_sum(s2) * (1.f / 1024.f) + 1e-5f);
#pragma unroll
    for (int j = 0; j < 4; ++j) { const f32x4 gg = *(const f32x4*)(g + 4 * lane + 256 * j), bb = *(const f32x4*)(b + 4 * lane + 256 * j); v[j] = v[j] * rstd * gg + bb; }
}
__device__ __forceinline__ void store_row_bf16(bf16* row, const f32x4 (&v)[4], int lane) {
#pragma unroll
    for (int j = 0; j < 4; ++j) { u32x2 w; w.x = pk2(v[j][0], v[j][1]); w.y = pk2(v[j][2], v[j][3]); *(u32x2*)(row + 4 * lane + 256 * j) = w; }
}

struct InPtrs { const float* const* p; __device__ __forceinline__ const float* operator[](int i) const { return (const float*)(GAS const float*)p[i]; } };
#define PHASE_IDS int wid_l_ = wid_k; asm volatile("" : "+s"(wid_l_)); const int lane_l_ = lane_id_v(); \
    const int wid = wid_l_, lane = lane_l_, tid = wid * 64 + lane, gw = c * 8 + wid; (void)lane; (void)gw; (void)wid; (void)tid; \
    GAS unsigned char* ws_l_ = (GAS unsigned char*)ws_k; GAS unsigned char* dout_l_ = (GAS unsigned char*)dout_k; asm volatile("" : "+s"(ws_l_), "+s"(dout_l_)); \
    unsigned char* const ws = (unsigned char*)ws_l_; unsigned char* const dout = (unsigned char*)dout_l_; (void)dout;
struct Args { const float* in[29]; float* out; unsigned char* ws; int ph_lo, ph_hi; };

__global__ void __launch_bounds__(512, 2) fwd(Args a) {
    extern __shared__ __attribute__((aligned(16))) unsigned char lds_[];
    LAS unsigned char* lds = (LAS unsigned char*)lds_;
    LAS char* ldc = (LAS char*)lds_;
    const int wid_k = __builtin_amdgcn_readfirstlane((int)threadIdx.x >> 6);
    const int G = gridDim.x, c = blockIdx.x, v = (G % 8 == 0) ? (c % 8) * (G / 8) + c / 8 : c;
    const int NGW = G * 8;
    volatile LAS unsigned* MISC = (volatile LAS unsigned*)(lds + LDS_MISC);
    if (threadIdx.x < 256) MISC[threadIdx.x] = 0u;
    __syncthreads();
    const InPtrs INP{a.in};
    unsigned char* const ws_k = a.ws;
    unsigned* ctl = (unsigned*)(ws_k + WS_CTL);
#if !MK_PER_PHASE
    XcdBarrier bar = xcd_barrier_post(ctl + CW_BAR, MISC + 8);
#define GRID_BAR() do { xcd_barrier(bar); if (PROBE_REPEAT == 17) xcd_barrier(bar); } while (0)
#else
#define GRID_BAR() do {} while (0)
#endif
    const int lo = a.ph_lo, hi = a.ph_hi;
#define IN(k) (lo <= (k) && (k) < hi)
#define BOTH(k) (IN(k) && IN((k) + 1))
    unsigned char* const dout_k = (unsigned char*)a.out;
#define CS ((float*)(ws + WS_CS))
#define MISCF ((float*)(ws + WS_MISC))
#define RSQ ((float*)(ws + WS_RSQ))
#define RSKV ((float*)(ws + WS_RSKV))
#define RTE ((int*)(ws + WS_RTE))
#define RTP ((int*)(ws + WS_RTP))
#define RTG ((float*)(ws + WS_RTG))
#define ROWIDX ((int*)(ws + WS_ROWIDX))
#define KCMP ((bf16*)(ws + WS_KCMP))
#define VCMP ((bf16*)(ws + WS_VCMP))
#define UL ((bf16*)(ws + WS_UL))
#define Hb ((bf16*)(ws + WS_HB))
#define P ((bf16*)(ws + WS_P))
#define Z ((bf16*)(ws + WS_P))
#define YS ((bf16*)(ws + WS_P))
#define HS ((bf16*)(ws + WS_HS))
#define GSwg ((bf16*)(ws + WS_GS) + (size_t)c * 3 * 65536)
#define QM ((bf16*)(dout + DO_QM))
#define KVM ((bf16*)(dout + DO_KVM))
#define Y ((bf16*)(dout + DO_KVM))
#define W13T ((bf16*)(dout + DO_W13))
#define W2T ((bf16*)(dout + DO_W2))
#define LAYER_W unsigned char* wl = ws + WS_WTS + (size_t)l * WL_STRIDE; \
        const bf16* WinT = (const bf16*)(wl + WL_WIN); const bf16* WgT = (const bf16*)(wl + WL_WG); const bf16* WbrT = (const bf16*)(wl + WL_WBR); const bf16* WoutT = (const bf16*)(wl + WL_WOUT); \
        const bf16* WuqT = (const bf16*)(wl + WL_WUQ); const bf16* WukvT = (const bf16*)(wl + WL_WUKV); const bf16* Wc1T = (const bf16*)(wl + WL_WC1); \
        unsigned* gcnt = (unsigned*)(ws + WS_CTL) + CW_CNT + l * 16 * 64; (void)WinT; (void)WgT; (void)WbrT; (void)WoutT; (void)WuqT; (void)WukvT; (void)Wc1T; (void)gcnt;
    if (PHON(0) && IN(0)) { PHASE_IDS
        for (int rep_ = (PROBE_REPEAT == 15 ? 0 : 1); rep_ < 2; ++rep_) {
        LAS float* scr = (LAS float*)(lds + wid * 8704);
#define DEC_PRO(it, J) do { const int l_ = (it) / 5152; int r_ = (it) - l_ * 5152; unsigned char* wl_ = ws + WS_WTS + (size_t)l_ * WL_STRIDE; \
            if (r_ < 1664) { J = TJob{INP[3] + (size_t)l_ * 1024 * IN_W, nullptr, (bf16*)(wl_ + WL_WIN), IN_W, 1024, 3328, 1, r_}; } \
            else if ((r_ -= 1664) < 1536) { J = TJob{INP[3] + (size_t)l_ * 1024 * IN_W + 3256, nullptr, (bf16*)(wl_ + WL_WG), IN_W, 1024, 3072, 0, r_}; } \
            else if ((r_ -= 1536) < 768) { const int jb_ = r_ / 256; J = TJob{INP[16 + jb_] + (size_t)l_ * 512 * 1024, nullptr, (bf16*)(wl_ + WL_WBR) + (size_t)jb_ * 1024 * 512, 1024, 512, 1024, 0, r_ - jb_ * 256}; } \
            else if ((r_ -= 768) < 512) { J = TJob{INP[19] + (size_t)l_ * 1024 * 1024, nullptr, (bf16*)(wl_ + WL_WOUT), 1024, 1024, 1024, 0, r_}; } \
            else if ((r_ -= 512) < 96) { J = TJob{INP[14] + (size_t)l_ * 256 * 768, INP[12] + l_ * 256, (bf16*)(wl_ + WL_WUQ), 768, 256, 768, 2, r_}; } \
            else if ((r_ -= 96) < 64) { J = TJob{INP[15] + (size_t)l_ * 128 * 1024, INP[13] + l_ * 128, (bf16*)(wl_ + WL_WUKV), 1024, 128, 1024, 0, r_}; } \
            else { r_ -= 64; const int job_ = r_ / 128, kv_ = job_ >> 1, half_ = job_ & 1; \
                J = TJob{INP[kv_ ? 8 : 5] + (size_t)l_ * 2048 * 256 + (size_t)half_ * 1024 * 256, nullptr, (bf16*)(wl_ + WL_WC1) + (size_t)kv_ * 512 * 1024 + (size_t)half_ * 256 * 1024, 256, 1024, 256, 0, r_ - job_ * 128}; } } while (0)
        TCONV_LOOP(2 * 5152, DEC_PRO);
#undef DEC_PRO
        for (int i = c * 512 + tid; i < S * 16; i += G * 512) { const int pos = i >> 4, k = i & 15;
            const float freq = fexp2(-(float)k * (13.287712379549449f / 16.f)); const float ang = (float)pos * freq;
            const double rev = (double)ang * 0.15915494309189535; const float fr = (float)(rev - __builtin_rint(rev));
            CS[2 * i] = __builtin_amdgcn_cosf(fr); CS[2 * i + 1] = __builtin_amdgcn_sinf(fr); }
        for (int jt = c * 512 + tid; jt < 32768; jt += G * 512) { const int i = jt & 1023, ch = jt >> 10; const int l = i >> 9, kv = (i >> 8) & 1, n = i & 255;
            const float* pos = INP[kv ? 7 : 4] + l * 2048 + ch * 64; const float* w1 = INP[kv ? 8 : 5] + (size_t)l * 2048 * 256 + (size_t)ch * 64 * 256 + n; float s = 0.f;
#pragma unroll 8
            for (int k = 0; k < 64; ++k) s += pos[k] * w1[(size_t)k * 256];
            MISCF[2048 + ch * 1024 + i] = s; }
        if (c == 0 && tid < 2) { const float* lp = INP[10] + tid * 256; float s1 = 0.f, s2 = 0.f;
            for (int k = 0; k < 64; ++k) { s1 += lp[k] * lp[64 + k]; s2 += lp[128 + k] * lp[192 + k]; }
            const float li = 0.8f - 0.6f * __expf(-0.3f * (float)tid); MISCF[1024 + tid] = __expf(s1) - __expf(s2) + li; MISCF[1026 + tid] = li; }
        { f32x4 xn[4];
          if (gw < T) {
#pragma unroll
              for (int j = 0; j < 4; ++j) xn[j] = *(const f32x4*)(INP[0] + (size_t)gw * 1024 + 4 * lane + 256 * j); }
          for (int m = gw; m < T; m += NGW) { f32x4 x[4];
#pragma unroll
            for (int j = 0; j < 4; ++j) x[j] = xn[j];
            const int mn_ = m + NGW < T ? m + NGW : m;
#pragma unroll
            for (int j = 0; j < 4; ++j) xn[j] = *(const f32x4*)(INP[0] + (size_t)mn_ * 1024 + 4 * lane + 256 * j);
            ln_row(x, INP[1], INP[2], lane); store_row_bf16(Hb + (size_t)m * 1024, x, lane); } }
        }
        if (BOTH(0)) GRID_BAR();
    }

    for (int l = 0; l < NLAYER; ++l) {
        const int pbase = 1 + 11 * l;
        if (PHON(1) && IN(pbase + 0)) { PHASE_IDS LAYER_W
            for (int rep_ = (PROBE_REPEAT == 1 ? 0 : 1); rep_ < 2; ++rep_) {
            pg8::TileSched Sd{(const char*)Hb, (const char*)WinT, 2048, 1024, 13, 128 * 13, G, v}; pg8::EpiStore E{P, PW, nullptr, 0, false};
            pg8::gemm_phase<pg8::EpiStore, pg8::TileSched, true>(lds, wid, 1024, 128u, Sd, E);
            }
            if (BOTH(pbase + 0)) GRID_BAR();
        }
        if (PHON(2) && IN(pbase + 1)) { PHASE_IDS LAYER_W
            for (int i = c * 512 + tid; i < 512; i += G * 512) { float sacc = 0.f;
                for (int ch = 0; ch < 32; ++ch) sacc += MISCF[2048 + ch * 1024 + l * 512 + i];
                MISCF[l * 512 + i] = sacc; }
            for (int rep_ = (PROBE_REPEAT == 2 ? 0 : 1); rep_ < 2; ++rep_)
            for (int m = gw; m < T; m += NGW) { bf16* pr = P + (size_t)m * PW; float ss = 0.f;
                if (lane < 48) { const u32x4 w = *(const u32x4*)(pr + (lane < 32 ? PC_CQ + lane * 8 : PC_CKV + (lane - 32) * 8));
                    ss = bflo(w.x) * bflo(w.x) + bfhi(w.x) * bfhi(w.x) + bflo(w.y) * bflo(w.y) + bfhi(w.y) * bfhi(w.y) + bflo(w.z) * bflo(w.z) + bfhi(w.z) * bfhi(w.z) + bflo(w.w) * bflo(w.w) + bfhi(w.w) * bfhi(w.w); }
                else if (lane < 52) { const int i0 = (lane - 48) * 4, pos = m & (S - 1); u32x4 w = *(const u32x4*)(pr + PC_KR + i0 * 2);
                    const f32x4* cs = (const f32x4*)(CS + ((size_t)pos * 16 + i0) * 2); const f32x4 ca = cs[0], cb = cs[1];
                    u32x4 o;
                    o.x = pk2(bflo(w.x) * ca[0] - bfhi(w.x) * ca[1], bflo(w.x) * ca[1] + bfhi(w.x) * ca[0]);
                    o.y = pk2(bflo(w.y) * ca[2] - bfhi(w.y) * ca[3], bflo(w.y) * ca[3] + bfhi(w.y) * ca[2]);
                    o.z = pk2(bflo(w.z) * cb[0] - bfhi(w.z) * cb[1], bflo(w.z) * cb[1] + bfhi(w.z) * cb[0]);
                    o.w = pk2(bflo(w.w) * cb[2] - bfhi(w.w) * cb[3], bflo(w.w) * cb[3] + bfhi(w.w) * cb[2]);
                    bf16* kr = KVM + (size_t)m * KVW + 64 + i0 * 2;
#pragma unroll
                    for (int hh = 0; hh < 8; ++hh) *(u32x4*)(kr + hh * 160) = o; }
                const float sq = wave_sum(lane < 32 ? ss : 0.f), skv = wave_sum((lane >= 32 && lane < 48) ? ss : 0.f);
                if (lane == 0) { RSQ[m] = 1.f / sqrtf(sq * (1.f / 256.f) + 1e-6f); RSKV[m] = 1.f / sqrtf(skv * (1.f / 128.f) + 1e-6f); } }
            if (BOTH(pbase + 1)) GRID_BAR();
        }
        if (PHON(3) && IN(pbase + 2)) { PHASE_IDS LAYER_W
            for (int rep_ = (PROBE_REPEAT == 3 ? 0 : 1); rep_ < 2; ++rep_) {
            const bool cmpwg = G > 64 && v >= G - 64; const int Gs = G > 64 ? G - 64 : G;
            { pg8::TileSched Sd{(const char*)(P + PC_CQ), (const char*)WuqT, PW * 2, 256, 3, cmpwg ? 0 : 384, Gs, v}; pg8::EpiRope E{QM, CS};
              pg8::gemm_phase<pg8::EpiRope, pg8::TileSched, true>(lds, wid, 256, 128u, Sd, E); }
            { pg8::TileSched Sd{(const char*)(P + PC_CKV), (const char*)WukvT, PW * 2, 128, 4, cmpwg ? 0 : 512, Gs, v}; pg8::EpiStore E{KVM, KVW, RSKV, 0, true};
              pg8::gemm_phase<pg8::EpiStore, pg8::TileSched, true>(lds, wid, 128, 128u, Sd, E); }
            { pg8::CmpSched Sd{(const char*)P, (const char*)Wc1T, G, v >= G - 64 ? v - (G - 64) : 64 + v}; pg8::EpiStore E{UL, 512, nullptr, (size_t)512 * 512, false};
              pg8::gemm_phase<pg8::EpiStore, pg8::CmpSched, true>(lds, wid, 1024, (unsigned)(PW * 2), Sd, E); }
            }
            if (BOTH(pbase + 2)) GRID_BAR();
        }
        if (PHON(4) && IN(pbase + 3)) { PHASE_IDS LAYER_W
            for (int rep_ = (PROBE_REPEAT == 4 ? 0 : 1); rep_ < 2; ++rep_) {
            LAS float* hid = (LAS float*)(lds + wid * 1024);
            for (int r = gw; r < 2 * 8 * 512; r += NGW) { const int kv = r >> 12, bg = (r >> 9) & 7, i = r & 511;
                bf16* out = (kv ? VCMP : KCMP) + ((size_t)bg * 512 + i) * 64;
                if (i == 511) { out[lane] = 0; continue; }
                const bf16* u = UL + ((size_t)(kv * 8 + bg) * 512 + i) * 512; const float* pbv = MISCF + l * 512 + kv * 256;
#pragma unroll
                for (int q = 0; q < 4; ++q) { const int n = lane + 64 * q; const float x = bf2f(u[n]) + bf2f(u[512 + 256 + n]) + pbv[n];
                    const float y = 0.7978845608028654f * (x + 0.044715f * x * x * x); const float th = 1.f - 2.f / (__expf(2.f * y) + 1.f);
                    hid[n] = 0.5f * x * (1.f + th); }
                asm volatile("s_waitcnt lgkmcnt(0)" ::: "memory");
                const float* w2 = INP[kv ? 9 : 6] + (size_t)l * 256 * 64 + lane; float acc = 0.f;
#pragma unroll 8
                for (int n = 0; n < 256; ++n) acc += hid[n] * w2[n * 64];
                out[lane] = (bf16)f2bf(acc);
                asm volatile("s_waitcnt lgkmcnt(0)" ::: "memory"); }
            }
            if (BOTH(pbase + 3)) GRID_BAR();
        }
        if (PHON(5) && IN(pbase + 4)) { PHASE_IDS LAYER_W
            const int xcd = c & 7, ii = c >> 3;
            if (G == 256) {
                for (int rep = (PROBE_REPEAT == 11 ? 0 : 1); rep < 2; ++rep)
                if (PHON(11)) for (int k = 0; k < 4; ++k) { const int bh = xcd + 8 * k; mla_unit(ldc, bh >> 3, bh & 7, (k & 1) ? ii : 31 - ii, QM, KVM, RSQ, wid, rep == 0); }
                for (int rep = (PROBE_REPEAT == 12 ? 0 : 1); rep < 2; ++rep)
                if (PHON(12)) for (int k = 0; k < 2; ++k) { const int bh = xcd + 8 * k; diff_unit(ldc, bh >> 2, bh & 3, k ? ii : 31 - ii, P, MISCF[1024 + l], MISCF[1026 + l], INP[11] + l * 128, GSwg, wid, rep == 0); }
                if (PHON(13)) for (int k = (PROBE_REPEAT == 13 ? -4 : 0); k < 4; ++k) { const int kk = k & 3; const int tile = (kk == 0) ? ii : (kk == 1) ? 63 - ii : (kk == 2) ? 64 + ii : 127 - ii; nsa_unit(ldc, xcd >> 1, xcd & 1, tile, P, KCMP, VCMP, wid, k < 0); }
            } else {
                if (PHON(11)) for (int u = c; u < 1024; u += G) { const int bh = u & 31; mla_unit(ldc, bh >> 3, bh & 7, 31 - (u >> 5), QM, KVM, RSQ, wid); }
                if (PHON(12)) for (int u = c; u < 512; u += G) { const int bh = u & 15; diff_unit(ldc, bh >> 2, bh & 3, 31 - (u >> 4), P, MISCF[1024 + l], MISCF[1026 + l], INP[11] + l * 128, GSwg, wid); }
                if (PHON(13)) for (int u = c; u < 1024; u += G) { const int bg = u & 7; nsa_unit(ldc, bg >> 1, bg & 1, 127 - (u >> 3), P, KCMP, VCMP, wid); }
            }
            if (BOTH(pbase + 4)) GRID_BAR();
        }
        if (PHON(6) && IN(pbase + 5)) { PHASE_IDS LAYER_W
            for (int rep_ = (PROBE_REPEAT == 6 ? 0 : 1); rep_ < 2; ++rep_) {
            for (int tl = v; tl < 512; tl += G) {
                const int pm = tl >> 2, pn = tl & 3;
                { pg8::GateSched Sd{(const char*)Hb, (const char*)WgT, pm, pn, true}; pg8::EpiGate E{GSwg};
                  pg8::gemm_phase<pg8::EpiGate, pg8::GateSched, true>(lds, wid, 1024, 128u, Sd, E); }
                { pg8::ChainSched Sd{(const char*)(P + PC_NQ), (const char*)(P + PC_DQ), (const char*)QM, (const char*)WbrT, pm, pn, true}; pg8::EpiChain E{Y, GSwg};
                  pg8::gemm_phase<pg8::EpiChain, pg8::ChainSched, true>(lds, wid, 512, 128u, Sd, E); }
            }
            }
            if (BOTH(pbase + 5)) GRID_BAR();
        }
        if (PHON(7) && IN(pbase + 6)) { PHASE_IDS LAYER_W
            for (int rep_ = (PROBE_REPEAT == 7 ? 0 : 1); rep_ < 2; ++rep_) {
            pg8::TileSched Sd{(const char*)Y, (const char*)WoutT, 2048, 1024, 4, 512, G, v}; pg8::EpiResid E{Z, Hb};
            pg8::gemm_phase<pg8::EpiResid, pg8::TileSched, true>(lds, wid, 1024, 128u, Sd, E);
            }
            if (BOTH(pbase + 6)) GRID_BAR();
        }
        if (PHON(8) && IN(pbase + 7)) { PHASE_IDS LAYER_W
            LAS float* rwT = (LAS float*)lds;
            for (int i = tid; i < 16384; i += 512) rwT[(i & 15) * 1024 + (i >> 4)] = INP[22][i];
            volatile LAS int* cntL = (volatile LAS int*)(MISC + 16); volatile LAS int* cbase = (volatile LAS int*)(MISC + 32);
            const float* g1 = INP[20] + l * 1024; const float* b1 = INP[21] + l * 1024; const float* rb = INP[23];
            LAS float* scr = (LAS float*)(lds + (wid < 7 ? 65536 + wid * 8448 : 132096));
#define DEC_MOE(it, J) do { const int e_ = (it) / 768; const int r_ = (it) - e_ * 768; \
                if (r_ < 512) { const int job_ = r_ >> 6, pn_ = job_ >> 1, half_ = job_ & 1; \
                    J = TJob{INP[half_ ? 25 : 24] + ((size_t)l * 16 + e_) * 1024 * 512 + pn_ * 128, nullptr, W13T + (size_t)e_ * 1024 * 1024 + (size_t)(pn_ * 256 + half_ * 128) * 1024, 512, 1024, 128, 0, r_ & 63}; } \
                else { J = TJob{INP[26] + ((size_t)l * 16 + e_) * 512 * 1024, nullptr, W2T + (size_t)e_ * 1024 * 512, 1024, 512, 1024, 0, r_ - 512}; } } while (0)
            int cv_it = gw; bool cv_has = cv_it < 16 * 768; f32x4 cv_x[8];
#pragma unroll
            for (int q = 0; q < 8; ++q) cv_x[q] = (f32x4){0.f, 0.f, 0.f, 0.f};
            if (cv_has) { TJob j0_; DEC_MOE(cv_it, j0_); tconv_load(j0_, cv_x, lane); }
#define CV_STEP() do { if (cv_has) { TJob cur_; DEC_MOE(cv_it, cur_); const int nit_ = cv_it + NGW; const bool hn_ = nit_ < 16 * 768; f32x4 xn_[8]; \
                _Pragma("unroll") for (int q_ = 0; q_ < 8; ++q_) xn_[q_] = cv_x[q_]; \
                if (hn_) { TJob nx_; DEC_MOE(nit_, nx_); tconv_load(nx_, xn_, lane); } \
                tconv_finish(cur_, cv_x, scr, lane); cv_it = nit_; cv_has = hn_; \
                _Pragma("unroll") for (int q_ = 0; q_ < 8; ++q_) cv_x[q_] = xn_[q_]; } } while (0)
            const int nit = (T + G * 128 - 1) / (G * 128);
            for (int rep_ = (PROBE_REPEAT == 8 ? 0 : 1); rep_ < 2; ++rep_)
            for (int it = 0; it < nit; ++it) {
                if (tid < 16) cntL[tid] = 0;
                __syncthreads();
                const int base = (it * G + c) * 128 + wid * 16;
                int e0 = -1, e1 = -1; float g0 = 0.f, g1v = 0.f;
                u32x2 zn[4];
                { const int m0_ = base < T ? base : T - 1;
#pragma unroll
                  for (int j = 0; j < 4; ++j) zn[j] = *(const u32x2*)(Z + (size_t)m0_ * 1024 + 4 * lane + 256 * j); }
                for (int i = 0; i < 16; ++i) { const int m = base + i; if (m >= T) break;
                    f32x4 x[4];
#pragma unroll
                    for (int j = 0; j < 4; ++j) { const u32x2 zw = zn[j]; x[j] = (f32x4){bflo(zw.x), bfhi(zw.x), bflo(zw.y), bfhi(zw.y)}; }
                    { const int mn_ = (i + 1 < 16 && m + 1 < T) ? m + 1 : m;
#pragma unroll
                      for (int j = 0; j < 4; ++j) zn[j] = *(const u32x2*)(Z + (size_t)mn_ * 1024 + 4 * lane + 256 * j); }
                    ln_row(x, g1, b1, lane); store_row_bf16(Hb + (size_t)m * 1024, x, lane);
                    float sel[16], aff[16];
                    { float acc[16];
#pragma unroll
                      for (int e = 0; e < 16; ++e) { float a_ = 0.f;
#pragma unroll
                          for (int j = 0; j < 4; ++j) { const f32x4 w = *(const LAS f32x4*)(rwT + e * 1024 + 4 * lane + 256 * j); a_ += x[j][0] * w[0] + x[j][1] * w[1] + x[j][2] * w[2] + x[j][3] * w[3]; }
                          acc[e] = a_; }
                      float v8[8], v4[4], v2[2], v1;
                      { const bool hi = (lane & 32) != 0;
#pragma unroll
                        for (int e = 0; e < 8; ++e) { const float rcv = __shfl_xor(hi ? acc[e] : acc[e + 8], 32); v8[e] = (hi ? acc[e + 8] : acc[e]) + rcv; } }
                      { const bool hi = (lane & 16) != 0;
#pragma unroll
                        for (int e = 0; e < 4; ++e) { const float rcv = __shfl_xor(hi ? v8[e] : v8[e + 4], 16); v4[e] = (hi ? v8[e + 4] : v8[e]) + rcv; } }
                      { const bool hi = (lane & 8) != 0;
#pragma unroll
                        for (int e = 0; e < 2; ++e) { const float rcv = __shfl_xor(hi ? v4[e] : v4[e + 2], 8); v2[e] = (hi ? v4[e + 2] : v4[e]) + rcv; } }
                      { const bool hi = (lane & 4) != 0; const float rcv = __shfl_xor(hi ? v2[0] : v2[1], 4); v1 = (hi ? v2[1] : v2[0]) + rcv; }
                      v1 += __shfl_xor(v1, 2); v1 += __shfl_xor(v1, 1);
#pragma unroll
                      for (int e = 0; e < 16; ++e) { const float lg = __uint_as_float(__builtin_amdgcn_readlane(__float_as_uint(v1), 32 * (e >> 3) + 16 * ((e >> 2) & 1) + 8 * ((e >> 1) & 1) + 4 * (e & 1)));
                          aff[e] = sigmoidf_(lg); sel[e] = aff[e] + rb[e]; } }
                    int grp = 0; float best = -1e30f;
#pragma unroll
                    for (int gq = 0; gq < 4; ++gq) { float m1 = sel[4 * gq], m2 = -1e30f;
#pragma unroll
                        for (int q = 1; q < 4; ++q) { const float s = sel[4 * gq + q]; if (s > m1) { m2 = m1; m1 = s; } else if (s > m2) m2 = s; }
                        const float sc = m1 + m2; if (sc > best) { best = sc; grp = gq; } }
                    float s4[4], a4[4];
#pragma unroll
                    for (int q = 0; q < 4; ++q) { s4[q] = grp == 0 ? sel[q] : grp == 1 ? sel[4 + q] : grp == 2 ? sel[8 + q] : sel[12 + q]; a4[q] = grp == 0 ? aff[q] : grp == 1 ? aff[4 + q] : grp == 2 ? aff[8 + q] : aff[12 + q]; }
                    int i1 = 0;
#pragma unroll
                    for (int q = 1; q < 4; ++q) if (s4[q] > s4[i1 == 0 ? 0 : i1 == 1 ? 1 : i1 == 2 ? 2 : 3]) i1 = q;
                    int i2 = -1; float b2 = -1e30f;
#pragma unroll
                    for (int q = 0; q < 4; ++q) if (q != i1 && s4[q] > b2) { b2 = s4[q]; i2 = q; }
                    const float a1 = i1 == 0 ? a4[0] : i1 == 1 ? a4[1] : i1 == 2 ? a4[2] : a4[3], a2 = i2 == 0 ? a4[0] : i2 == 1 ? a4[1] : i2 == 2 ? a4[2] : a4[3];
                    const float inv = 1.f / (a1 + a2);
                    if (lane == i) { e0 = grp * 4 + i1; e1 = grp * 4 + i2; g0 = a1 * inv; g1v = a2 * inv; }
                    if (rep_) CV_STEP(); }
                int p0 = 0, p1 = 0, mycount = 0; const unsigned long long lt = (1ull << lane) - 1ull;
#pragma unroll
                for (int e = 0; e < 16; ++e) { const unsigned long long b0 = __ballot(e0 == e), bb1 = __ballot(e1 == e); const int c0 = __popcll(b0);
                    if (lane == e) mycount = c0 + __popcll(bb1); if (e0 == e) p0 = __popcll(b0 & lt); if (e1 == e) p1 = c0 + __popcll(bb1 & lt); }
                int woff = 0; if (lane < 16) woff = __hip_atomic_fetch_add((LAS int*)(MISC + 16) + lane, mycount, __ATOMIC_RELAXED, __HIP_MEMORY_SCOPE_WORKGROUP);
                __syncthreads();
                if (tid < 16 && rep_) cbase[tid] = (int)xb_add(gcnt + tid * 64, (unsigned)cntL[tid]);
                __syncthreads();
                const int wo0 = __shfl(woff, e0 < 0 ? 0 : e0), wo1 = __shfl(woff, e1 < 0 ? 0 : e1);
                if (e0 >= 0 && rep_) { const int m = base + lane; const int q0 = cbase[e0] + wo0 + p0, q1 = cbase[e1] + wo1 + p1;
                    ROWIDX[e0 * CAP + q0] = m; ROWIDX[e1 * CAP + q1] = m; RTE[2 * m] = e0; RTE[2 * m + 1] = e1; RTP[2 * m] = q0; RTP[2 * m + 1] = q1; RTG[2 * m] = g0; RTG[2 * m + 1] = g1v; }
                __syncthreads();
            }
            while (cv_has) CV_STEP();
#undef CV_STEP
#undef DEC_MOE
            if (BOTH(pbase + 7)) GRID_BAR();
        }
        if (PHON(9) && (IN(pbase + 8) || IN(pbase + 9))) { PHASE_IDS LAYER_W
            volatile LAS int* TP = (volatile LAS int*)(MISC + 64); volatile LAS int* CNT = (volatile LAS int*)(MISC + 96);
            if (tid == 0) { int acc = 0; for (int e = 0; e < 16; ++e) { const int cn = (int)xb_ld(gcnt + e * 64); CNT[e] = cn; TP[e] = acc; acc += (cn + 255) >> 8; } TP[16] = acc; }
            __syncthreads();
            if (IN(pbase + 8)) {
                pg8::MoeSched Sd{(const char*)Hb, (const char*)W13T, ROWIDX, TP, CNT, 2048, 1024, (size_t)1024 * 1024 * 2, true, G, v}; pg8::EpiSwiglu E{HS};
                for (int rep_ = (PROBE_REPEAT == 9 ? 0 : 1); rep_ < 2; ++rep_)
                pg8::gemm_phase<pg8::EpiSwiglu, pg8::MoeSched, true>(lds, wid, 1024, 128u, Sd, E);
                if (BOTH(pbase + 8)) GRID_BAR();
            }
            if (IN(pbase + 9)) {
                pg8::MoeSched Sd{(const char*)HS, (const char*)W2T, ROWIDX, TP, CNT, 1024, 512, (size_t)1024 * 512 * 2, false, G, v}; pg8::EpiStore E{YS, 1024, nullptr, 0, false};
                for (int rep_ = (PROBE_REPEAT == 14 ? 0 : 1); rep_ < 2; ++rep_)
                pg8::gemm_phase<pg8::EpiStore, pg8::MoeSched, true>(lds, wid, 512, 128u, Sd, E);
                if (BOTH(pbase + 9)) GRID_BAR();
            }
        }
        if (PHON(10) && IN(pbase + 10)) { PHASE_IDS LAYER_W
            int tp = 0;
            { const int cn = lane < 16 ? (int)xb_ld(gcnt + lane * 64) : 0; const int tl = (cn + 255) >> 8; int inc = tl;
#pragma unroll
              for (int o = 1; o < 16; o <<= 1) { const int n = __shfl_up(inc, o); if (lane >= o) inc += n; }
              tp = inc - tl; }
            const float* g2 = INP[27] + l * 1024; const float* b2 = INP[28] + l * 1024;
            for (int rep_ = (PROBE_REPEAT == 10 ? 0 : 1); rep_ < 2; ++rep_)
            for (int m = gw; m < T; m += NGW) {
                const int e0 = RTE[2 * m], e1 = RTE[2 * m + 1];
                const int r0 = __shfl(tp, e0) * 256 + RTP[2 * m], r1 = __shfl(tp, e1) * 256 + RTP[2 * m + 1]; const float g0 = RTG[2 * m], g1v = RTG[2 * m + 1];
                f32x4 x[4];
#pragma unroll
                for (int j = 0; j < 4; ++j) { const int col = 4 * lane + 256 * j;
                    const u32x2 hw = *(const u32x2*)(Hb + (size_t)m * 1024 + col), y0 = *(const u32x2*)(YS + (size_t)r0 * 1024 + col), y1 = *(const u32x2*)(YS + (size_t)r1 * 1024 + col);
                    x[j][0] = ALPHA * bflo(hw.x) + g0 * bflo(y0.x) + g1v * bflo(y1.x); x[j][1] = ALPHA * bfhi(hw.x) + g0 * bfhi(y0.x) + g1v * bfhi(y1.x);
                    x[j][2] = ALPHA * bflo(hw.y) + g0 * bflo(y0.y) + g1v * bflo(y1.y); x[j][3] = ALPHA * bfhi(hw.y) + g0 * bfhi(y0.y) + g1v * bfhi(y1.y); }
                ln_row(x, g2, b2, lane);
                if (!rep_) continue;
                if (l == NLAYER - 1) {
#pragma unroll
                    for (int j = 0; j < 4; ++j) *(f32x4*)((float*)dout + (size_t)m * 1024 + 4 * lane + 256 * j) = x[j];
                } else store_row_bf16(Hb + (size_t)m * 1024, x, lane);
            }
            if (BOTH(pbase + 10)) GRID_BAR();
        }
    }
#undef IN
#undef BOTH
}

extern "C" void kernel_launch(void* const* d_in, const int* in_sizes, int n_in, void* d_out, int out_size, void* d_ws, size_t ws_size, hipStream_t stream) {
    static int grid = 0;
    if (grid == 0) {
        if (n_in != 29 || out_size != T * DM || ws_size < WS_END) { fprintf(stderr, "kernel_launch: unexpected shapes (n_in %d out %d ws %zu)\n", n_in, out_size, ws_size); grid = -1; return; }
        int dev = 0, cus = 0, per_cu = 0;
        if (hipGetDevice(&dev) != hipSuccess || hipDeviceGetAttribute(&cus, hipDeviceAttributeMultiprocessorCount, dev) != hipSuccess) { grid = -1; return; }
        if (hipFuncSetAttribute((const void*)fwd, hipFuncAttributeMaxDynamicSharedMemorySize, LDS_BYTES) != hipSuccess) { fprintf(stderr, "kernel_launch: hipFuncSetAttribute failed\n"); grid = -1; return; }
        if (hipOccupancyMaxActiveBlocksPerMultiprocessor(&per_cu, (const void*)fwd, 512, LDS_BYTES) != hipSuccess || per_cu < 1) fprintf(stderr, "kernel_launch: occupancy query reports %d\n", per_cu);
        (void)hipGetLastError();
        grid = cus;
    }
    if (grid < 0) return;
    (void)hipMemsetAsync((char*)d_ws + WS_CTL, 0, CTL_BYTES, stream);
    Args a{};
    for (int i = 0; i < 29; ++i) a.in[i] = (const float*)d_in[i];
    a.out = (float*)d_out; a.ws = (unsigned char*)d_ws;
#if MK_PER_PHASE
    for (int p = 0; p < NPHASE; ++p) { a.ph_lo = p; a.ph_hi = p + 1; hipLaunchKernelGGL(fwd, dim3(grid), dim3(512), LDS_BYTES, stream, a); }
#else
    a.ph_lo = 0; a.ph_hi = NPHASE; hipLaunchKernelGGL(fwd, dim3(grid), dim3(512), LDS_BYTES, stream, a);
#endif
}
```

```cpp
#include <hip/hip_runtime.h>
#include <cstdio>
#include <cstdint>

#ifndef MK_PER_PHASE
#define MK_PER_PHASE 0
#endif

#ifndef PROBE_REPEAT
#define PROBE_REPEAT 0
#endif
#ifndef PHMASK
#define PHMASK 0xFFFF
#endif
#define PHON(i) (((PHMASK) >> (i)) & 1)
#define LAS __attribute__((address_space(3)))
#define GAS __attribute__((address_space(1)))
typedef unsigned short bf16;
typedef short bf16x8 __attribute__((ext_vector_type(8)));
typedef short s16x4 __attribute__((ext_vector_type(4)));
typedef float f32x2 __attribute__((ext_vector_type(2)));
typedef float f32x4 __attribute__((ext_vector_type(4)));
typedef float f32x16 __attribute__((ext_vector_type(16)));
typedef unsigned u32x2 __attribute__((ext_vector_type(2)));
typedef unsigned u32x4 __attribute__((ext_vector_type(4)));
typedef __bf16 bf16x2_t __attribute__((ext_vector_type(2)));
typedef short v4i16_t __attribute__((ext_vector_type(4)));

constexpr int T = 32768, S = 8192, NB = 4, DM = 1024, NLAYER = 2;
constexpr int IN_W = 6328;
constexpr int PW = 3328;
constexpr int PC_NQ = 0, PC_KC = 512, PC_VC = 640, PC_KS = 768, PC_VS = 896, PC_KW = 1024, PC_VW = 1152, PC_DQ = 1280, PC_DK = 1792, PC_DV = 2304,
              PC_CQ = 2816, PC_CKV = 3072, PC_KR = 3200, PC_NG = 3232;
constexpr float LOG2E = 1.4426950408889634f;
constexpr float ALPHA = 1.4142135623730951f;
constexpr int NEXP = 16, CAP = 32768, DFF = 512;

constexpr size_t MiB = 1u << 20;
constexpr size_t WS_CTL = 0, CTL_BYTES = 128 * 1024;
constexpr size_t WS_CS = 1 * MiB;
constexpr size_t WS_MISC = 2 * MiB;
constexpr size_t WS_RSQ = 3 * MiB;
constexpr size_t WS_RSKV = WS_RSQ + 256 * 1024;
constexpr size_t WS_RTE = 4 * MiB;
constexpr size_t WS_RTP = WS_RTE + 512 * 1024;
constexpr size_t WS_RTG = WS_RTP + 512 * 1024;
constexpr size_t WS_ROWIDX = 6 * MiB;
constexpr size_t WS_KCMP = 8 * MiB;
constexpr size_t WS_VCMP = WS_KCMP + 512 * 1024;
constexpr size_t WS_UL = 10 * MiB;
constexpr size_t WS_WTS = 32 * MiB;
constexpr size_t WL_WIN = 0, WL_WG = 7 * MiB, WL_WBR = 13 * MiB, WL_WOUT = 16 * MiB, WL_WUQ = 18 * MiB, WL_WUKV = 18 * MiB + 512 * 1024, WL_WC1 = 19 * MiB, WL_STRIDE = 22 * MiB;
constexpr size_t WS_HB = 76 * MiB;
constexpr size_t WS_P = 140 * MiB;
constexpr size_t WS_HS = WS_P + 136 * MiB;
constexpr size_t WS_GS = 348 * MiB;
constexpr size_t WS_END = 444 * MiB;
constexpr size_t DO_QM = 0, DO_KVM = 48 * MiB, DO_W13 = 0, DO_W2 = 32 * MiB;

constexpr int CW_BAR = 4096;
constexpr int CW_CNT = 16384;

constexpr int LDS_RING = 131072, LDS_MISC = 131072, LDS_BYTES = 147456;
constexpr int NPHASE = 1 + 11 * NLAYER;

__device__ __forceinline__ int lane_id_v() { int l; asm volatile("v_mbcnt_lo_u32_b32 %0, -1, 0\n\tv_mbcnt_hi_u32_b32 %0, -1, %0" : "=v"(l)); return l; }
__device__ __forceinline__ unsigned f2bf(float f) { unsigned u = __builtin_bit_cast(unsigned, f); return (u + 0x7fffu + ((u >> 16) & 1u)) >> 16; }
__device__ __forceinline__ unsigned pk2(float lo, float hi) { f32x2 v = {lo, hi}; bf16x2_t b = __builtin_convertvector(v, bf16x2_t); return __builtin_bit_cast(unsigned, b); }
__device__ __forceinline__ float bflo(unsigned w) { return __uint_as_float(w << 16); }
__device__ __forceinline__ float bfhi(unsigned w) { return __uint_as_float(w & 0xffff0000u); }
__device__ __forceinline__ float bf2f(bf16 v) { return __uint_as_float(((unsigned)v) << 16); }
__device__ __forceinline__ float fexp2(float x) { return __builtin_amdgcn_exp2f(x); }
__device__ __forceinline__ float sigmoidf_(float x) { return 1.0f / (1.0f + __expf(-x)); }
__device__ __forceinline__ float wave_sum(float v) {
#pragma unroll
    for (int o = 1; o < 64; o <<= 1) v += __shfl_xor(v, o);
    return v;
}
__device__ __forceinline__ float hmax(float v) { auto rr = __builtin_amdgcn_permlane32_swap(__float_as_uint(v), __float_as_uint(v), false, false); return fmaxf(__uint_as_float(rr[0]), __uint_as_float(rr[1])); }
__device__ __forceinline__ float hsum(float v) { auto rr = __builtin_amdgcn_permlane32_swap(__float_as_uint(v), __float_as_uint(v), false, false); return __uint_as_float(rr[0]) + __uint_as_float(rr[1]); }

#define XB_TMO      128
#define XB_XCNT(j)  (256  + 64 * (j))
#define XB_XSUB(j)  (1280 + 64 * (j))
#define XB_XGEN(j)  (2304 + 64 * (j))
#define XB_TOP      3328
#define XB_TOPGEN   3392
#define XCD_BAR_WORDS 3456
#define XB_SPIN_CAP (1u << 23)
__device__ __forceinline__ unsigned xb_ld(unsigned* p)              { return __hip_atomic_load(p, __ATOMIC_RELAXED, __HIP_MEMORY_SCOPE_AGENT); }
__device__ __forceinline__ unsigned xb_add(unsigned* p, unsigned v) { return __hip_atomic_fetch_add(p, v, __ATOMIC_RELAXED, __HIP_MEMORY_SCOPE_AGENT); }
__device__ __forceinline__ unsigned xb_xcc_id() { return (unsigned)__builtin_amdgcn_s_getreg((3 << 11) | 20) & 0xFu; }
#define XB_SPIN(cond, bar) do { unsigned _sp = 0; while (cond) { __builtin_amdgcn_s_sleep(1); \
    if ((++_sp & 255u) == 0u) { if (xb_ld(&(bar)[XB_TMO])) break; if (_sp > XB_SPIN_CAP) { atomicAdd(&(bar)[XB_TMO], 1u); break; } } } } while (0)
struct XcdBarrier { unsigned* bar; unsigned x; volatile LAS unsigned* st; };
__device__ __forceinline__ XcdBarrier xcd_barrier_post(unsigned* bar, volatile LAS unsigned* st) {
    XcdBarrier b; b.bar = bar; b.x = xb_xcc_id(); b.st = st;
    if (threadIdx.x == 0) (void)xb_add(&bar[XB_XCNT(b.x)], 1u);
    return b;
}
__device__ __forceinline__ void xcd_barrier_complete(unsigned* bar, unsigned x, unsigned& nloc, unsigned& nx) {
    const unsigned G = gridDim.x * gridDim.y * gridDim.z;
    unsigned sum, cnt, mine, sp = 0u;
    for (;;) {
        sum = 0u; cnt = 0u; mine = 0u;
#pragma unroll
        for (unsigned j = 0; j < 16; ++j) { const unsigned c = xb_ld(&bar[XB_XCNT(j)]); sum += c; cnt += (c > 0u) ? 1u : 0u; mine = (j == x) ? c : mine; }
        if (sum == G) break;
        __builtin_amdgcn_s_sleep(1);
        if ((++sp & 255u) == 0u) { if (xb_ld(&bar[XB_TMO])) break; if (sp > XB_SPIN_CAP) { atomicAdd(&bar[XB_TMO], 1u); break; } }
    }
    nloc = mine > 0u ? mine : 1u; nx = cnt > 0u ? cnt : 1u;
}
__device__ __forceinline__ void xcd_barrier(const XcdBarrier& b) {
    asm volatile("s_waitcnt vmcnt(0)" ::: "memory");
    __syncthreads();
    if (threadIdx.x == 0) {
        unsigned* bar = b.bar;
        __builtin_amdgcn_s_waitcnt(0);
        unsigned nloc = b.st[0], nx = b.st[1];
        if (nloc == 0u) { xcd_barrier_complete(bar, b.x, nloc, nx); b.st[0] = nloc; b.st[1] = nx; }
        const unsigned old = xb_add(&bar[XB_XSUB(b.x)], 1u);
        const unsigned gen = old / nloc;
        if (old + 1u == (gen + 1u) * nloc) {
            __builtin_amdgcn_fence(__ATOMIC_RELEASE, "agent");
            asm volatile("s_waitcnt vmcnt(0)" ::: "memory");
            const unsigned og = xb_add(&bar[XB_TOP], 1u);
            const unsigned tg = og / nx;
            if (og + 1u == (tg + 1u) * nx) xb_add(&bar[XB_TOPGEN], 1u);
            else XB_SPIN(xb_ld(&bar[XB_TOPGEN]) == tg, bar);
            __builtin_amdgcn_fence(__ATOMIC_ACQUIRE, "agent");
            xb_add(&bar[XB_XGEN(b.x)], 1u);
            asm volatile("s_waitcnt vmcnt(0)" ::: "memory");
        } else {
            XB_SPIN(xb_ld(&bar[XB_XGEN(b.x)]) == gen, bar);
            __builtin_amdgcn_fence(__ATOMIC_ACQUIRE, "agent");
            asm volatile("s_waitcnt vmcnt(0)" ::: "memory");
        }
    }
    __syncthreads();
}

namespace pg8 {
constexpr int BM = 256, BK = 64, HALF = 128, HTB = HALF * BK * 2, STAGE_BYTES = 8 * HTB;
__device__ __forceinline__ int lds_byte(int r, int c) { const int st = (r >> 4) * 2 + (c >> 5), rr = r & 15, cc = c & 31, ob = rr * 64 + cc * 2; return st * 1024 + (ob ^ (((ob >> 9) & 1) << 5)); }
__device__ __forceinline__ void stage_rc(int b, int& R, int& C) { const int st = b / 1024, sb = b % 1024, swz = sb ^ (((sb >> 9) & 1) << 5); R = (st >> 1) * 16 + swz / 64; C = (st & 1) * 32 + (swz % 64) / 2; }
__device__ __forceinline__ int perm32(int rho) { const int n = rho >> 4, i = rho & 15; return 8 * (i >> 2) + 4 * n + (i & 3); }
struct Unit { int pm, pn, e; };
__device__ __forceinline__ void glds16_s(const void* sbase, unsigned voff, unsigned lds_dst) { unsigned keep;
    asm volatile("s_mov_b32 %0, m0\n\ts_mov_b32 m0, %3\n\ts_nop 0\n\tglobal_load_lds_dwordx4 %1, %2\n\ts_mov_b32 m0, %0" : "=&s"(keep) : "v"(voff), "s"(sbase), "s"(lds_dst) : "memory"); }
template <class Epi, class Sched, bool ALIGN_EPI>
__device__ __forceinline__ void gemm_phase(LAS unsigned char* lds, const int wid_in, const int K, const unsigned kstepA, const Sched& S, const Epi& E) {
    const int wid = wid_in, lane = lane_id_v(), tid = wid * 64 + lane, wr = wid >> 2, wc = wid & 3, fr = lane & 15, fq = lane >> 4;
    const int nt = K / BK;
    int Rr[2], Cc[2]; unsigned voffB[2];
#pragma unroll
    for (int i = 0; i < 2; ++i) { int R, C; stage_rc(tid * 16 + i * 8192, R, C); Rr[i] = R; Cc[i] = C; const int Rb = (R & ~31) + perm32(R & 31); voffB[i] = (unsigned)(Rb * K + C) * 2u; }
    const size_t kstepB = (size_t)(BK * 2);
    const size_t hstepB = (size_t)HALF * K * 2;
    const unsigned ldsb = (unsigned)(uintptr_t)lds + (unsigned)wid * 1024u;
    const int aoff = lds_byte(wr * 64 + fr, fq * 8), boff = lds_byte(wc * 32 + fr, fq * 8);
#define PG8_SA(b, h) (((b) * 2 + (h)) * HTB)
#define PG8_SB(b, h) ((4 + (b) * 2 + (h)) * HTB)
#define PG8_STAGE(bufoff, gbase, voff) do { _Pragma("unroll") for (int _i = 0; _i < 2; ++_i) \
        glds16_s((const void*)(gbase), (voff)[_i], ldsb + (unsigned)((bufoff) + _i * 8192)); } while (0)
#define PG8_LDA(dst, b, h) do { _Pragma("unroll") for (int m = 0; m < 4; ++m) _Pragma("unroll") for (int k = 0; k < 2; ++k) dst[m][k] = *(const LAS bf16x8*)(lds + PG8_SA(b, h) + aoff + m * 2048 + k * 1024); } while (0)
#define PG8_LDB(dst, b, h) do { _Pragma("unroll") for (int n = 0; n < 2; ++n) _Pragma("unroll") for (int k = 0; k < 2; ++k) dst[n][k] = *(const LAS bf16x8*)(lds + PG8_SB(b, h) + boff + n * 2048 + k * 1024); } while (0)
#define PG8_MMA(ai, bj, At, Bt) do { __builtin_amdgcn_s_setprio(1); _Pragma("unroll") for (int m = 0; m < 4; ++m) _Pragma("unroll") for (int n = 0; n < 2; ++n) _Pragma("unroll") for (int k = 0; k < 2; ++k) \
        acc[ai][bj][m][n] = __builtin_amdgcn_mfma_f32_16x16x32_bf16(Bt[n][k], At[m][k], acc[ai][bj][m][n], 0, 0, 0); __builtin_amdgcn_s_setprio(0); } while (0)
#define PG8_WAIT_V(n) asm volatile("s_waitcnt vmcnt(" #n ")" ::: "memory")
#define PG8_WAIT_L(n) asm volatile("s_waitcnt lgkmcnt(" #n ")" ::: "memory")
#define PG8_BAR __builtin_amdgcn_s_barrier()
#define PG8_SCHED __builtin_amdgcn_sched_barrier(0)
    Unit cur, nxt; int ui = 0;
    if (!S.next(0, cur)) return;
    f32x4 acc[2][2][4][2];
#pragma unroll
    for (int a = 0; a < 2; ++a)
#pragma unroll
        for (int b = 0; b < 2; ++b)
#pragma unroll
            for (int m = 0; m < 4; ++m)
#pragma unroll
                for (int n = 0; n < 2; ++n) acc[a][b][m][n] = (f32x4){0.f, 0.f, 0.f, 0.f};
    bf16x8 At[4][2], B0[2][2], B1[2][2];
    const char* cA; const char* cB; unsigned vc[2][2], vn[2][2];
    S.ptrs(cur, cA, cB); S.aoff(cur, Rr, Cc, vc);
    unsigned ksA = kstepA, ksN = kstepA;
    if constexpr (Sched::VAR_KSTEP) { ksA = S.kstep(cur); ksN = ksA; }
    PG8_STAGE(PG8_SB(0, 0), cB, voffB); PG8_STAGE(PG8_SB(0, 1), cB + hstepB, voffB); PG8_STAGE(PG8_SA(0, 0), cA, vc[0]); PG8_STAGE(PG8_SA(0, 1), cA, vc[1]);
    if (wr == 1) PG8_BAR;
    PG8_WAIT_V(2); PG8_BAR;
    PG8_STAGE(PG8_SB(1, 0), cB + kstepB, voffB); PG8_STAGE(PG8_SA(1, 0), cA + ksA, vc[0]); PG8_STAGE(PG8_SB(1, 1), cB + hstepB + kstepB, voffB);
    PG8_WAIT_V(6); PG8_BAR;
    for (;;) {
        const bool has_next = S.next(ui + 1, nxt);
        const char* nA = cA; const char* nB = cB;
        if (has_next) { S.ptrs(nxt, nA, nB); if constexpr (Sched::PER_UNIT_AOFF && !Sched::AOFF_CHEAP) S.aoff(nxt, Rr, Cc, vn); if constexpr (Sched::VAR_KSTEP) ksN = S.kstep(nxt); }
        else if constexpr (Sched::PER_UNIT_AOFF) {
            if constexpr (Sched::AOFF_CHEAP) nxt = cur;
#pragma unroll
            for (int h = 0; h < 2; ++h)
#pragma unroll
                for (int i = 0; i < 2; ++i) vn[h][i] = vc[h][i];
        }
        for (int t = 0; t < nt; t += 2) {
            const bool last = (t == nt - 2);
            const char* a1 = cA + (size_t)(t + 1) * ksA;
            const char* a2 = last ? nA : cA + (size_t)(t + 2) * ksA; const char* b2 = last ? nB : cB + (size_t)(t + 2) * kstepB;
            const char* a3 = a2 + (last ? ksN : ksA); const char* b3 = b2 + kstepB;
#define PG8_STAGE_A2(bufoff, gbase, h) do { if constexpr (Sched::PER_UNIT_AOFF) { if (last) { if constexpr (Sched::AOFF_CHEAP) { unsigned vt_[2][2]; S.aoff(nxt, Rr, Cc, vt_); PG8_STAGE(bufoff, gbase, vt_[h]); } else PG8_STAGE(bufoff, gbase, vn[h]); } else PG8_STAGE(bufoff, gbase, vc[h]); } else PG8_STAGE(bufoff, gbase, vc[h]); } while (0)
            PG8_LDB(B0, 0, 0); PG8_LDB(B1, 0, 1); PG8_SCHED; PG8_LDA(At, 0, 0); PG8_STAGE(PG8_SA(1, 1), a1, vc[1]);
            PG8_WAIT_V(8); PG8_WAIT_L(0); PG8_BAR; PG8_MMA(0, 0, At, B0); PG8_MMA(0, 1, At, B1); PG8_BAR; PG8_SCHED;
            PG8_LDA(At, 0, 1); PG8_STAGE(PG8_SB(0, 0), b2, voffB); PG8_STAGE(PG8_SB(0, 1), b2 + hstepB, voffB); PG8_STAGE_A2(PG8_SA(0, 0), a2, 0);
            PG8_WAIT_V(8); PG8_WAIT_L(0); PG8_BAR; PG8_MMA(1, 0, At, B0); PG8_MMA(1, 1, At, B1); PG8_BAR; PG8_SCHED;
            PG8_LDB(B0, 1, 0); PG8_LDB(B1, 1, 1); PG8_SCHED; PG8_LDA(At, 1, 0); PG8_STAGE_A2(PG8_SA(0, 1), a2, 1);
            PG8_WAIT_V(8); PG8_WAIT_L(0); PG8_BAR; PG8_MMA(0, 0, At, B0); PG8_MMA(0, 1, At, B1); PG8_BAR; PG8_SCHED;
            PG8_LDA(At, 1, 1); PG8_STAGE(PG8_SB(1, 0), b3, voffB); PG8_STAGE(PG8_SB(1, 1), b3 + hstepB, voffB); PG8_STAGE_A2(PG8_SA(1, 0), a3, 0);
            PG8_WAIT_V(8); PG8_WAIT_L(0); PG8_BAR; PG8_MMA(1, 0, At, B0); PG8_MMA(1, 1, At, B1); PG8_BAR; PG8_SCHED;
        }
        if constexpr (ALIGN_EPI) { if (wr == 0) PG8_BAR; }
        E(acc, cur, wr, wc, fr, fq);
        if (!has_next) break;
        bool keep = false; if constexpr (Epi::CHAIN) keep = E.keep(cur);
        if (!keep) {
#pragma unroll
        for (int a = 0; a < 2; ++a)
#pragma unroll
            for (int b = 0; b < 2; ++b)
#pragma unroll
                for (int m = 0; m < 4; ++m)
#pragma unroll
                    for (int n = 0; n < 2; ++n) acc[a][b][m][n] = (f32x4){0.f, 0.f, 0.f, 0.f};
        }
        cur = nxt; cA = nA; cB = nB; ++ui; ksA = ksN;
        if constexpr (Sched::PER_UNIT_AOFF) {
            if constexpr (Sched::AOFF_CHEAP) S.aoff(cur, Rr, Cc, vc);
            else {
#pragma unroll
            for (int h = 0; h < 2; ++h)
#pragma unroll
                for (int i = 0; i < 2; ++i) vc[h][i] = vn[h][i];
            }
        }
        if constexpr (ALIGN_EPI) { if (wr == 1) PG8_BAR; }
    }
    PG8_WAIT_V(0);
    if constexpr (!ALIGN_EPI) { if (wr == 0) PG8_BAR; }
    PG8_BAR;
#undef PG8_SA
#undef PG8_SB
#undef PG8_STAGE
#undef PG8_STAGE_A2
#undef PG8_LDA
#undef PG8_LDB
#undef PG8_MMA
#undef PG8_WAIT_V
#undef PG8_WAIT_L
#undef PG8_BAR
#undef PG8_SCHED
}

struct TileSched {
    static constexpr bool AOFF_CHEAP = false;
    static constexpr bool VAR_KSTEP = false;
    static constexpr bool PER_UNIT_AOFF = false;
    const char* A; const char* Bt; int lda; int K; int nN; int ntot; int G; int v;
    __device__ __forceinline__ bool next(int i, Unit& u) const { const int L = i * G + v; if (L >= ntot) return false; u.pm = L / nN; u.pn = L % nN; u.e = i; return true; }
    __device__ __forceinline__ void ptrs(const Unit& u, const char*& cA, const char*& cB) const { cA = A + (size_t)u.pm * 256 * lda; cB = Bt + (size_t)u.pn * 256 * K * 2; }
    __device__ __forceinline__ void aoff(const Unit&, const int (&R)[2], const int (&C)[2], unsigned (&vo)[2][2]) const {
#pragma unroll
        for (int h = 0; h < 2; ++h)
#pragma unroll
            for (int i = 0; i < 2; ++i) vo[h][i] = (unsigned)((h * 128 + R[i]) * lda + C[i] * 2);
    }
};
struct CmpSched {
    static constexpr bool AOFF_CHEAP = false;
    static constexpr bool VAR_KSTEP = false;
    static constexpr bool PER_UNIT_AOFF = false;
    const char* P; const char* W; int G; int v;
    __device__ __forceinline__ bool next(int i, Unit& u) const { const int L = i * G + v; if (L >= 64) return false; u.pm = (L >> 1) & 1; u.pn = L & 1; u.e = L >> 2; return true; }
    __device__ __forceinline__ void ptrs(const Unit& u, const char*& cA, const char*& cB) const {
        const int kv = u.e >> 3, b = (u.e >> 1) & 3, g = u.e & 1;
        cA = P + ((size_t)(b * S + u.pm * 4096) * PW + PC_KC + kv * 128 + g * 64) * 2; cB = W + (size_t)kv * (512 * 1024 * 2) + (size_t)u.pn * 256 * 2048; }
    __device__ __forceinline__ void aoff(const Unit&, const int (&R)[2], const int (&C)[2], unsigned (&vo)[2][2]) const {
#pragma unroll
        for (int h = 0; h < 2; ++h)
#pragma unroll
            for (int i = 0; i < 2; ++i) vo[h][i] = (unsigned)((h * 128 + R[i]) * (16 * PW * 2) + C[i] * 2);
    }
};
struct MoeSched {
    static constexpr bool VAR_KSTEP = false, AOFF_CHEAP = false;
    static constexpr bool PER_UNIT_AOFF = true;
    const char* A; const char* W; const int* rowidx; const volatile LAS int* TP; const volatile LAS int* CNT; int lda; int K; size_t wstride; bool gather; int G; int v;
    __device__ __forceinline__ bool next(int i, Unit& u) const {
        const int L = i * G + v; const int rt = L >> 2; if (rt >= __builtin_amdgcn_readfirstlane(TP[16])) return false;
        int e = 0;
#pragma unroll
        for (int j = 1; j < 16; ++j) e += (rt >= TP[j]) ? 1 : 0;
        u.pm = rt; u.pn = L & 3; u.e = __builtin_amdgcn_readfirstlane(e); return true; }
    __device__ __forceinline__ void ptrs(const Unit& u, const char*& cA, const char*& cB) const {
        cA = gather ? A : A + (size_t)u.pm * 256 * lda; cB = W + (size_t)u.e * wstride + (size_t)u.pn * 256 * K * 2; }
    __device__ __forceinline__ void aoff(const Unit& u, const int (&R)[2], const int (&C)[2], unsigned (&vo)[2][2]) const {
        if (gather) {
            const int r0 = (u.pm - __builtin_amdgcn_readfirstlane(TP[u.e])) * 256, cnt = __builtin_amdgcn_readfirstlane(CNT[u.e]);
#pragma unroll
            for (int h = 0; h < 2; ++h)
#pragma unroll
                for (int i = 0; i < 2; ++i) { int r = r0 + h * 128 + R[i]; r = r < cnt ? r : 0; const int tok = rowidx[u.e * CAP + r]; vo[h][i] = (unsigned)(tok * lda + C[i] * 2); }
        } else {
#pragma unroll
            for (int h = 0; h < 2; ++h)
#pragma unroll
                for (int i = 0; i < 2; ++i) vo[h][i] = (unsigned)((h * 128 + R[i]) * lda + C[i] * 2);
        }
    }
};

struct EpiStore {
    static constexpr bool CHAIN = false;
    bf16* O; int ldc; const float* rscale; size_t estride; bool remap160;
    __device__ __forceinline__ void operator()(const f32x4 (&acc)[2][2][4][2], const Unit& u, int wr, int wc, int fr, int fq) const {
        bf16* base = O + (estride ? (size_t)u.e * estride : (size_t)0);
        const int row0 = u.pm * 256 + wr * 64 + fr; int col0 = u.pn * 256 + wc * 32 + 8 * fq; int bjs = 128;
        if (remap160) { const int cm = col0 & 127; col0 = (col0 >> 7) * 160 + (cm < 64 ? cm : cm + 32); bjs = 160; }
#pragma unroll
        for (int ai = 0; ai < 2; ++ai)
#pragma unroll
            for (int m = 0; m < 4; ++m) { const int row = row0 + ai * 128 + m * 16; const float sc = rscale ? rscale[row] : 1.f; bf16* rowp = base + (size_t)row * ldc + col0;
#pragma unroll
                for (int bj = 0; bj < 2; ++bj) { const f32x4 v0 = acc[ai][bj][m][0] * sc, v1 = acc[ai][bj][m][1] * sc;
                    u32x4 w; w.x = pk2(v0[0], v0[1]); w.y = pk2(v0[2], v0[3]); w.z = pk2(v1[0], v1[1]); w.w = pk2(v1[2], v1[3]);
                    *(u32x4*)(rowp + bj * bjs) = w; } }
    }
};
struct EpiRope {
    static constexpr bool CHAIN = false;
    bf16* O; const float* CS;
    __device__ __forceinline__ void operator()(const f32x4 (&acc)[2][2][4][2], const Unit& u, int wr, int wc, int fr, int fq) const {
        const int row0 = u.pm * 256 + wr * 64 + fr, col0 = u.pn * 256 + wc * 32 + 8 * fq;
        int i0v[2]; bool rp[2];
#pragma unroll
        for (int bj = 0; bj < 2; ++bj) { const int cm = (col0 + bj * 128) % 96; rp[bj] = cm >= 64; i0v[bj] = rp[bj] ? (cm - 64) >> 1 : 0; }
#pragma unroll
        for (int ai = 0; ai < 2; ++ai)
#pragma unroll
            for (int m = 0; m < 4; ++m) {
                f32x4 ca[2], cb[2];
                const int row = row0 + ai * 128 + m * 16; const int pos = row & (S - 1);
#pragma unroll
                for (int bj = 0; bj < 2; ++bj) { const f32x4* cs = (const f32x4*)(CS + ((size_t)pos * 16 + i0v[bj]) * 2); ca[bj] = cs[0]; cb[bj] = cs[1]; }
                bf16* rowp = O + (size_t)row * 768 + col0;
#pragma unroll
                for (int bj = 0; bj < 2; ++bj) { f32x4 v[2] = {acc[ai][bj][m][0], acc[ai][bj][m][1]};
                    if (rp[bj]) {
                        const f32x4 a = ca[bj], b = cb[bj];
                        f32x4 r0, r1;
                        r0[0] = v[0][0] * a[0] - v[0][1] * a[1]; r0[1] = v[0][0] * a[1] + v[0][1] * a[0];
                        r0[2] = v[0][2] * a[2] - v[0][3] * a[3]; r0[3] = v[0][2] * a[3] + v[0][3] * a[2];
                        r1[0] = v[1][0] * b[0] - v[1][1] * b[1]; r1[1] = v[1][0] * b[1] + v[1][1] * b[0];
                        r1[2] = v[1][2] * b[2] - v[1][3] * b[3]; r1[3] = v[1][2] * b[3] + v[1][3] * b[2];
                        v[0] = r0; v[1] = r1; }
                    u32x4 w; w.x = pk2(v[0][0], v[0][1]); w.y = pk2(v[0][2], v[0][3]); w.z = pk2(v[1][0], v[1][1]); w.w = pk2(v[1][2], v[1][3]);
                    *(u32x4*)(rowp + bj * 128) = w; }
                asm volatile("" ::: "memory");
            }
    }
};
struct EpiGate {
    static constexpr bool CHAIN = false;
    bf16* GS;
    __device__ __forceinline__ void operator()(const f32x4 (&acc)[2][2][4][2], const Unit& u, int wr, int wc, int fr, int fq) const {
        bf16* base = GS + (size_t)u.e * 65536; const int row0 = wr * 64 + fr, col0 = wc * 32 + 8 * fq;
#pragma unroll
        for (int ai = 0; ai < 2; ++ai)
#pragma unroll
            for (int m = 0; m < 4; ++m) { bf16* rowp = base + (row0 + ai * 128 + m * 16) * 256 + col0;
#pragma unroll
                for (int bj = 0; bj < 2; ++bj) { const f32x4 v0 = acc[ai][bj][m][0], v1 = acc[ai][bj][m][1];
#define SG_(x) fmaxf(sigmoidf_(x), 1.0e-30f)
                    u32x4 w; w.x = pk2(SG_(v0[0]), SG_(v0[1])); w.y = pk2(SG_(v0[2]), SG_(v0[3])); w.z = pk2(SG_(v1[0]), SG_(v1[1])); w.w = pk2(SG_(v1[2]), SG_(v1[3]));
#undef SG_
                    *(u32x4*)(rowp + bj * 128) = w; } }
    }
};
struct EpiBranch {
    static constexpr bool CHAIN = false;
    bf16* Y; const bf16* GS; bool first;
    __device__ __forceinline__ void operator()(const f32x4 (&acc)[2][2][4][2], const Unit& u, int wr, int wc, int fr, int fq) const {
        const bf16* gbase = GS + (size_t)u.e * 65536; const int lrow0 = wr * 64 + fr, lcol0 = wc * 32 + 8 * fq;
#pragma unroll
        for (int ai = 0; ai < 2; ++ai)
#pragma unroll
            for (int mp = 0; mp < 2; ++mp) {
                u32x4 gwv[2][2], yov[2][2];
#pragma unroll
                for (int mm = 0; mm < 2; ++mm)
#pragma unroll
                    for (int bj = 0; bj < 2; ++bj) { const int lrow = lrow0 + ai * 128 + (2 * mp + mm) * 16;
                        gwv[mm][bj] = *(const u32x4*)(gbase + lrow * 256 + lcol0 + bj * 128);
                        if (!first) yov[mm][bj] = *(const u32x4*)(Y + (size_t)(u.pm * 256 + lrow) * DM + u.pn * 256 + lcol0 + bj * 128); }
#pragma unroll
                for (int mm = 0; mm < 2; ++mm) { const int m = 2 * mp + mm; const int lrow = lrow0 + ai * 128 + m * 16; bf16* yrow = Y + (size_t)(u.pm * 256 + lrow) * DM + u.pn * 256 + lcol0;
#pragma unroll
                    for (int bj = 0; bj < 2; ++bj) { const f32x4 v0 = acc[ai][bj][m][0], v1 = acc[ai][bj][m][1]; const u32x4 gw = gwv[mm][bj];
                        float r[8] = {v0[0] * bflo(gw.x), v0[1] * bfhi(gw.x), v0[2] * bflo(gw.y), v0[3] * bfhi(gw.y), v1[0] * bflo(gw.z), v1[1] * bfhi(gw.z), v1[2] * bflo(gw.w), v1[3] * bfhi(gw.w)};
                        if (!first) { const u32x4 yo = yov[mm][bj];
                            r[0] += bflo(yo.x); r[1] += bfhi(yo.x); r[2] += bflo(yo.y); r[3] += bfhi(yo.y); r[4] += bflo(yo.z); r[5] += bfhi(yo.z); r[6] += bflo(yo.w); r[7] += bfhi(yo.w); }
                        u32x4 w; w.x = pk2(r[0], r[1]); w.y = pk2(r[2], r[3]); w.z = pk2(r[4], r[5]); w.w = pk2(r[6], r[7]);
                        *(u32x4*)(yrow + bj * 128) = w; } }
            }
    }
};
struct EpiResid {
    static constexpr bool CHAIN = false;
    bf16* Z; const bf16* H;
    __device__ __forceinline__ void operator()(const f32x4 (&acc)[2][2][4][2], const Unit& u, int wr, int wc, int fr, int fq) const {
        const int row0 = u.pm * 256 + wr * 64 + fr, col0 = u.pn * 256 + wc * 32 + 8 * fq;
#pragma unroll
        for (int ai = 0; ai < 2; ++ai) {
            u32x4 hv[4][2];
#pragma unroll
            for (int m = 0; m < 4; ++m)
#pragma unroll
                for (int bj = 0; bj < 2; ++bj) hv[m][bj] = *(const u32x4*)(H + (size_t)(row0 + ai * 128 + m * 16) * DM + col0 + bj * 128);
#pragma unroll
            for (int m = 0; m < 4; ++m) { const size_t off = (size_t)(row0 + ai * 128 + m * 16) * DM + col0;
#pragma unroll
                for (int bj = 0; bj < 2; ++bj) { const u32x4 hw = hv[m][bj];
                    const f32x4 o0 = acc[ai][bj][m][0], o1 = acc[ai][bj][m][1];
                    u32x4 w; w.x = pk2(o0[0] + ALPHA * bflo(hw.x), o0[1] + ALPHA * bfhi(hw.x)); w.y = pk2(o0[2] + ALPHA * bflo(hw.y), o0[3] + ALPHA * bfhi(hw.y));
                    w.z = pk2(o1[0] + ALPHA * bflo(hw.z), o1[1] + ALPHA * bfhi(hw.z)); w.w = pk2(o1[2] + ALPHA * bflo(hw.w), o1[3] + ALPHA * bfhi(hw.w));
                    *(u32x4*)(Z + off + bj * 128) = w; } }
        }
    }
};
struct EpiSwiglu {
    static constexpr bool CHAIN = false;
    bf16* HS;
    __device__ __forceinline__ void operator()(const f32x4 (&acc)[2][2][4][2], const Unit& u, int wr, int wc, int fr, int fq) const {
        const int row0 = u.pm * 256 + wr * 64 + fr, col0 = u.pn * 128 + wc * 32 + 8 * fq;
#pragma unroll
        for (int ai = 0; ai < 2; ++ai)
#pragma unroll
            for (int m = 0; m < 4; ++m) { bf16* rowp = HS + (size_t)(row0 + ai * 128 + m * 16) * DFF + col0;
                float r[8];
#pragma unroll
                for (int n = 0; n < 2; ++n)
#pragma unroll
                    for (int q = 0; q < 4; ++q) { const float a = acc[ai][0][m][n][q], b = acc[ai][1][m][n][q]; r[n * 4 + q] = a * sigmoidf_(a) * b; }
                u32x4 w; w.x = pk2(r[0], r[1]); w.y = pk2(r[2], r[3]); w.z = pk2(r[4], r[5]); w.w = pk2(r[6], r[7]);
                *(u32x4*)rowp = w; }
    }
};

struct GateSched {
    static constexpr bool AOFF_CHEAP = false;
    static constexpr bool PER_UNIT_AOFF = false, VAR_KSTEP = false;
    const char* A; const char* Wg; int pm, pn; bool valid;
    __device__ __forceinline__ bool next(int i, Unit& u) const { if (!valid || i >= 3) return false; u.pm = pm; u.pn = pn; u.e = i; return true; }
    __device__ __forceinline__ void ptrs(const Unit& u, const char*& cA, const char*& cB) const { cA = A + (size_t)pm * 256 * 2048; cB = Wg + ((size_t)u.e * 1024 + (size_t)pn * 256) * 2048; }
    __device__ __forceinline__ void aoff(const Unit&, const int (&R)[2], const int (&C)[2], unsigned (&vo)[2][2]) const {
#pragma unroll
        for (int h = 0; h < 2; ++h)
#pragma unroll
            for (int i = 0; i < 2; ++i) vo[h][i] = (unsigned)((h * 128 + R[i]) * 2048 + C[i] * 2);
    }
};
struct ChainSched {
    static constexpr bool AOFF_CHEAP = true;
    static constexpr bool PER_UNIT_AOFF = true, VAR_KSTEP = true;
    const char* Pn; const char* Pd; const char* Qm; const char* Wbr; int pm, pn; bool valid;
    __device__ __forceinline__ bool next(int i, Unit& u) const { if (!valid || i >= 3) return false; u.pm = pm; u.pn = pn; u.e = i; return true; }
    __device__ __forceinline__ int lda(const Unit& u) const { return u.e == 2 ? 1536 : PW * 2; }
    __device__ __forceinline__ unsigned kstep(const Unit& u) const { return u.e == 2 ? 192u : 128u; }
    __device__ __forceinline__ void ptrs(const Unit& u, const char*& cA, const char*& cB) const {
        cA = (u.e == 0 ? Pn : (u.e == 1 ? Pd : Qm)) + (size_t)pm * 256 * lda(u); cB = Wbr + (size_t)u.e * (1024 * 512 * 2) + (size_t)pn * 256 * 1024; }
    __device__ __forceinline__ void aoff(const Unit& u, const int (&R)[2], const int (&C)[2], unsigned (&vo)[2][2]) const { const int ld = lda(u);
#pragma unroll
        for (int h = 0; h < 2; ++h)
#pragma unroll
            for (int i = 0; i < 2; ++i) vo[h][i] = (unsigned)((h * 128 + R[i]) * ld + C[i] * 2);
    }
};
struct EpiChain {
    static constexpr bool CHAIN = true;
    bf16* Y; const bf16* GS;
    __device__ __forceinline__ bool keep(const Unit& u) const { return u.e < 2; }
    __device__ __forceinline__ void operator()(f32x4 (&acc)[2][2][4][2], const Unit& u, int wr, int wc, int fr, int fq) const {
        const int j = u.e; const bf16* ga = GS + (size_t)j * 65536; const bf16* gb = GS + (size_t)(j < 2 ? j + 1 : j) * 65536; const int lrow0 = wr * 64 + fr, lcol0 = wc * 32 + 8 * fq;
#pragma unroll
        for (int ai = 0; ai < 2; ++ai)
#pragma unroll
            for (int m = 0; m < 4; ++m) {
#pragma unroll
                for (int bj = 0; bj < 2; ++bj) { const int off = (lrow0 + ai * 128 + m * 16) * 256 + lcol0 + bj * 128;
                    const u32x4 a = *(const u32x4*)(ga + off); float f[8] = {bflo(a.x), bfhi(a.x), bflo(a.y), bfhi(a.y), bflo(a.z), bfhi(a.z), bflo(a.w), bfhi(a.w)};
                    if (j < 2) { const u32x4 b = *(const u32x4*)(gb + off); const float d[8] = {bflo(b.x), bfhi(b.x), bflo(b.y), bfhi(b.y), bflo(b.z), bfhi(b.z), bflo(b.w), bfhi(b.w)};
#pragma unroll
                        for (int q = 0; q < 8; ++q) f[q] *= __builtin_amdgcn_rcpf(d[q]); }
                    f32x4& v0 = acc[ai][bj][m][0]; f32x4& v1 = acc[ai][bj][m][1];
                    v0[0] *= f[0]; v0[1] *= f[1]; v0[2] *= f[2]; v0[3] *= f[3]; v1[0] *= f[4]; v1[1] *= f[5]; v1[2] *= f[6]; v1[3] *= f[7];
                    if (j == 2) { u32x4 w; w.x = pk2(v0[0], v0[1]); w.y = pk2(v0[2], v0[3]); w.z = pk2(v1[0], v1[1]); w.w = pk2(v1[2], v1[3]);
                        *(u32x4*)(Y + (size_t)(u.pm * 256 + lrow0 + ai * 128 + m * 16) * DM + u.pn * 256 + lcol0 + bj * 128) = w; } }
                asm volatile("" ::: "memory");
            }
    }
};
}

namespace fa {
constexpr float NEG = -1.0e30f;
__device__ __forceinline__ int crow(int i, int hb) { return (i & 3) + 8 * (i >> 2) + 4 * hb; }
__device__ __forceinline__ s16x4 vtr(const LAS char* p) { return __builtin_bit_cast(s16x4, __builtin_amdgcn_ds_read_tr16_b64_v4i16((LAS v4i16_t*)p)); }

template <int DQK>
__device__ __forceinline__ void qk_tile(const LAS char* kl, const bf16x8 (&qf)[DQK / 16], f32x16& s0, f32x16& s1, int r32, int hb) {
    constexpr int KSTR = DQK * 2 + 16, KS = DQK / 16;
    const LAS char* kp = kl + r32 * KSTR + hb * 16;
    bf16x8 k0[KS], k1[KS];
#pragma unroll
    for (int s = 0; s < KS; ++s) { k0[s] = *(const LAS bf16x8*)(kp + s * 32); k1[s] = *(const LAS bf16x8*)(kp + 32 * KSTR + s * 32); }
    __builtin_amdgcn_sched_barrier(0);
    const f32x16 z = {0.f, 0.f, 0.f, 0.f, 0.f, 0.f, 0.f, 0.f, 0.f, 0.f, 0.f, 0.f, 0.f, 0.f, 0.f, 0.f};
    s0 = __builtin_amdgcn_mfma_f32_32x32x16_bf16(k0[0], qf[0], z, 0, 0, 0);
    s1 = __builtin_amdgcn_mfma_f32_32x32x16_bf16(k1[0], qf[0], z, 0, 0, 0);
#pragma unroll
    for (int s = 1; s < KS; ++s) {
        s0 = __builtin_amdgcn_mfma_f32_32x32x16_bf16(k0[s], qf[s], s0, 0, 0, 0);
        s1 = __builtin_amdgcn_mfma_f32_32x32x16_bf16(k1[s], qf[s], s1, 0, 0, 0);
    }
}
template <bool CHECK>
__device__ __forceinline__ void score_tile(f32x16& s0, f32x16& s1, float d0, float kstep, float c1, float slope2, float wlim, bool lanevalid, int hb) {
#pragma unroll
    for (int i = 0; i < 16; ++i) {
        const float k0 = (float)crow(i, hb) * kstep;
        const float da = d0 - k0, db = d0 - k0 - 32.f * kstep;
        float va = __builtin_fmaf(s0[i], c1, -slope2 * da), vb = __builtin_fmaf(s1[i], c1, -slope2 * db);
        if (CHECK) { va = (da >= 0.f && da < wlim && lanevalid) ? va : NEG; vb = (db >= 0.f && db < wlim && lanevalid) ? vb : NEG; }
        s0[i] = va; s1[i] = vb;
    }
}
__device__ __forceinline__ float tile_max(const f32x16& s0, const f32x16& s1) {
    float a = fmaxf(fmaxf(s0[0], s0[1]), s1[0]), b = fmaxf(fmaxf(s0[2], s0[3]), s1[1]);
    a = fmaxf(fmaxf(a, s1[2]), s1[3]);
#pragma unroll
    for (int i = 4; i < 16; i += 4) { a = fmaxf(fmaxf(a, s0[i]), s0[i + 1]); b = fmaxf(fmaxf(b, s0[i + 2]), s0[i + 3]); a = fmaxf(fmaxf(a, s1[i]), s1[i + 1]); b = fmaxf(fmaxf(b, s1[i + 2]), s1[i + 3]); }
    return hmax(fmaxf(a, b));
}
__device__ __forceinline__ void pack_p(const f32x16& s0, const f32x16& s1, bf16x8 (&pa)[4]) {
#pragma unroll
    for (int sp = 0; sp < 2; ++sp) {
        u32x4 w0, w1;
        w0.x = pk2(s0[8 * sp + 0], s0[8 * sp + 1]); w0.y = pk2(s0[8 * sp + 2], s0[8 * sp + 3]); w0.z = pk2(s0[8 * sp + 4], s0[8 * sp + 5]); w0.w = pk2(s0[8 * sp + 6], s0[8 * sp + 7]);
        w1.x = pk2(s1[8 * sp + 0], s1[8 * sp + 1]); w1.y = pk2(s1[8 * sp + 2], s1[8 * sp + 3]); w1.z = pk2(s1[8 * sp + 4], s1[8 * sp + 5]); w1.w = pk2(s1[8 * sp + 6], s1[8 * sp + 7]);
        pa[sp] = __builtin_bit_cast(bf16x8, w0); pa[2 + sp] = __builtin_bit_cast(bf16x8, w1);
    }
}
__device__ __forceinline__ float softmax_step(f32x16& s0, f32x16& s1, float& m, float& l) {
    const float mx = tile_max(s0, s1);
    const float mn = fmaxf(m, mx);
    const float alpha = fexp2(m - mn);
    m = mn;
    float ra = 0.f, rb = 0.f;
#pragma unroll
    for (int i = 0; i < 16; ++i) { s0[i] = fexp2(s0[i] - mn); s1[i] = fexp2(s1[i] - mn); ra += s0[i]; rb += s1[i]; }
    l = l * alpha + hsum(ra + rb);
    return alpha;
}
template <int DV>
__device__ __forceinline__ int v_swz(int key) { return DV == 64 ? (((key >> 1) & 1) << 6) : ((key & 3) << 6); }
template <int DV>
__device__ __forceinline__ void v_load(const LAS char* vl, int lane, int dvb0, bf16x8 (&vf)[2][4]) {
    constexpr int VSTR = DV * 2;
    const int g16 = lane >> 4, i16 = lane & 15, q = i16 >> 2, p = i16 & 3, hb = lane >> 5;
    const int f = (DV == 64) ? ((q >> 1) & 1) : q;
    const int rowb = (4 * hb + q) * VSTR + 2 * (16 * (g16 & 1) + 4 * p);
#pragma unroll
    for (int d = 0; d < 2; ++d) {
        unsigned vba = (unsigned)(uintptr_t)vl + (unsigned)(rowb + (((dvb0 + d) ^ f) << 6));
        asm volatile("" : "+v"(vba));
        const LAS char* vb = (const LAS char*)vba;
#pragma unroll
        for (int ks = 0; ks < 4; ++ks) {
            const s16x4 lo = vtr(vb + (16 * ks) * VSTR), hi = vtr(vb + (16 * ks + 8) * VSTR);
            vf[d][ks] = (bf16x8){lo[0], lo[1], lo[2], lo[3], hi[0], hi[1], hi[2], hi[3]};
        }
    }
}
__device__ __forceinline__ void pv_mma(const bf16x8 (&vf)[2][4], const bf16x8 (&pa)[4], f32x16& oa, f32x16& ob) {
#pragma unroll
    for (int ks = 0; ks < 4; ++ks) {
        oa = __builtin_amdgcn_mfma_f32_32x32x16_bf16(vf[0][ks], pa[ks], oa, 0, 0, 0);
        ob = __builtin_amdgcn_mfma_f32_32x32x16_bf16(vf[1][ks], pa[ks], ob, 0, 0, 0);
    }
}
template <int DV>
__device__ __forceinline__ void pv_tile(const LAS char* vl, const bf16x8 (&pa)[4], f32x16 (&o)[DV / 32], int lane) {
#pragma unroll
    for (int d0 = 0; d0 < DV / 32; d0 += 2) { bf16x8 vf[2][4]; v_load<DV>(vl, lane, d0, vf); __builtin_amdgcn_sched_barrier(0); pv_mma(vf, pa, o[d0], o[d0 + 1]); }
}
}

constexpr int A_KB = 13312, A_VB0 = 26624, A_VB = 16384;
constexpr int A_SC = 61440, A_SM = 129920, A_UN = 130944;
__device__ __forceinline__ float alibi_slope(int idx) { return fexp2(-8.0f * (float)(idx + 1) / 12.0f); }
__device__ __forceinline__ unsigned getw(const u32x4& w, int i) { return i == 0 ? w.x : (i == 1 ? w.y : (i == 2 ? w.z : w.w)); }
__device__ __forceinline__ int next_bit(const u32x4& w, int from) {
    int res = 128;
#pragma unroll
    for (int wi = 3; wi >= 0; --wi) { unsigned x = getw(w, wi); const int lo = wi * 32;
        if (from > lo + 31) x = 0u; else if (from > lo) x &= (~0u) << (from - lo);
        if (x) res = lo + __builtin_ctz(x); }
    return res;
}

struct Ld64 {
    const char* kp; const char* vp; int kstr, vstr; u32x4 rk, rv;
    __device__ __forceinline__ void issue(int key0, int tid, bool withV) { const int row = tid >> 3, ch = tid & 7;
        rk = *(const u32x4*)(kp + (size_t)(key0 + row) * kstr + ch * 16); if (withV) rv = *(const u32x4*)(vp + (size_t)(key0 + row) * vstr + ch * 16); }
    __device__ __forceinline__ void commit(LAS char* kl, LAS char* vl, int tid, bool withV) { const int row = tid >> 3, ch = tid & 7;
        *(LAS u32x4*)(kl + row * 144 + ch * 16) = rk; if (withV) *(LAS u32x4*)(vl + row * 128 + ((ch * 16) ^ fa::v_swz<64>(row))) = rv; }
};
struct LdDiff {
    const char* kp; const char* vp; u32x4 rk, rv0, rv1;
    __device__ __forceinline__ void issue(int key0, int tid) {
        rk = *(const u32x4*)(kp + (size_t)(key0 + (tid >> 3)) * (PW * 2) + (tid & 7) * 16);
        const char* v = vp + (size_t)(key0 + (tid >> 4)) * (PW * 2) + (tid & 15) * 16; rv0 = *(const u32x4*)v; rv1 = *(const u32x4*)(v + (size_t)32 * PW * 2); }
    __device__ __forceinline__ void commit(LAS char* kl, LAS char* vl, int tid) {
        *(LAS u32x4*)(kl + (tid >> 3) * 144 + (tid & 7) * 16) = rk;
        const int row = tid >> 4, off = ((tid & 15) * 16) ^ fa::v_swz<128>(row);
        *(LAS u32x4*)(vl + row * 256 + off) = rv0; *(LAS u32x4*)(vl + (row + 32) * 256 + off) = rv1; }
};
struct LdMla {
    const char* knp; const char* krp; const char* vp; u32x4 rk0, rk1, rv;
    __device__ __forceinline__ const char* ksrc(int key0, int c) const { const int row = c / 12, ch = c - row * 12;
        return ch < 8 ? knp + (size_t)(key0 + row) * 2048 + ch * 16 : krp + (size_t)(key0 + row) * (PW * 2) + (ch - 8) * 16; }
    __device__ __forceinline__ void issue(int key0, int tid) {
        rk0 = *(const u32x4*)ksrc(key0, tid); if (tid < 256) rk1 = *(const u32x4*)ksrc(key0, tid + 512);
        rv = *(const u32x4*)(vp + (size_t)(key0 + (tid >> 3)) * 2048 + (tid & 7) * 16); }
    __device__ __forceinline__ void commit(LAS char* kl, LAS char* vl, int tid) {
        { const int row = tid / 12, ch = tid - row * 12; *(LAS u32x4*)(kl + row * 208 + ch * 16) = rk0; }
        if (tid < 256) { const int c = tid + 512, row = c / 12, ch = c - row * 12; *(LAS u32x4*)(kl + row * 208 + ch * 16) = rk1; }
        const int row = tid >> 3; *(LAS u32x4*)(vl + row * 128 + (((tid & 7) * 16) ^ fa::v_swz<64>(row))) = rv; }
};

template <int DQK, int DV, class Ld>
__device__ __forceinline__ void flash_causal(LAS char* lds, Ld& ld, const bf16x8 (&qf)[DQK / 16], f32x16 (&o)[DV / 32], float& m, float& l,
                                             int q0, int wq0, int t, float c1, float slope2, int tid, int lane, int r32, int hb) {
    const int nt = (q0 + 256) >> 6;
    ld.issue(0, tid); ld.commit(lds, lds + A_VB0, tid); __syncthreads();
    for (int kt = 0; kt < nt; ++kt) {
        const int buf = kt & 1, key0 = 64 * kt;
        if (kt + 1 < nt) ld.issue(key0 + 64, tid);
        if (key0 <= wq0 + 31) {
            f32x16 s0, s1; fa::qk_tile<DQK>(lds + buf * A_KB, qf, s0, s1, r32, hb);
            if (key0 + 63 > wq0) fa::score_tile<true>(s0, s1, (float)(t - key0), 1.f, c1, slope2, 1.0e9f, true, hb);
            else fa::score_tile<false>(s0, s1, (float)(t - key0), 1.f, c1, slope2, 1.0e9f, true, hb);
            const float alpha = fa::softmax_step(s0, s1, m, l);
#pragma unroll
            for (int d = 0; d < DV / 32; ++d) o[d] = o[d] * alpha;
            bf16x8 pa[4]; fa::pack_p(s0, s1, pa);
            fa::pv_tile<DV>(lds + A_VB0 + buf * A_VB, pa, o, lane);
        }
        if (kt + 1 < nt) ld.commit(lds + (buf ^ 1) * A_KB, lds + A_VB0 + (buf ^ 1) * A_VB, tid);
        __syncthreads();
    }
}


#ifndef DIFF_PIPE
#define DIFF_PIPE false
#endif
#ifndef MLA_PIPE
#define MLA_PIPE false
#endif
#ifndef PROBE_VAR
#define PROBE_VAR 0
#endif
namespace fr {
template <int DQK, int DV> struct Geo {
    static constexpr int KS = DQK / 16, NDV = DV / 32;
    static constexpr int KROWB = (DQK == 64) ? 128 : 256;
    static constexpr int KSLOT = 64 * KROWB, VSLOT = 64 * DV * 2;
    static constexpr int KBASE = 0, VBASE = 3 * KSLOT;
    static constexpr int PK = KSLOT / 8192, PV = VSLOT / 8192;
};
template <int DQK> __device__ __forceinline__ void k_offsets(unsigned* vo, int wid, int lane, int strideB) {
    if constexpr (DQK == 64) { const int row = 8 * wid + (lane >> 3), cp = lane & 7, c = cp ^ ((row >> 1) & 7); vo[0] = (unsigned)(row * strideB + c * 16); }
    else {
#pragma unroll
        for (int j = 0; j < 2; ++j) { const int p = wid + 8 * j, row = 4 * p + (lane >> 4), cp = lane & 15; int c = cp ^ (row & 15); if (c >= 12) c = 0; vo[j] = (unsigned)(row * strideB + c * 16); }
    }
}
template <int DV> __device__ __forceinline__ void v_offsets(unsigned* vo, int wid, int lane, int strideB) {
    if constexpr (DV == 64) { const int row = 8 * wid + (lane >> 3), pp = lane & 7, lg = ((((pp >> 2) ^ ((row >> 1) & 1))) << 2) | (pp & 3); vo[0] = (unsigned)(row * strideB + lg * 16); }
    else {
#pragma unroll
        for (int j = 0; j < 2; ++j) { const int p = wid + 8 * j, row = 4 * p + (lane >> 4), pp = lane & 15, lg = (((pp >> 2) ^ (row & 3)) << 2) | (pp & 3); vo[j] = (unsigned)(row * strideB + lg * 16); }
    }
}
template <int DQK, bool BATCH = true>
__device__ __forceinline__ void qk_ring(const LAS char* kl, const int (&ka)[DQK / 16], const bf16x8 (&qf)[DQK / 16], f32x16& s0, f32x16& s1) {
    constexpr int KROWB = (DQK == 64) ? 128 : 256, KS = DQK / 16;
    bf16x8 k0[KS], k1[KS];
#pragma unroll
    for (int s = 0; s < KS; ++s) { unsigned a = (unsigned)(uintptr_t)kl + (unsigned)ka[s]; asm volatile("" : "+v"(a)); const LAS char* kp = (const LAS char*)a;
        k0[s] = *(const LAS bf16x8*)kp; k1[s] = *(const LAS bf16x8*)(kp + 32 * KROWB); }
    if constexpr (BATCH) __builtin_amdgcn_sched_barrier(0);
    const f32x16 z = {0.f, 0.f, 0.f, 0.f, 0.f, 0.f, 0.f, 0.f, 0.f, 0.f, 0.f, 0.f, 0.f, 0.f, 0.f, 0.f};
    s0 = __builtin_amdgcn_mfma_f32_32x32x16_bf16(k0[0], qf[0], z, 0, 0, 0);
    s1 = __builtin_amdgcn_mfma_f32_32x32x16_bf16(k1[0], qf[0], z, 0, 0, 0);
#pragma unroll
    for (int s = 1; s < KS; ++s) {
        s0 = __builtin_amdgcn_mfma_f32_32x32x16_bf16(k0[s], qf[s], s0, 0, 0, 0);
        s1 = __builtin_amdgcn_mfma_f32_32x32x16_bf16(k1[s], qf[s], s1, 0, 0, 0);
    }
}
template <bool ALIBI, bool CHECK, int NDV>
__device__ __forceinline__ void soft_tile(f32x16& s0, f32x16& s1, float c1, float slope2, float d0, int hb, float& m, float& l, f32x16 (&o)[NDV], bf16x8 (&pa)[4]) {
    const float dh = d0 - (float)(4 * hb);
    if constexpr (ALIBI) {
        const float e0 = -slope2 * dh, e1 = e0 + 32.f * slope2;
#pragma unroll
        for (int i = 0; i < 16; ++i) { const float ci = (float)((i & 3) + 8 * (i >> 2)); s0[i] = __builtin_fmaf(s0[i], c1, __builtin_fmaf(slope2, ci, e0)); s1[i] = __builtin_fmaf(s1[i], c1, __builtin_fmaf(slope2, ci, e1)); }
    }
    if constexpr (CHECK) {
#pragma unroll
        for (int i = 0; i < 16; ++i) { const float ci = (float)((i & 3) + 8 * (i >> 2)); if (ci > dh) s0[i] = fa::NEG; if (ci + 32.f > dh) s1[i] = fa::NEG; }
    }
    const float mx = fa::tile_max(s0, s1);
    const float mn = fmaxf(m, mx);
    if (NDV > 2 || __builtin_amdgcn_ballot_w64(mn > m) != 0ull) {
        const float alpha = fexp2(m - mn); l *= alpha;
#pragma unroll
        for (int d = 0; d < NDV; ++d) o[d] = o[d] * alpha;
    }
    m = mn;
    float ra = 0.f, rb = 0.f;
#pragma unroll
    for (int i = 0; i < 16; ++i) {
        s0[i] = fexp2(s0[i] - mn); s1[i] = fexp2(s1[i] - mn);
        ra += s0[i]; rb += s1[i]; }
    l += hsum(ra + rb);
    fa::pack_p(s0, s1, pa);
}
#define FR_WAITBAR(N) asm volatile("s_waitcnt vmcnt(" #N ") lgkmcnt(0)\n\ts_barrier" ::: "memory")
template <int DQK, int DV, bool ALIBI, bool PIPE, int VAR = 0>
__device__ __forceinline__ void flash_ring(LAS char* lds, const char* kbase, const char* vbase, const int strideB, const bf16x8 (&qf)[DQK / 16], f32x16 (&o)[DV / 32], float& m, float& l,
                                           const int q0, const int wq0, const int t, const float c1, const float slope2, const int wid, const int lane) {
    typedef Geo<DQK, DV> GG;
    constexpr int PK = GG::PK, PV = GG::PV, NDV = DV / 32;
    const int r32 = lane & 31, hb = lane >> 5;
    const int nt = (q0 + 256) >> 6, tmax = (wq0 + 31) >> 6;
    const int iskip = nt - 1 - tmax;
    unsigned voK[PK], voV[PV];
    k_offsets<DQK>(voK, wid, lane, strideB); v_offsets<DV>(voV, wid, lane, strideB);
    int ka[DQK / 16];
    { const int f = (DQK == 64) ? ((r32 >> 1) & 7) : (r32 & 15);
#pragma unroll
      for (int s = 0; s < DQK / 16; ++s) ka[s] = r32 * GG::KROWB + (((2 * s + hb) ^ f) << 4); }
    const unsigned ldsb = (unsigned)(uintptr_t)lds + (unsigned)wid * 1024u;
#define FR_ISSUE_K(it) do { const int it_ = (it); const char* b_ = kbase + (size_t)(nt - 1 - it_) * 64 * strideB; const unsigned d_ = ldsb + GG::KBASE + (unsigned)(it_ % 3) * GG::KSLOT; \
        _Pragma("unroll") for (int j_ = 0; j_ < PK; ++j_) pg8::glds16_s(b_, voK[j_], d_ + j_ * 8192); } while (0)
#define FR_ISSUE_V(it) do { const int it_ = (it); const char* b_ = vbase + (size_t)(nt - 1 - it_) * 64 * strideB; const unsigned d_ = ldsb + GG::VBASE + (unsigned)(it_ % 3) * GG::VSLOT; \
        _Pragma("unroll") for (int j_ = 0; j_ < PV; ++j_) pg8::glds16_s(b_, voV[j_], d_ + j_ * 8192); } while (0)
    constexpr int KA = PIPE ? 1 : 0;
#define FR_ISSUE(i_) do { if ((i_) + 2 + KA < nt) FR_ISSUE_K((i_) + 2 + KA); if ((i_) + 2 < nt) FR_ISSUE_V((i_) + 2); } while (0)
#define FR_END(i_) do { if ((i_) + 2 + KA < nt) { if constexpr (PK + PV == 2) FR_WAITBAR(2); else FR_WAITBAR(3); } \
        else if ((i_) + 2 < nt) { if constexpr (PV == 1) FR_WAITBAR(1); else FR_WAITBAR(2); } else FR_WAITBAR(0); } while (0)
#define FR_KSLOT(i_) (lds + GG::KBASE + ((i_) % 3) * GG::KSLOT)
#define FR_VSLOT(i_) (lds + GG::VBASE + ((i_) % 3) * GG::VSLOT)
    FR_ISSUE_K(0); if constexpr (PIPE) FR_ISSUE_K(1); FR_ISSUE_V(0);
    FR_ISSUE_K(1 + KA); FR_ISSUE_V(1);
    if constexpr (PK + PV == 2) FR_WAITBAR(2); else FR_WAITBAR(3);
    int i = 0;
    for (; i < iskip; ++i) { FR_ISSUE(i); FR_END(i); }
    f32x16 sc0, sc1;
    {
        FR_ISSUE(i);
        bf16x8 pa[4], vf[2][4];
        qk_ring<DQK>(FR_KSLOT(i), ka, qf, sc0, sc1);
        soft_tile<ALIBI, true, NDV>(sc0, sc1, c1, slope2, (float)(t - 64 * (nt - 1 - i)), hb, m, l, o, pa);
#pragma unroll
        for (int d0 = 0; d0 < NDV; d0 += 2) { fa::v_load<DV>(FR_VSLOT(i), lane, d0, vf); __builtin_amdgcn_sched_barrier(0); fa::pv_mma(vf, pa, o[d0], o[d0 + 1]); }
        if (PIPE && i + 1 < nt) qk_ring<DQK>(FR_KSLOT(i + 1), ka, qf, sc0, sc1);
        FR_END(i); ++i;
    }
#define FR_PV(i_) do { _Pragma("unroll") for (int d0 = 0; d0 < NDV; d0 += 2) { fa::v_load<DV>(FR_VSLOT(i_), lane, d0, vf); __builtin_amdgcn_sched_barrier(0); fa::pv_mma(vf, pa, o[d0], o[d0 + 1]); } } while (0)
    if constexpr (PIPE) {
        f32x16 sb0, sb1;
        bool curA = true;
#define FR_BODY(C0, C1, N0, N1) do { FR_ISSUE(i); bf16x8 pa[4], vf[2][4]; const float d0f = (float)(t - 64 * (nt - 1 - i)); \
            qk_ring<DQK, false>(FR_KSLOT(i + 1), ka, qf, N0, N1); \
            if constexpr (VAR != 1) soft_tile<ALIBI, false, NDV>(C0, C1, c1, slope2, d0f, hb, m, l, o, pa); else fa::pack_p(C0, C1, pa); \
            FR_PV(i); FR_END(i); ++i; } while (0)
        while (i + 1 < nt) {
            FR_BODY(sc0, sc1, sb0, sb1);
            if (i + 1 >= nt) { curA = false; break; }
            FR_BODY(sb0, sb1, sc0, sc1);
        }
#undef FR_BODY
        if (i < nt) {
            FR_ISSUE(i); bf16x8 pa[4], vf[2][4]; const float d0f = (float)(t - 64 * (nt - 1 - i));
            if (curA) soft_tile<ALIBI, false, NDV>(sc0, sc1, c1, slope2, d0f, hb, m, l, o, pa); else soft_tile<ALIBI, false, NDV>(sb0, sb1, c1, slope2, d0f, hb, m, l, o, pa);
            FR_PV(i); FR_END(i); ++i;
        }
    } else {
        for (; i < nt; ++i) {
            FR_ISSUE(i);
            bf16x8 pa[4], vf[2][4];
            const float d0f = (float)(t - 64 * (nt - 1 - i));
            qk_ring<DQK>(FR_KSLOT(i), ka, qf, sc0, sc1);
            if constexpr (DV == 64) { fa::v_load<DV>(FR_VSLOT(i), lane, 0, vf); __builtin_amdgcn_sched_barrier(0); }
            if constexpr (VAR != 1) soft_tile<ALIBI, false, NDV>(sc0, sc1, c1, slope2, d0f, hb, m, l, o, pa); else fa::pack_p(sc0, sc1, pa);
#pragma unroll
            for (int d0 = 0; d0 < NDV; d0 += 2) { if (DV != 64 || d0 != 0) { fa::v_load<DV>(FR_VSLOT(i), lane, d0, vf); __builtin_amdgcn_sched_barrier(0); } fa::pv_mma(vf, pa, o[d0], o[d0 + 1]); }
            FR_END(i);
        }
    }
#undef FR_PV
#undef FR_ISSUE_K
#undef FR_ISSUE_V
#undef FR_ISSUE
#undef FR_END
#undef FR_KSLOT
#undef FR_VSLOT
}
}

__device__ __forceinline__ void diff_unit(LAS char* lds, int b, int h, int qt, bf16* P, float lam, float lam_init, const float* subg, bf16* scratch, int wid, bool dry = false) {
    const int lane = lane_id_v(), r32 = lane & 31, hb = lane >> 5;
    const int q0 = 256 * qt, wq0 = q0 + 32 * wid, t = wq0 + r32;
    bf16* prow = P + ((size_t)b * S + t) * PW;
    const char* pb = (const char*)(P + (size_t)b * S * PW);
    const float slope2 = alibi_slope(8 + h) * LOG2E, c1 = 0.125f * LOG2E;
    u32x4* o1g = (u32x4*)scratch + wid * 64 + lane;
    f32x16 o[4]; float m = 0.f, l = 0.f;
    for (int map = 0; map < 2; ++map) {
        bf16x8 qf[4];
#pragma unroll
        for (int s = 0; s < 4; ++s) qf[s] = *(const bf16x8*)(prow + PC_DQ + h * 128 + map * 64 + 16 * s + 8 * hb);
#pragma unroll
        for (int d = 0; d < 4; ++d)
#pragma unroll
            for (int i = 0; i < 16; ++i) o[d][i] = 0.f;
        m = fa::NEG; l = 0.f;
        fr::flash_ring<64, 128, true, DIFF_PIPE>(lds, pb + (PC_DK + h * 128 + map * 64) * 2, pb + (PC_DV + h * 128) * 2, PW * 2, qf, o, m, l, q0, wq0, t, c1, slope2, wid, lane);
        if (map == 0) { const float inv = 1.f / l;
#pragma unroll
            for (int d = 0; d < 4; ++d)
#pragma unroll
                for (int k = 0; k < 2; ++k) { u32x4 w; w.x = pk2(o[d][8 * k] * inv, o[d][8 * k + 1] * inv); w.y = pk2(o[d][8 * k + 2] * inv, o[d][8 * k + 3] * inv);
                    w.z = pk2(o[d][8 * k + 4] * inv, o[d][8 * k + 5] * inv); w.w = pk2(o[d][8 * k + 6] * inv, o[d][8 * k + 7] * inv); o1g[512 * (2 * d + k)] = w; } }
    }
    const float inv2 = lam / l; float ss = 0.f;
#pragma unroll
    for (int d = 0; d < 4; ++d)
#pragma unroll
        for (int k = 0; k < 2; ++k) { u32x4 w;
            { const unsigned long long* p64 = (const unsigned long long*)(o1g + 512 * (2 * d + k));
              const unsigned long long x0 = __hip_atomic_load(p64, __ATOMIC_RELAXED, __HIP_MEMORY_SCOPE_AGENT), x1 = __hip_atomic_load(p64 + 1, __ATOMIC_RELAXED, __HIP_MEMORY_SCOPE_AGENT);
              w.x = (unsigned)x0; w.y = (unsigned)(x0 >> 32); w.z = (unsigned)x1; w.w = (unsigned)(x1 >> 32); }
            const float a0 = bflo(w.x) - o[d][8 * k] * inv2, a1 = bfhi(w.x) - o[d][8 * k + 1] * inv2, a2 = bflo(w.y) - o[d][8 * k + 2] * inv2, a3 = bfhi(w.y) - o[d][8 * k + 3] * inv2;
            const float a4 = bflo(w.z) - o[d][8 * k + 4] * inv2, a5 = bfhi(w.z) - o[d][8 * k + 5] * inv2, a6 = bflo(w.w) - o[d][8 * k + 6] * inv2, a7 = bfhi(w.w) - o[d][8 * k + 7] * inv2;
            o[d][8 * k] = a0; o[d][8 * k + 1] = a1; o[d][8 * k + 2] = a2; o[d][8 * k + 3] = a3; o[d][8 * k + 4] = a4; o[d][8 * k + 5] = a5; o[d][8 * k + 6] = a6; o[d][8 * k + 7] = a7;
            ss += (a0 * a0 + a1 * a1) + (a2 * a2 + a3 * a3) + (a4 * a4 + a5 * a5) + (a6 * a6 + a7 * a7); }
    ss = hsum(ss);
    const float rs = __builtin_amdgcn_rsqf(ss * (1.f / 128.f) + 1e-6f) * (1.f - lam_init);
#pragma unroll
    for (int d = 0; d < 4; ++d)
#pragma unroll
        for (int k = 0; k < 4; ++k) { const int dv = 32 * d + 8 * k + 4 * hb; const f32x4 g = *(const f32x4*)(subg + dv);
            u32x2 w; w.x = pk2(o[d][4 * k] * rs * g[0], o[d][4 * k + 1] * rs * g[1]); w.y = pk2(o[d][4 * k + 2] * rs * g[2], o[d][4 * k + 3] * rs * g[3]);
            if (!dry) *(u32x2*)(prow + PC_DQ + h * 128 + dv) = w; }
}

constexpr int KVW = 1280;
__device__ __forceinline__ void mla_unit(LAS char* lds, int b, int h, int qt, bf16* QM, const bf16* KVM, const float* rsq, int wid, bool dry = false) {
    const int lane = lane_id_v(), r32 = lane & 31, hb = lane >> 5;
    const int q0 = 256 * qt, wq0 = q0 + 32 * wid, t = wq0 + r32; const size_t mrow = (size_t)b * S + t;
    bf16* qrow = QM + mrow * 768 + h * 96;
    bf16x8 qf[6];
#pragma unroll
    for (int s = 0; s < 6; ++s) qf[s] = *(const bf16x8*)(qrow + 16 * s + 8 * hb);
    const float c1 = 0.10206207261596575f * LOG2E * rsq[mrow];
#pragma unroll
    for (int s = 0; s < 6; ++s) { const u32x4 w = __builtin_bit_cast(u32x4, qf[s]); u32x4 r;
        r.x = pk2(bflo(w.x) * c1, bfhi(w.x) * c1); r.y = pk2(bflo(w.y) * c1, bfhi(w.y) * c1); r.z = pk2(bflo(w.z) * c1, bfhi(w.z) * c1); r.w = pk2(bflo(w.w) * c1, bfhi(w.w) * c1);
        qf[s] = __builtin_bit_cast(bf16x8, r); }
    const char* kb = (const char*)(KVM + (size_t)b * S * KVW + h * 160);
    f32x16 o[2];
#pragma unroll
    for (int d = 0; d < 2; ++d)
#pragma unroll
        for (int i = 0; i < 16; ++i) o[d][i] = 0.f;
    float m = fa::NEG, l = 0.f;
    if (PROBE_VAR != 0 && dry) fr::flash_ring<96, 64, false, MLA_PIPE, PROBE_VAR>(lds, kb, kb + 192, KVW * 2, qf, o, m, l, q0, wq0, t, c1, 0.f, wid, lane); else
    fr::flash_ring<96, 64, false, MLA_PIPE>(lds, kb, kb + 192, KVW * 2, qf, o, m, l, q0, wq0, t, c1, 0.f, wid, lane);
    const float inv = 1.f / l;
#pragma unroll
    for (int d = 0; d < 2; ++d)
#pragma unroll
        for (int k = 0; k < 4; ++k) { u32x2 w; w.x = pk2(o[d][4 * k] * inv, o[d][4 * k + 1] * inv); w.y = pk2(o[d][4 * k + 2] * inv, o[d][4 * k + 3] * inv);
            if (!dry) *(u32x2*)(qrow + 32 * d + 8 * k + 4 * hb) = w; }
}

#define LAUNDER(x) asm volatile("" : "+v"(x))
#define NSA_IDS const int lane = lane_id_v(), tid = wid * 64 + lane, r32 = lane & 31, hb = lane >> 5, h4 = r32 >> 3, qi = r32 & 7; (void)h4; (void)qi; (void)hb; (void)r32;
__device__ __forceinline__ void nsa_unit(LAS char* lds, int b, int g, int j, bf16* P, const bf16* KCMP, const bf16* VCMP, int wid, bool dry = false) {
    const int lane = lane_id_v(), r32 = lane & 31, hb = lane >> 5, h4 = r32 >> 3, qi = r32 & 7;
    const int head = 4 * g + h4, t0 = 64 * j, t = t0 + 8 * wid + qi;
    bf16* prow = P + ((size_t)b * S + t) * PW;
    const char* pb = (const char*)(P + (size_t)b * S * PW);
    bf16x8 qf[4];
#pragma unroll
    for (int s = 0; s < 4; ++s) qf[s] = *(const bf16x8*)(prow + PC_NQ + head * 64 + 16 * s + 8 * hb);
    const float slope2 = alibi_slope(head) * LOG2E, c1 = 0.125f * LOG2E;
    const float gc = sigmoidf_(bf2f(prow[PC_NG + head * 3 + 0])), gs = sigmoidf_(bf2f(prow[PC_NG + head * 3 + 1])), gw = sigmoidf_(bf2f(prow[PC_NG + head * 3 + 2]));
    LAS float* sc = (LAS float*)(lds + A_SC + wid * 4096);
    { float z = 0.f; LAUNDER(z);
#pragma unroll
    for (int k = 0; k < 4; ++k) *(LAS f32x4*)(sc + lane * 16 + 4 * k) = (f32x4){z, z, z, z}; }
    f32x16 ob[2];
#pragma unroll
    for (int d = 0; d < 2; ++d)
#pragma unroll
        for (int i = 0; i < 16; ++i) ob[d][i] = 0.f;
    {
        NSA_IDS
        const int ntc = (4 * j + 3 + 63) >> 6;
        Ld64 ld; ld.kp = (const char*)(KCMP + (size_t)(b * 2 + g) * 512 * 64); ld.vp = (const char*)(VCMP + (size_t)(b * 2 + g) * 512 * 64); ld.kstr = 128; ld.vstr = 128;
        float mc = fa::NEG, lc = 0.f;
        ld.issue(0, tid, false); ld.commit(lds, lds + A_VB0, tid, false); __syncthreads();
        for (int kt = 0; kt < ntc; ++kt) {
            const int buf = kt & 1;
            if (kt + 1 < ntc) ld.issue(64 * (kt + 1), tid, false);
            f32x16 s0, s1; fa::qk_tile<64>(lds + buf * A_KB, qf, s0, s1, r32, hb);
            fa::score_tile<true>(s0, s1, (float)(t - 31 - 1024 * kt), 16.f, c1, slope2, 1.0e9f, true, hb);
            (void)fa::softmax_step(s0, s1, mc, lc);
            if (kt + 1 < ntc) ld.commit(lds + (buf ^ 1) * A_KB, lds + A_VB0, tid, false);
            __syncthreads();
        }
        const float inv = (mc > -1.0e29f) ? 1.f / lc : 0.f;
        float carry = 0.f;
        ld.issue(0, tid, true); ld.commit(lds, lds + A_VB0, tid, true); __syncthreads();
        for (int kt = 0; kt < ntc; ++kt) {
            const int buf = kt & 1;
            if (kt + 1 < ntc) ld.issue(64 * (kt + 1), tid, true);
            f32x16 s0, s1; fa::qk_tile<64>(lds + buf * A_KB, qf, s0, s1, r32, hb);
            fa::score_tile<true>(s0, s1, (float)(t - 31 - 1024 * kt), 16.f, c1, slope2, 1.0e9f, true, hb);
#pragma unroll
            for (int i = 0; i < 16; ++i) { s0[i] = fexp2(s0[i] - mc) * inv; s1[i] = fexp2(s1[i] - mc) * inv; }
            { float mainv[8], ps[8];
#pragma unroll
              for (int gq = 0; gq < 8; ++gq) { const int kb = gq >> 2, k = gq & 3;
                  const float p0 = kb ? s1[4 * k] : s0[4 * k], p1 = kb ? s1[4 * k + 1] : s0[4 * k + 1], p2 = kb ? s1[4 * k + 2] : s0[4 * k + 2], p3 = kb ? s1[4 * k + 3] : s0[4 * k + 3];
                  float mv = 2.f * (p0 + p1 + p2) + p3, sv = p3;
                  mv += __shfl_xor(mv, 8); mv += __shfl_xor(mv, 16); sv += __shfl_xor(sv, 8); sv += __shfl_xor(sv, 16);
                  mainv[gq] = mv;
                  auto rr = __builtin_amdgcn_permlane32_swap(__float_as_uint(sv), __float_as_uint(sv), false, false);
                  ps[gq] = __uint_as_float(hb ? rr[0] : rr[1]); }
#pragma unroll
              for (int gq = 0; gq < 8; ++gq) { const float prev = gq ? ps[gq - 1] : carry; const float fin = mainv[gq] + (hb ? ps[gq] : prev);
                  if (h4 == 0) sc[qi * 128 + 16 * kt + 8 * (gq >> 2) + 2 * (gq & 3) + hb] = fin; }
              carry = ps[7]; }
            bf16x8 pa[4]; fa::pack_p(s0, s1, pa);
            fa::pv_tile<64>(lds + A_VB0 + buf * A_VB, pa, ob, lane);
            if (kt + 1 < ntc) ld.commit(lds + (buf ^ 1) * A_KB, lds + A_VB0 + (buf ^ 1) * A_VB, tid, true);
            __syncthreads();
        }
#pragma unroll
        for (int d = 0; d < 2; ++d)
#pragma unroll
            for (int i = 0; i < 16; ++i) ob[d][i] = gc * ob[d][i];
    }
    {
        NSA_IDS
        asm volatile("s_waitcnt lgkmcnt(0)" ::: "memory");
        const int qq = lane >> 3, sub = lane & 7, cur = j;
        float v[16];
#pragma unroll
        for (int k = 0; k < 4; ++k) { const f32x4 x = *(const LAS f32x4*)(sc + qq * 128 + 16 * sub + 4 * k); v[4 * k] = x[0]; v[4 * k + 1] = x[1]; v[4 * k + 2] = x[2]; v[4 * k + 3] = x[3]; }
        unsigned bits = 0u;
        if (cur < 16) {
#pragma unroll
            for (int jj = 0; jj < 16; ++jj) if (16 * sub + jj <= cur) bits |= 1u << jj;
        } else {
#pragma unroll
            for (int jj = 0; jj < 16; ++jj) { const int blk = 16 * sub + jj; if (!(blk >= 1 && blk <= cur - 2)) v[jj] = -1.f; }
            for (int round = 0; round < 13; ++round) {
                float bm = v[0]; int bi = 0;
#pragma unroll
                for (int jj = 1; jj < 16; ++jj) if (v[jj] > bm) { bm = v[jj]; bi = jj; }
                int gi = 16 * sub + bi;
#pragma unroll
                for (int st = 1; st < 8; st <<= 1) { const float ov = __shfl_xor(bm, st); const int oi = __shfl_xor(gi, st); if (ov > bm || (ov == bm && oi < gi)) { bm = ov; gi = oi; } }
                const bool own = (gi >> 4) == sub; const int wj = gi & 15;
#pragma unroll
                for (int jj = 0; jj < 16; ++jj) if (own && jj == wj) { v[jj] = -1.f; bits |= 1u << jj; }
            }
#pragma unroll
            for (int jj = 0; jj < 16; ++jj) { const int blk = 16 * sub + jj; if (blk == 0 || blk == cur || blk == cur - 1) bits |= 1u << jj; }
        }
        ((LAS unsigned short*)(lds + A_SM + wid * 128))[qq * 8 + sub] = (unsigned short)bits;
        unsigned ub = bits; ub |= __shfl_xor(ub, 8); ub |= __shfl_xor(ub, 16); ub |= __shfl_xor(ub, 32);
        if (lane < 8) ((LAS unsigned short*)(lds + A_UN))[wid * 8 + lane] = (unsigned short)ub;
    }
    __syncthreads();
    LAS float* otl = (LAS float*)(lds + A_SC + wid * 8192) + lane;
#pragma unroll
    for (int d = 0; d < 2; ++d)
#pragma unroll
        for (int i = 0; i < 16; ++i) { otl[64 * (16 * d + i)] = ob[d][i]; ob[d][i] = 0.f; }
    {
        NSA_IDS
        u32x4 un = (u32x4){0u, 0u, 0u, 0u};
#pragma unroll
        for (int w = 0; w < 8; ++w) { const u32x4 x = *(const LAS u32x4*)(lds + A_UN + w * 16); un.x |= x.x; un.y |= x.y; un.z |= x.z; un.w |= x.w; }
        un.x = __builtin_amdgcn_readfirstlane(un.x); un.y = __builtin_amdgcn_readfirstlane(un.y); un.z = __builtin_amdgcn_readfirstlane(un.z); un.w = __builtin_amdgcn_readfirstlane(un.w);
        u32x4 wv = *(const LAS u32x4*)(lds + A_UN + wid * 16);
        wv.x = __builtin_amdgcn_readfirstlane(wv.x); wv.y = __builtin_amdgcn_readfirstlane(wv.y); wv.z = __builtin_amdgcn_readfirstlane(wv.z); wv.w = __builtin_amdgcn_readfirstlane(wv.w);
        const u32x4 mq = *(const LAS u32x4*)(lds + A_SM + wid * 128 + qi * 16);
        Ld64 ld; ld.kp = pb + (PC_KS + g * 64) * 2; ld.vp = pb + (PC_VS + g * 64) * 2; ld.kstr = PW * 2; ld.vstr = PW * 2;
        float ms = fa::NEG, ls = 0.f;
        int blk = next_bit(un, 0), buf = 0;
        ld.issue(64 * blk, tid, true); ld.commit(lds, lds + A_VB0, tid, true); __syncthreads();
        while (blk < 128) {
            const int nblk = next_bit(un, blk + 1);
            if (nblk < 128) ld.issue(64 * nblk, tid, true);
            if ((getw(wv, blk >> 5) >> (blk & 31)) & 1u) {
                f32x16 s0, s1; fa::qk_tile<64>(lds + buf * A_KB, qf, s0, s1, r32, hb);
                const bool lsel = ((getw(mq, blk >> 5) >> (blk & 31)) & 1u) != 0u;
                fa::score_tile<true>(s0, s1, (float)(t - 64 * blk), 1.f, c1, slope2, 1.0e9f, lsel, hb);
                const float alpha = fa::softmax_step(s0, s1, ms, ls);
                ob[0] = ob[0] * alpha; ob[1] = ob[1] * alpha;
                bf16x8 pa[4]; fa::pack_p(s0, s1, pa);
                fa::pv_tile<64>(lds + A_VB0 + buf * A_VB, pa, ob, lane);
            }
            if (nblk < 128) ld.commit(lds + (buf ^ 1) * A_KB, lds + A_VB0 + (buf ^ 1) * A_VB, tid, true);
            __syncthreads(); buf ^= 1; blk = nblk;
        }
        const float f = (ms > -1.0e29f) ? gs / ls : 0.f;
#pragma unroll
        for (int d = 0; d < 2; ++d)
#pragma unroll
            for (int i = 0; i < 16; ++i) { otl[64 * (16 * d + i)] += f * ob[d][i]; ob[d][i] = 0.f; }
    }
    {
        NSA_IDS
        Ld64 ld; ld.kp = pb + (PC_KW + g * 64) * 2; ld.vp = pb + (PC_VW + g * 64) * 2; ld.kstr = PW * 2; ld.vstr = PW * 2;
        float mw = fa::NEG, lw = 0.f;
        const int b0 = j >= 8 ? j - 8 : 0; int buf = 0;
        ld.issue(64 * b0, tid, true); ld.commit(lds, lds + A_VB0, tid, true); __syncthreads();
        for (int blk = b0; blk <= j; ++blk) {
            if (blk < j) ld.issue(64 * (blk + 1), tid, true);
            f32x16 s0, s1; fa::qk_tile<64>(lds + buf * A_KB, qf, s0, s1, r32, hb);
            if (blk == j || blk == j - 8) fa::score_tile<true>(s0, s1, (float)(t - 64 * blk), 1.f, c1, slope2, 512.f, true, hb);
            else fa::score_tile<false>(s0, s1, (float)(t - 64 * blk), 1.f, c1, slope2, 512.f, true, hb);
            const float alpha = fa::softmax_step(s0, s1, mw, lw);
            ob[0] = ob[0] * alpha; ob[1] = ob[1] * alpha;
            bf16x8 pa[4]; fa::pack_p(s0, s1, pa);
            fa::pv_tile<64>(lds + A_VB0 + buf * A_VB, pa, ob, lane);
            if (blk < j) ld.commit(lds + (buf ^ 1) * A_KB, lds + A_VB0 + (buf ^ 1) * A_VB, tid, true);
            __syncthreads(); buf ^= 1;
        }
        const float f = (mw > -1.0e29f) ? gw / lw : 0.f;
#pragma unroll
        for (int d = 0; d < 2; ++d)
#pragma unroll
            for (int i = 0; i < 16; ++i) ob[d][i] = otl[64 * (16 * d + i)] + f * ob[d][i];
    }
#pragma unroll
    for (int d = 0; d < 2; ++d)
#pragma unroll
        for (int k = 0; k < 4; ++k) { u32x2 w; w.x = pk2(ob[d][4 * k], ob[d][4 * k + 1]); w.y = pk2(ob[d][4 * k + 2], ob[d][4 * k + 3]);
            if (!dry) *(u32x2*)(prow + PC_NQ + head * 64 + 32 * d + 8 * k + 4 * hb) = w; }
    __syncthreads();
}

__device__ __forceinline__ int srccol(int mode, int n) {
    if (mode == 0) return n;
    if (mode == 1) {
        if (n < 1280) return n;
        if (n < 2816) return n - 1280 + 1304;
        if (n < 3200) return n - 2816 + 2840;
        if (n < 3232) { const int i = n - 3200; return 3224 + (i & 1) * 16 + (i >> 1); }
        if (n < 3256) return 1280 + (n - 3232);
        return -1; }
    { const int h = n / 96, c = n - h * 96; if (c < 64) return n; const int i = c - 64; return h * 96 + 64 + (i & 1) * 16 + (i >> 1); }
}
__device__ __forceinline__ void tconv_item(const float* W, int ldw, const float* kscale, bf16* WT, int K, int N, int mode, int item, LAS float* scr, int lane) {
    const int nblk = N / 32, kb = item / nblk, nb = item - kb * nblk, k0 = 64 * kb, n0 = 32 * nb;
    if (mode == 0 || (mode == 1 && n0 + 31 < 3200)) {
        const int c0 = srccol(mode, n0), kq = lane >> 3, n4 = (lane & 7) * 4;
        f32x4 x[8];
#pragma unroll
        for (int i = 0; i < 8; ++i) x[i] = *(const f32x4*)(W + (size_t)(k0 + kq + 8 * i) * ldw + c0 + n4);
#pragma unroll
        for (int i = 0; i < 8; ++i) { const int kk = kq + 8 * i; const float ksc = kscale ? kscale[k0 + kk] : 1.f; LAS float* d = scr + kk * 33 + n4;
            d[0] = x[i][0] * ksc; d[1] = x[i][1] * ksc; d[2] = x[i][2] * ksc; d[3] = x[i][3] * ksc; }
    } else {
    const int sc = srccol(mode, n0 + (lane & 31));
#pragma unroll 8
    for (int i = 0; i < 32; ++i) { const int kk = 2 * i + (lane >> 5); float x = 0.f; if (sc >= 0) { x = W[(size_t)(k0 + kk) * ldw + sc]; if (kscale) x *= kscale[k0 + kk]; } scr[kk * 33 + (lane & 31)] = x; }
    }
    asm volatile("s_waitcnt lgkmcnt(0)" ::: "memory");
    const int c = lane & 7;
#pragma unroll
    for (int j = 0; j < 4; ++j) { const int n = (lane >> 3) + 8 * j; const LAS float* s = scr + (8 * c) * 33 + n;
        u32x4 o; o.x = pk2(s[0 * 33], s[1 * 33]); o.y = pk2(s[2 * 33], s[3 * 33]); o.z = pk2(s[4 * 33], s[5 * 33]); o.w = pk2(s[6 * 33], s[7 * 33]);
        *(u32x4*)(WT + (size_t)(n0 + n) * K + k0 + 8 * c) = o; }
    asm volatile("s_waitcnt lgkmcnt(0)" ::: "memory");
}
struct TJob { const float* W; const float* ks; bf16* WT; int ldw, K, N, mode, item; };
__device__ __forceinline__ bool tjob_fast(const TJob& j) { const int nblk = j.N / 32, kb = j.item / nblk, n0 = 32 * (j.item - kb * nblk); return j.mode == 0 || (j.mode == 1 && n0 + 31 < 3200); }
__device__ __forceinline__ void tconv_load(const TJob& j, f32x4 (&x)[8], int lane) {
    if (!tjob_fast(j)) return;
    const int nblk = j.N / 32, kb = j.item / nblk, nb = j.item - kb * nblk, k0 = 64 * kb, n0 = 32 * nb;
    const int c0 = srccol(j.mode, n0), kq = lane >> 3, n4 = (lane & 7) * 4;
#pragma unroll
    for (int i = 0; i < 8; ++i) x[i] = *(const f32x4*)(j.W + (size_t)(k0 + kq + 8 * i) * j.ldw + c0 + n4);
}
__device__ __forceinline__ void tconv_finish(const TJob& j, const f32x4 (&x)[8], LAS float* scr, int lane) {
    if (!tjob_fast(j)) { tconv_item(j.W, j.ldw, j.ks, j.WT, j.K, j.N, j.mode, j.item, scr, lane); return; }
    const int nblk = j.N / 32, kb = j.item / nblk, nb = j.item - kb * nblk, k0 = 64 * kb, n0 = 32 * nb;
    const int kq = lane >> 3, n4 = (lane & 7) * 4;
#pragma unroll
    for (int i = 0; i < 8; ++i) { const int kk = kq + 8 * i; const float ksc = j.ks ? j.ks[k0 + kk] : 1.f; LAS float* d = scr + kk * 33 + n4;
        d[0] = x[i][0] * ksc; d[1] = x[i][1] * ksc; d[2] = x[i][2] * ksc; d[3] = x[i][3] * ksc; }
    asm volatile("s_waitcnt lgkmcnt(0)" ::: "memory");
    const int c = lane & 7;
#pragma unroll
    for (int q = 0; q < 4; ++q) { const int n = (lane >> 3) + 8 * q; const LAS float* sp = scr + (8 * c) * 33 + n;
        u32x4 o; o.x = pk2(sp[0 * 33], sp[1 * 33]); o.y = pk2(sp[2 * 33], sp[3 * 33]); o.z = pk2(sp[4 * 33], sp[5 * 33]); o.w = pk2(sp[6 * 33], sp[7 * 33]);
        *(u32x4*)(j.WT + (size_t)(n0 + n) * j.K + k0 + 8 * c) = o; }
    asm volatile("s_waitcnt lgkmcnt(0)" ::: "memory");
}
#define TCONV_LOOP(NITEMS, DECODE) do { int it_ = gw; if (it_ < (NITEMS)) { TJob cur_; f32x4 xc_[8]; DECODE(it_, cur_); tconv_load(cur_, xc_, lane); \
        for (;;) { const int nit_ = it_ + NGW; const bool hn_ = nit_ < (NITEMS); TJob nx_ = cur_; f32x4 xn_[8]; \
            _Pragma("unroll") for (int q_ = 0; q_ < 8; ++q_) xn_[q_] = xc_[q_]; \
            if (hn_) { DECODE(nit_, nx_); tconv_load(nx_, xn_, lane); } \
            tconv_finish(cur_, xc_, scr, lane); if (!hn_) break; cur_ = nx_; it_ = nit_; \
            _Pragma("unroll") for (int q_ = 0; q_ < 8; ++q_) xc_[q_] = xn_[q_]; } } } while (0)
__device__ __forceinline__ void ln_row(f32x4 (&v)[4], const float* g, const float* b, int lane) {
    float s = 0.f;
#pragma unroll
    for (int j = 0; j < 4; ++j) s += (v[j][0] + v[j][1]) + (v[j][2] + v[j][3]);
    const float mean = wave_sum(s) * (1.f / 1024.f); float s2 = 0.f;
#pragma unroll
    for (int j = 0; j < 4; ++j) { v[j] = v[j] - mean; s2 += (v[j][0] * v[j][0] + v[j][1] * v[j][1]) + (v[j][2] * v[j][2] + v[j][3] * v[j][3]); }
    const float rstd = 1.f / sqrtf(wave_sum(s2) * (1.f / 1024.f) + 1e-5f);
#pragma unroll
    for (int j = 0; j < 4; ++j) { const f32x4 gg = *(const f32x4*)(g + 4 * lane + 256 * j), bb = *(const f32x4*)(b + 4 * lane + 256 * j); v[j] = v[j] * rstd * gg + bb; }
}
__device__ __forceinline__ void store_row_bf16(bf16* row, const f32x4 (&v)[4], int lane) {
#pragma unroll
    for (int j = 0; j < 4; ++j) { u32x2 w; w.x = pk2(v[j][0], v[j][1]); w.y = pk2(v[j][2], v[j][3]); *(u32x2*)(row + 4 * lane + 256 * j) = w; }
}

struct InPtrs { const float* const* p; __device__ __forceinline__ const float* operator[](int i) const { return (const float*)(GAS const float*)p[i]; } };
#define PHASE_IDS int wid_l_ = wid_k; asm volatile("" : "+s"(wid_l_)); const int lane_l_ = lane_id_v(); \
    const int wid = wid_l_, lane = lane_l_, tid = wid * 64 + lane, gw = c * 8 + wid; (void)lane; (void)gw; (void)wid; (void)tid; \
    GAS unsigned char* ws_l_ = (GAS unsigned char*)ws_k; GAS unsigned char* dout_l_ = (GAS unsigned char*)dout_k; asm volatile("" : "+s"(ws_l_), "+s"(dout_l_)); \
    unsigned char* const ws = (unsigned char*)ws_l_; unsigned char* const dout = (unsigned char*)dout_l_; (void)dout;
struct Args { const float* in[29]; float* out; unsigned char* ws; int ph_lo, ph_hi; };

__global__ void __launch_bounds__(512, 2) fwd(Args a) {
    extern __shared__ __attribute__((aligned(16))) unsigned char lds_[];
    LAS unsigned char* lds = (LAS unsigned char*)lds_;
    LAS char* ldc = (LAS char*)lds_;
    const int wid_k = __builtin_amdgcn_readfirstlane((int)threadIdx.x >> 6);
    const int G = gridDim.x, c = blockIdx.x, v = (G % 8 == 0) ? (c % 8) * (G / 8) + c / 8 : c;
    const int NGW = G * 8;
    volatile LAS unsigned* MISC = (volatile LAS unsigned*)(lds + LDS_MISC);
    if (threadIdx.x < 256) MISC[threadIdx.x] = 0u;
    __syncthreads();
    const InPtrs INP{a.in};
    unsigned char* const ws_k = a.ws;
    unsigned* ctl = (unsigned*)(ws_k + WS_CTL);
#if !MK_PER_PHASE
    XcdBarrier bar = xcd_barrier_post(ctl + CW_BAR, MISC + 8);
#define GRID_BAR() do { xcd_barrier(bar); if (PROBE_REPEAT == 17) xcd_barrier(bar); } while (0)
#else
#define GRID_BAR() do {} while (0)
#endif
    const int lo = a.ph_lo, hi = a.ph_hi;
#define IN(k) (lo <= (k) && (k) < hi)
#define BOTH(k) (IN(k) && IN((k) + 1))
    unsigned char* const dout_k = (unsigned char*)a.out;
#define CS ((float*)(ws + WS_CS))
#define MISCF ((float*)(ws + WS_MISC))
#define RSQ ((float*)(ws + WS_RSQ))
#define RSKV ((float*)(ws + WS_RSKV))
#define RTE ((int*)(ws + WS_RTE))
#define RTP ((int*)(ws + WS_RTP))
#define RTG ((float*)(ws + WS_RTG))
#define ROWIDX ((int*)(ws + WS_ROWIDX))
#define KCMP ((bf16*)(ws + WS_KCMP))
#define VCMP ((bf16*)(ws + WS_VCMP))
#define UL ((bf16*)(ws + WS_UL))
#define Hb ((bf16*)(ws + WS_HB))
#define P ((bf16*)(ws + WS_P))
#define Z ((bf16*)(ws + WS_P))
#define YS ((bf16*)(ws + WS_P))
#define HS ((bf16*)(ws + WS_HS))
#define GSwg ((bf16*)(ws + WS_GS) + (size_t)c * 3 * 65536)
#define QM ((bf16*)(dout + DO_QM))
#define KVM ((bf16*)(dout + DO_KVM))
#define Y ((bf16*)(dout + DO_KVM))
#define W13T ((bf16*)(dout + DO_W13))
#define W2T ((bf16*)(dout + DO_W2))
#define LAYER_W unsigned char* wl = ws + WS_WTS + (size_t)l * WL_STRIDE; \
        const bf16* WinT = (const bf16*)(wl + WL_WIN); const bf16* WgT = (const bf16*)(wl + WL_WG); const bf16* WbrT = (const bf16*)(wl + WL_WBR); const bf16* WoutT = (const bf16*)(wl + WL_WOUT); \
        const bf16* WuqT = (const bf16*)(wl + WL_WUQ); const bf16* WukvT = (const bf16*)(wl + WL_WUKV); const bf16* Wc1T = (const bf16*)(wl + WL_WC1); \
        unsigned* gcnt = (unsigned*)(ws + WS_CTL) + CW_CNT + l * 16 * 64; (void)WinT; (void)WgT; (void)WbrT; (void)WoutT; (void)WuqT; (void)WukvT; (void)Wc1T; (void)gcnt;
    if (PHON(0) && IN(0)) { PHASE_IDS
        for (int rep_ = (PROBE_REPEAT == 15 ? 0 : 1); rep_ < 2; ++rep_) {
        LAS float* scr = (LAS float*)(lds + wid * 8704);
#define DEC_PRO(it, J) do { const int l_ = (it) / 5152; int r_ = (it) - l_ * 5152; unsigned char* wl_ = ws + WS_WTS + (size_t)l_ * WL_STRIDE; \
            if (r_ < 1664) { J = TJob{INP[3] + (size_t)l_ * 1024 * IN_W, nullptr, (bf16*)(wl_ + WL_WIN), IN_W, 1024, 3328, 1, r_}; } \
            else if ((r_ -= 1664) < 1536) { J = TJob{INP[3] + (size_t)l_ * 1024 * IN_W + 3256, nullptr, (bf16*)(wl_ + WL_WG), IN_W, 1024, 3072, 0, r_}; } \
            else if ((r_ -= 1536) < 768) { const int jb_ = r_ / 256; J = TJob{INP[16 + jb_] + (size_t)l_ * 512 * 1024, nullptr, (bf16*)(wl_ + WL_WBR) + (size_t)jb_ * 1024 * 512, 1024, 512, 1024, 0, r_ - jb_ * 256}; } \
            else if ((r_ -= 768) < 512) { J = TJob{INP[19] + (size_t)l_ * 1024 * 1024, nullptr, (bf16*)(wl_ + WL_WOUT), 1024, 1024, 1024, 0, r_}; } \
            else if ((r_ -= 512) < 96) { J = TJob{INP[14] + (size_t)l_ * 256 * 768, INP[12] + l_ * 256, (bf16*)(wl_ + WL_WUQ), 768, 256, 768, 2, r_}; } \
            else if ((r_ -= 96) < 64) { J = TJob{INP[15] + (size_t)l_ * 128 * 1024, INP[13] + l_ * 128, (bf16*)(wl_ + WL_WUKV), 1024, 128, 1024, 0, r_}; } \
            else { r_ -= 64; const int job_ = r_ / 128, kv_ = job_ >> 1, half_ = job_ & 1; \
                J = TJob{INP[kv_ ? 8 : 5] + (size_t)l_ * 2048 * 256 + (size_t)half_ * 1024 * 256, nullptr, (bf16*)(wl_ + WL_WC1) + (size_t)kv_ * 512 * 1024 + (size_t)half_ * 256 * 1024, 256, 1024, 256, 0, r_ - job_ * 128}; } } while (0)
        TCONV_LOOP(2 * 5152, DEC_PRO);
#undef DEC_PRO
        for (int i = c * 512 + tid; i < S * 16; i += G * 512) { const int pos = i >> 4, k = i & 15;
            const float freq = fexp2(-(float)k * (13.287712379549449f / 16.f)); const float ang = (float)pos * freq;
            const double rev = (double)ang * 0.15915494309189535; const float fr = (float)(rev - __builtin_rint(rev));
            CS[2 * i] = __builtin_amdgcn_cosf(fr); CS[2 * i + 1] = __builtin_amdgcn_sinf(fr); }
        for (int jt = c * 512 + tid; jt < 32768; jt += G * 512) { const int i = jt & 1023, ch = jt >> 10; const int l = i >> 9, kv = (i >> 8) & 1, n = i & 255;
            const float* pos = INP[kv ? 7 : 4] + l * 2048 + ch * 64; const float* w1 = INP[kv ? 8 : 5] + (size_t)l * 2048 * 256 + (size_t)ch * 64 * 256 + n; float s = 0.f;
#pragma unroll 8
            for (int k = 0; k < 64; ++k) s += pos[k] * w1[(size_t)k * 256];
            MISCF[2048 + ch * 1024 + i] = s; }
        if (c == 0 && tid < 2) { const float* lp = INP[10] + tid * 256; float s1 = 0.f, s2 = 0.f;
            for (int k = 0; k < 64; ++k) { s1 += lp[k] * lp[64 + k]; s2 += lp[128 + k] * lp[192 + k]; }
            const float li = 0.8f - 0.6f * __expf(-0.3f * (float)tid); MISCF[1024 + tid] = __expf(s1) - __expf(s2) + li; MISCF[1026 + tid] = li; }
        { f32x4 xn[4];
          if (gw < T) {
#pragma unroll
              for (int j = 0; j < 4; ++j) xn[j] = *(const f32x4*)(INP[0] + (size_t)gw * 1024 + 4 * lane + 256 * j); }
          for (int m = gw; m < T; m += NGW) { f32x4 x[4];
#pragma unroll
            for (int j = 0; j < 4; ++j) x[j] = xn[j];
            const int mn_ = m + NGW < T ? m + NGW : m;
#pragma unroll
            for (int j = 0; j < 4; ++j) xn[j] = *(const f32x4*)(INP[0] + (size_t)mn_ * 1024 + 4 * lane + 256 * j);
            ln_row(x, INP[1], INP[2], lane); store_row_bf16(Hb + (size_t)m * 1024, x, lane); } }
        }
        if (BOTH(0)) GRID_BAR();
    }

    for (int l = 0; l < NLAYER; ++l) {
        const int pbase = 1 + 11 * l;
        if (PHON(1) && IN(pbase + 0)) { PHASE_IDS LAYER_W
            for (int rep_ = (PROBE_REPEAT == 1 ? 0 : 1); rep_ < 2; ++rep_) {
            pg8::TileSched Sd{(const char*)Hb, (const char*)WinT, 2048, 1024, 13, 128 * 13, G, v}; pg8::EpiStore E{P, PW, nullptr, 0, false};
            pg8::gemm_phase<pg8::EpiStore, pg8::TileSched, true>(lds, wid, 1024, 128u, Sd, E);
            }
            if (BOTH(pbase + 0)) GRID_BAR();
        }
        if (PHON(2) && IN(pbase + 1)) { PHASE_IDS LAYER_W
            for (int i = c * 512 + tid; i < 512; i += G * 512) { float sacc = 0.f;
                for (int ch = 0; ch < 32; ++ch) sacc += MISCF[2048 + ch * 1024 + l * 512 + i];
                MISCF[l * 512 + i] = sacc; }
            for (int rep_ = (PROBE_REPEAT == 2 ? 0 : 1); rep_ < 2; ++rep_)
            for (int m = gw; m < T; m += NGW) { bf16* pr = P + (size_t)m * PW; float ss = 0.f;
                if (lane < 48) { const u32x4 w = *(const u32x4*)(pr + (lane < 32 ? PC_CQ + lane * 8 : PC_CKV + (lane - 32) * 8));
                    ss = bflo(w.x) * bflo(w.x) + bfhi(w.x) * bfhi(w.x) + bflo(w.y) * bflo(w.y) + bfhi(w.y) * bfhi(w.y) + bflo(w.z) * bflo(w.z) + bfhi(w.z) * bfhi(w.z) + bflo(w.w) * bflo(w.w) + bfhi(w.w) * bfhi(w.w); }
                else if (lane < 52) { const int i0 = (lane - 48) * 4, pos = m & (S - 1); u32x4 w = *(const u32x4*)(pr + PC_KR + i0 * 2);
                    const f32x4* cs = (const f32x4*)(CS + ((size_t)pos * 16 + i0) * 2); const f32x4 ca = cs[0], cb = cs[1];
                    u32x4 o;
                    o.x = pk2(bflo(w.x) * ca[0] - bfhi(w.x) * ca[1], bflo(w.x) * ca[1] + bfhi(w.x) * ca[0]);
                    o.y = pk2(bflo(w.y) * ca[2] - bfhi(w.y) * ca[3], bflo(w.y) * ca[3] + bfhi(w.y) * ca[2]);
                    o.z = pk2(bflo(w.z) * cb[0] - bfhi(w.z) * cb[1], bflo(w.z) * cb[1] + bfhi(w.z) * cb[0]);
                    o.w = pk2(bflo(w.w) * cb[2] - bfhi(w.w) * cb[3], bflo(w.w) * cb[3] + bfhi(w.w) * cb[2]);
                    bf16* kr = KVM + (size_t)m * KVW + 64 + i0 * 2;
#pragma unroll
                    for (int hh = 0; hh < 8; ++hh) *(u32x4*)(kr + hh * 160) = o; }
                const float sq = wave_sum(lane < 32 ? ss : 0.f), skv = wave_sum((lane >= 32 && lane < 48) ? ss : 0.f);
                if (lane == 0) { RSQ[m] = 1.f / sqrtf(sq * (1.f / 256.f) + 1e-6f); RSKV[m] = 1.f / sqrtf(skv * (1.f / 128.f) + 1e-6f); } }
            if (BOTH(pbase + 1)) GRID_BAR();
        }
        if (PHON(3) && IN(pbase + 2)) { PHASE_IDS LAYER_W
            for (int rep_ = (PROBE_REPEAT == 3 ? 0 : 1); rep_ < 2; ++rep_) {
            const bool cmpwg = G > 64 && v >= G - 64; const int Gs = G > 64 ? G - 64 : G;
            { pg8::TileSched Sd{(const char*)(P + PC_CQ), (const char*)WuqT, PW * 2, 256, 3, cmpwg ? 0 : 384, Gs, v}; pg8::EpiRope E{QM, CS};
              pg8::gemm_phase<pg8::EpiRope, pg8::TileSched, true>(lds, wid, 256, 128u, Sd, E); }
            { pg8::TileSched Sd{(const char*)(P + PC_CKV), (const char*)WukvT, PW * 2, 128, 4, cmpwg ? 0 : 512, Gs, v}; pg8::EpiStore E{KVM, KVW, RSKV, 0, true};
              pg8::gemm_phase<pg8::EpiStore, pg8::TileSched, true>(lds, wid, 128, 128u, Sd, E); }
            { pg8::CmpSched Sd{(const char*)P, (const char*)Wc1T, G, v >= G - 64 ? v - (G - 64) : 64 + v}; pg8::EpiStore E{UL, 512, nullptr, (size_t)512 * 512, false};
              pg8::gemm_phase<pg8::EpiStore, pg8::CmpSched, true>(lds, wid, 1024, (unsigned)(PW * 2), Sd, E); }
            }
            if (BOTH(pbase + 2)) GRID_BAR();
        }
        if (PHON(4) && IN(pbase + 3)) { PHASE_IDS LAYER_W
            for (int rep_ = (PROBE_REPEAT == 4 ? 0 : 1); rep_ < 2; ++rep_) {
            LAS float* hid = (LAS float*)(lds + wid * 1024);
            for (int r = gw; r < 2 * 8 * 512; r += NGW) { const int kv = r >> 12, bg = (r >> 9) & 7, i = r & 511;
                bf16* out = (kv ? VCMP : KCMP) + ((size_t)bg * 512 + i) * 64;
                if (i == 511) { out[lane] = 0; continue; }
                const bf16* u = UL + ((size_t)(kv * 8 + bg) * 512 + i) * 512; const float* pbv = MISCF + l * 512 + kv * 256;
#pragma unroll
                for (int q = 0; q < 4; ++q) { const int n = lane + 64 * q; const float x = bf2f(u[n]) + bf2f(u[512 + 256 + n]) + pbv[n];
                    const float y = 0.7978845608028654f * (x + 0.044715f * x * x * x); const float th = 1.f - 2.f / (__expf(2.f * y) + 1.f);
                    hid[n] = 0.5f * x * (1.f + th); }
                asm volatile("s_waitcnt lgkmcnt(0)" ::: "memory");
                const float* w2 = INP[kv ? 9 : 6] + (size_t)l * 256 * 64 + lane; float acc = 0.f;
#pragma unroll 8
                for (int n = 0; n < 256; ++n) acc += hid[n] * w2[n * 64];
                out[lane] = (bf16)f2bf(acc);
                asm volatile("s_waitcnt lgkmcnt(0)" ::: "memory"); }
            }
            if (BOTH(pbase + 3)) GRID_BAR();
        }
        if (PHON(5) && IN(pbase + 4)) { PHASE_IDS LAYER_W
            const int xcd = c & 7, ii = c >> 3;
            if (G == 256) {
                for (int rep = (PROBE_REPEAT == 11 ? 0 : 1); rep < 2; ++rep)
                if (PHON(11)) for (int k = 0; k < 4; ++k) { const int bh = xcd + 8 * k; mla_unit(ldc, bh >> 3, bh & 7, (k & 1) ? ii : 31 - ii, QM, KVM, RSQ, wid, rep == 0); }
                for (int rep = (PROBE_REPEAT == 12 ? 0 : 1); rep < 2; ++rep)
                if (PHON(12)) for (int k = 0; k < 2; ++k) { const int bh = xcd + 8 * k; diff_unit(ldc, bh >> 2, bh & 3, k ? ii : 31 - ii, P, MISCF[1024 + l], MISCF[1026 + l], INP[11] + l * 128, GSwg, wid, rep == 0); }
                if (PHON(13)) for (int k = (PROBE_REPEAT == 13 ? -4 : 0); k < 4; ++k) { const int kk = k & 3; const int tile = (kk == 0) ? ii : (kk == 1) ? 63 - ii : (kk == 2) ? 64 + ii : 127 - ii; nsa_unit(ldc, xcd >> 1, xcd & 1, tile, P, KCMP, VCMP, wid, k < 0); }
            } else {
                if (PHON(11)) for (int u = c; u < 1024; u += G) { const int bh = u & 31; mla_unit(ldc, bh >> 3, bh & 7, 31 - (u >> 5), QM, KVM, RSQ, wid); }
                if (PHON(12)) for (int u = c; u < 512; u += G) { const int bh = u & 15; diff_unit(ldc, bh >> 2, bh & 3, 31 - (u >> 4), P, MISCF[1024 + l], MISCF[1026 + l], INP[11] + l * 128, GSwg, wid); }
                if (PHON(13)) for (int u = c; u < 1024; u += G) { const int bg = u & 7; nsa_unit(ldc, bg >> 1, bg & 1, 127 - (u >> 3), P, KCMP, VCMP, wid); }
            }
            if (BOTH(pbase + 4)) GRID_BAR();
        }
        if (PHON(6) && IN(pbase + 5)) { PHASE_IDS LAYER_W
            for (int rep_ = (PROBE_REPEAT == 6 ? 0 : 1); rep_ < 2; ++rep_) {
            for (int tl = v; tl < 512; tl += G) {
                const int pm = tl >> 2, pn = tl & 3;
                { pg8::GateSched Sd{(const char*)Hb, (const char*)WgT, pm, pn, true}; pg8::EpiGate E{GSwg};
                  pg8::gemm_phase<pg8::EpiGate, pg8::GateSched, true>(lds, wid, 1024, 128u, Sd, E); }
                { pg8::ChainSched Sd{(const char*)(P + PC_NQ), (const char*)(P + PC_DQ), (const char*)QM, (const char*)WbrT, pm, pn, true}; pg8::EpiChain E{Y, GSwg};
                  pg8::gemm_phase<pg8::EpiChain, pg8::ChainSched, true>(lds, wid, 512, 128u, Sd, E); }
            }
            }
            if (BOTH(pbase + 5)) GRID_BAR();
        }
        if (PHON(7) && IN(pbase + 6)) { PHASE_IDS LAYER_W
            for (int rep_ = (PROBE_REPEAT == 7 ? 0 : 1); rep_ < 2; ++rep_) {
            pg8::TileSched Sd{(const char*)Y, (const char*)WoutT, 2048, 1024, 4, 512, G, v}; pg8::EpiResid E{Z, Hb};
            pg8::gemm_phase<pg8::EpiResid, pg8::TileSched, true>(lds, wid, 1024, 128u, Sd, E);
            }
            if (BOTH(pbase + 6)) GRID_BAR();
        }
        if (PHON(8) && IN(pbase + 7)) { PHASE_IDS LAYER_W
            LAS float* rwT = (LAS float*)lds;
            for (int i = tid; i < 16384; i += 512) rwT[(i & 15) * 1024 + (i >> 4)] = INP[22][i];
            volatile LAS int* cntL = (volatile LAS int*)(MISC + 16); volatile LAS int* cbase = (volatile LAS int*)(MISC + 32);
            const float* g1 = INP[20] + l * 1024; const float* b1 = INP[21] + l * 1024; const float* rb = INP[23];
            LAS float* scr = (LAS float*)(lds + (wid < 7 ? 65536 + wid * 8448 : 132096));
#define DEC_MOE(it, J) do { const int e_ = (it) / 768; const int r_ = (it) - e_ * 768; \
                if (r_ < 512) { const int job_ = r_ >> 6, pn_ = job_ >> 1, half_ = job_ & 1; \
                    J = TJob{INP[half_ ? 25 : 24] + ((size_t)l * 16 + e_) * 1024 * 512 + pn_ * 128, nullptr, W13T + (size_t)e_ * 1024 * 1024 + (size_t)(pn_ * 256 + half_ * 128) * 1024, 512, 1024, 128, 0, r_ & 63}; } \
                else { J = TJob{INP[26] + ((size_t)l * 16 + e_) * 512 * 1024, nullptr, W2T + (size_t)e_ * 1024 * 512, 1024, 512, 1024, 0, r_ - 512}; } } while (0)
            int cv_it = gw; bool cv_has = cv_it < 16 * 768; f32x4 cv_x[8];
#pragma unroll
            for (int q = 0; q < 8; ++q) cv_x[q] = (f32x4){0.f, 0.f, 0.f, 0.f};
            if (cv_has) { TJob j0_; DEC_MOE(cv_it, j0_); tconv_load(j0_, cv_x, lane); }
#define CV_STEP() do { if (cv_has) { TJob cur_; DEC_MOE(cv_it, cur_); const int nit_ = cv_it + NGW; const bool hn_ = nit_ < 16 * 768; f32x4 xn_[8]; \
                _Pragma("unroll") for (int q_ = 0; q_ < 8; ++q_) xn_[q_] = cv_x[q_]; \
                if (hn_) { TJob nx_; DEC_MOE(nit_, nx_); tconv_load(nx_, xn_, lane); } \
                tconv_finish(cur_, cv_x, scr, lane); cv_it = nit_; cv_has = hn_; \
                _Pragma("unroll") for (int q_ = 0; q_ < 8; ++q_) cv_x[q_] = xn_[q_]; } } while (0)
            const int nit = (T + G * 128 - 1) / (G * 128);
            for (int rep_ = (PROBE_REPEAT == 8 ? 0 : 1); rep_ < 2; ++rep_)
            for (int it = 0; it < nit; ++it) {
                if (tid < 16) cntL[tid] = 0;
                __syncthreads();
                const int base = (it * G + c) * 128 + wid * 16;
                int e0 = -1, e1 = -1; float g0 = 0.f, g1v = 0.f;
                u32x2 zn[4];
                { const int m0_ = base < T ? base : T - 1;
#pragma unroll
                  for (int j = 0; j < 4; ++j) zn[j] = *(const u32x2*)(Z + (size_t)m0_ * 1024 + 4 * lane + 256 * j); }
                for (int i = 0; i < 16; ++i) { const int m = base + i; if (m >= T) break;
                    f32x4 x[4];
#pragma unroll
                    for (int j = 0; j < 4; ++j) { const u32x2 zw = zn[j]; x[j] = (f32x4){bflo(zw.x), bfhi(zw.x), bflo(zw.y), bfhi(zw.y)}; }
                    { const int mn_ = (i + 1 < 16 && m + 1 < T) ? m + 1 : m;
#pragma unroll
                      for (int j = 0; j < 4; ++j) zn[j] = *(const u32x2*)(Z + (size_t)mn_ * 1024 + 4 * lane + 256 * j); }
                    ln_row(x, g1, b1, lane); store_row_bf16(Hb + (size_t)m * 1024, x, lane);
                    float sel[16], aff[16];
                    { float acc[16];
#pragma unroll
                      for (int e = 0; e < 16; ++e) { float a_ = 0.f;
#pragma unroll
                          for (int j = 0; j < 4; ++j) { const f32x4 w = *(const LAS f32x4*)(rwT + e * 1024 + 4 * lane + 256 * j); a_ += x[j][0] * w[0] + x[j][1] * w[1] + x[j][2] * w[2] + x[j][3] * w[3]; }
                          acc[e] = a_; }
                      float v8[8], v4[4], v2[2], v1;
                      { const bool hi = (lane & 32) != 0;
#pragma unroll
                        for (int e = 0; e < 8; ++e) { const float rcv = __shfl_xor(hi ? acc[e] : acc[e + 8], 32); v8[e] = (hi ? acc[e + 8] : acc[e]) + rcv; } }
                      { const bool hi = (lane & 16) != 0;
#pragma unroll
                        for (int e = 0; e < 4; ++e) { const float rcv = __shfl_xor(hi ? v8[e] : v8[e + 4], 16); v4[e] = (hi ? v8[e + 4] : v8[e]) + rcv; } }
                      { const bool hi = (lane & 8) != 0;
#pragma unroll
                        for (int e = 0; e < 2; ++e) { const float rcv = __shfl_xor(hi ? v4[e] : v4[e + 2], 8); v2[e] = (hi ? v4[e + 2] : v4[e]) + rcv; } }
                      { const bool hi = (lane & 4) != 0; const float rcv = __shfl_xor(hi ? v2[0] : v2[1], 4); v1 = (hi ? v2[1] : v2[0]) + rcv; }
                      v1 += __shfl_xor(v1, 2); v1 += __shfl_xor(v1, 1);
#pragma unroll
                      for (int e = 0; e < 16; ++e) { const float lg = __uint_as_float(__builtin_amdgcn_readlane(__float_as_uint(v1), 32 * (e >> 3) + 16 * ((e >> 2) & 1) + 8 * ((e >> 1) & 1) + 4 * (e & 1)));
                          aff[e] = sigmoidf_(lg); sel[e] = aff[e] + rb[e]; } }
                    int grp = 0; float best = -1e30f;
#pragma unroll
                    for (int gq = 0; gq < 4; ++gq) { float m1 = sel[4 * gq], m2 = -1e30f;
#pragma unroll
                        for (int q = 1; q < 4; ++q) { const float s = sel[4 * gq + q]; if (s > m1) { m2 = m1; m1 = s; } else if (s > m2) m2 = s; }
                        const float sc = m1 + m2; if (sc > best) { best = sc; grp = gq; } }
                    float s4[4], a4[4];
#pragma unroll
                    for (int q = 0; q < 4; ++q) { s4[q] = grp == 0 ? sel[q] : grp == 1 ? sel[4 + q] : grp == 2 ? sel[8 + q] : sel[12 + q]; a4[q] = grp == 0 ? aff[q] : grp == 1 ? aff[4 + q] : grp == 2 ? aff[8 + q] : aff[12 + q]; }
                    int i1 = 0;
#pragma unroll
                    for (int q = 1; q < 4; ++q) if (s4[q] > s4[i1 == 0 ? 0 : i1 == 1 ? 1 : i1 == 2 ? 2 : 3]) i1 = q;
                    int i2 = -1; float b2 = -1e30f;
#pragma unroll
                    for (int q = 0; q < 4; ++q) if (q != i1 && s4[q] > b2) { b2 = s4[q]; i2 = q; }
                    const float a1 = i1 == 0 ? a4[0] : i1 == 1 ? a4[1] : i1 == 2 ? a4[2] : a4[3], a2 = i2 == 0 ? a4[0] : i2 == 1 ? a4[1] : i2 == 2 ? a4[2] : a4[3];
                    const float inv = 1.f / (a1 + a2);
                    if (lane == i) { e0 = grp * 4 + i1; e1 = grp * 4 + i2; g0 = a1 * inv; g1v = a2 * inv; }
                    if (rep_) CV_STEP(); }
                int p0 = 0, p1 = 0, mycount = 0; const unsigned long long lt = (1ull << lane) - 1ull;
#pragma unroll
                for (int e = 0; e < 16; ++e) { const unsigned long long b0 = __ballot(e0 == e), bb1 = __ballot(e1 == e); const int c0 = __popcll(b0);
                    if (lane == e) mycount = c0 + __popcll(bb1); if (e0 == e) p0 = __popcll(b0 & lt); if (e1 == e) p1 = c0 + __popcll(bb1 & lt); }
                int woff = 0; if (lane < 16) woff = __hip_atomic_fetch_add((LAS int*)(MISC + 16) + lane, mycount, __ATOMIC_RELAXED, __HIP_MEMORY_SCOPE_WORKGROUP);
                __syncthreads();
                if (tid < 16 && rep_) cbase[tid] = (int)xb_add(gcnt + tid * 64, (unsigned)cntL[tid]);
                __syncthreads();
                const int wo0 = __shfl(woff, e0 < 0 ? 0 : e0), wo1 = __shfl(woff, e1 < 0 ? 0 : e1);
                if (e0 >= 0 && rep_) { const int m = base + lane; const int q0 = cbase[e0] + wo0 + p0, q1 = cbase[e1] + wo1 + p1;
                    ROWIDX[e0 * CAP + q0] = m; ROWIDX[e1 * CAP + q1] = m; RTE[2 * m] = e0; RTE[2 * m + 1] = e1; RTP[2 * m] = q0; RTP[2 * m + 1] = q1; RTG[2 * m] = g0; RTG[2 * m + 1] = g1v; }
                __syncthreads();
            }
            while (cv_has) CV_STEP();
#undef CV_STEP
#undef DEC_MOE
            if (BOTH(pbase + 7)) GRID_BAR();
        }
        if (PHON(9) && (IN(pbase + 8) || IN(pbase + 9))) { PHASE_IDS LAYER_W
            volatile LAS int* TP = (volatile LAS int*)(MISC + 64); volatile LAS int* CNT = (volatile LAS int*)(MISC + 96);
            if (tid == 0) { int acc = 0; for (int e = 0; e < 16; ++e) { const int cn = (int)xb_ld(gcnt + e * 64); CNT[e] = cn; TP[e] = acc; acc += (cn + 255) >> 8; } TP[16] = acc; }
            __syncthreads();
            if (IN(pbase + 8)) {
                pg8::MoeSched Sd{(const char*)Hb, (const char*)W13T, ROWIDX, TP, CNT, 2048, 1024, (size_t)1024 * 1024 * 2, true, G, v}; pg8::EpiSwiglu E{HS};
                for (int rep_ = (PROBE_REPEAT == 9 ? 0 : 1); rep_ < 2; ++rep_)
                pg8::gemm_phase<pg8::EpiSwiglu, pg8::MoeSched, true>(lds, wid, 1024, 128u, Sd, E);
                if (BOTH(pbase + 8)) GRID_BAR();
            }
            if (IN(pbase + 9)) {
                pg8::MoeSched Sd{(const char*)HS, (const char*)W2T, ROWIDX, TP, CNT, 1024, 512, (size_t)1024 * 512 * 2, false, G, v}; pg8::EpiStore E{YS, 1024, nullptr, 0, false};
                for (int rep_ = (PROBE_REPEAT == 14 ? 0 : 1); rep_ < 2; ++rep_)
                pg8::gemm_phase<pg8::EpiStore, pg8::MoeSched, true>(lds, wid, 512, 128u, Sd, E);
                if (BOTH(pbase + 9)) GRID_BAR();
            }
        }
        if (PHON(10) && IN(pbase + 10)) { PHASE_IDS LAYER_W
            int tp = 0;
            { const int cn = lane < 16 ? (int)xb_ld(gcnt + lane * 64) : 0; const int tl = (cn + 255) >> 8; int inc = tl;
#pragma unroll
              for (int o = 1; o < 16; o <<= 1) { const int n = __shfl_up(inc, o); if (lane >= o) inc += n; }
              tp = inc - tl; }
            const float* g2 = INP[27] + l * 1024; const float* b2 = INP[28] + l * 1024;
            for (int rep_ = (PROBE_REPEAT == 10 ? 0 : 1); rep_ < 2; ++rep_)
            for (int m = gw; m < T; m += NGW) {
                const int e0 = RTE[2 * m], e1 = RTE[2 * m + 1];
                const int r0 = __shfl(tp, e0) * 256 + RTP[2 * m], r1 = __shfl(tp, e1) * 256 + RTP[2 * m + 1]; const float g0 = RTG[2 * m], g1v = RTG[2 * m + 1];
                f32x4 x[4];
#pragma unroll
                for (int j = 0; j < 4; ++j) { const int col = 4 * lane + 256 * j;
                    const u32x2 hw = *(const u32x2*)(Hb + (size_t)m * 1024 + col), y0 = *(const u32x2*)(YS + (size_t)r0 * 1024 + col), y1 = *(const u32x2*)(YS + (size_t)r1 * 1024 + col);
                    x[j][0] = ALPHA * bflo(hw.x) + g0 * bflo(y0.x) + g1v * bflo(y1.x); x[j][1] = ALPHA * bfhi(hw.x) + g0 * bfhi(y0.x) + g1v * bfhi(y1.x);
                    x[j][2] = ALPHA * bflo(hw.y) + g0 * bflo(y0.y) + g1v * bflo(y1.y); x[j][3] = ALPHA * bfhi(hw.y) + g0 * bfhi(y0.y) + g1v * bfhi(y1.y); }
                ln_row(x, g2, b2, lane);
                if (!rep_) continue;
                if (l == NLAYER - 1) {
#pragma unroll
                    for (int j = 0; j < 4; ++j) *(f32x4*)((float*)dout + (size_t)m * 1024 + 4 * lane + 256 * j) = x[j];
                } else store_row_bf16(Hb + (size_t)m * 1024, x, lane);
            }
            if (BOTH(pbase + 10)) GRID_BAR();
        }
    }
#undef IN
#undef BOTH
}

extern "C" void kernel_launch(void* const* d_in, const int* in_sizes, int n_in, void* d_out, int out_size, void* d_ws, size_t ws_size, hipStream_t stream) {
    static int grid = 0;
    if (grid == 0) {
        if (n_in != 29 || out_size != T * DM || ws_size < WS_END) { fprintf(stderr, "kernel_launch: unexpected shapes (n_in %d out %d ws %zu)\n", n_in, out_size, ws_size); grid = -1; return; }
        int dev = 0, cus = 0, per_cu = 0;
        if (hipGetDevice(&dev) != hipSuccess || hipDeviceGetAttribute(&cus, hipDeviceAttributeMultiprocessorCount, dev) != hipSuccess) { grid = -1; return; }
        if (hipFuncSetAttribute((const void*)fwd, hipFuncAttributeMaxDynamicSharedMemorySize, LDS_BYTES) != hipSuccess) { fprintf(stderr, "kernel_launch: hipFuncSetAttribute failed\n"); grid = -1; return; }
        if (hipOccupancyMaxActiveBlocksPerMultiprocessor(&per_cu, (const void*)fwd, 512, LDS_BYTES) != hipSuccess || per_cu < 1) fprintf(stderr, "kernel_launch: occupancy query reports %d\n", per_cu);
        (void)hipGetLastError();
        grid = cus;
    }
    if (grid < 0) return;
    (void)hipMemsetAsync((char*)d_ws + WS_CTL, 0, CTL_BYTES, stream);
    Args a{};
    for (int i = 0; i < 29; ++i) a.in[i] = (const float*)d_in[i];
    a.out = (float*)d_out; a.ws = (unsigned char*)d_ws;
#if MK_PER_PHASE
    for (int p = 0; p < NPHASE; ++p) { a.ph_lo = p; a.ph_hi = p + 1; hipLaunchKernelGGL(fwd, dim3(grid), dim3(512), LDS_BYTES, stream, a); }
#else
    a.ph_lo = 0; a.ph_hi = NPHASE; hipLaunchKernelGGL(fwd, dim3(grid), dim3(512), LDS_BYTES, stream, a);
#endif
}
```

```cpp
#include <hip/hip_runtime.h>
#include <cstdio>
#include <cstdint>

#ifndef MK_PER_PHASE
#define MK_PER_PHASE 0
#endif

#ifndef PROBE_REPEAT
#define PROBE_REPEAT 0
#endif
#ifndef PROBE_STAMP
#define PROBE_STAMP -1
#endif
#ifndef PROBE_BLOCK
#define PROBE_BLOCK 0
#endif
#ifndef PHMASK
#define PHMASK 0xFFFF
#endif
#define PHON(i) (((PHMASK) >> (i)) & 1)
#define LAS __attribute__((address_space(3)))
#define GAS __attribute__((address_space(1)))
typedef unsigned short bf16;
typedef short bf16x8 __attribute__((ext_vector_type(8)));
typedef short s16x4 __attribute__((ext_vector_type(4)));
typedef float f32x2 __attribute__((ext_vector_type(2)));
typedef float f32x4 __attribute__((ext_vector_type(4)));
typedef float f32x16 __attribute__((ext_vector_type(16)));
typedef unsigned u32x2 __attribute__((ext_vector_type(2)));
typedef unsigned u32x4 __attribute__((ext_vector_type(4)));
typedef __bf16 bf16x2_t __attribute__((ext_vector_type(2)));
typedef short v4i16_t __attribute__((ext_vector_type(4)));

constexpr int T = 32768, S = 8192, NB = 4, DM = 1024, NLAYER = 2;
constexpr int IN_W = 6328;
constexpr int PW = 3328;
constexpr int PC_NQ = 0, PC_KC = 512, PC_VC = 640, PC_KS = 768, PC_VS = 896, PC_KW = 1024, PC_VW = 1152, PC_DQ = 1280, PC_DK = 1792, PC_DV = 2304,
              PC_CQ = 2816, PC_CKV = 3072, PC_KR = 3200, PC_NG = 3232;
constexpr float LOG2E = 1.4426950408889634f;
constexpr float ALPHA = 1.4142135623730951f;
constexpr int NEXP = 16, CAP = 32768, DFF = 512;

constexpr size_t MiB = 1u << 20;
constexpr size_t WS_CTL = 0, CTL_BYTES = 128 * 1024;
constexpr size_t WS_CS = 1 * MiB;
constexpr size_t WS_MISC = 2 * MiB;
constexpr size_t WS_RSQ = 3 * MiB;
constexpr size_t WS_RSKV = WS_RSQ + 256 * 1024;
constexpr size_t WS_RTE = 4 * MiB;
constexpr size_t WS_RTP = WS_RTE + 512 * 1024;
constexpr size_t WS_RTG = WS_RTP + 512 * 1024;
constexpr size_t WS_ROWIDX = 6 * MiB;
constexpr size_t WS_KCMP = 8 * MiB;
constexpr size_t WS_VCMP = WS_KCMP + 512 * 1024;
constexpr size_t WS_UL = 10 * MiB;
constexpr size_t WS_WTS = 32 * MiB;
constexpr size_t WL_WIN = 0, WL_WG = 7 * MiB, WL_WBR = 13 * MiB, WL_WOUT = 16 * MiB, WL_WUQ = 18 * MiB, WL_WUKV = 18 * MiB + 512 * 1024, WL_WC1 = 19 * MiB, WL_STRIDE = 22 * MiB;
constexpr size_t WS_HB = 76 * MiB;
constexpr size_t WS_P = 140 * MiB;
constexpr size_t WS_HS = WS_P + 136 * MiB;
constexpr size_t WS_GS = 348 * MiB;
constexpr size_t WS_END = 444 * MiB;
constexpr size_t DO_QM = 0, DO_KVM = 48 * MiB, DO_W13 = 0, DO_W2 = 32 * MiB;

constexpr int CW_BAR = 4096;
constexpr int CW_CNT = 16384;

constexpr int LDS_RING = 131072, LDS_MISC = 131072, LDS_BYTES = 147456;
constexpr int NPHASE = 1 + 11 * NLAYER;

__device__ __forceinline__ int lane_id_v() { int l; asm volatile("v_mbcnt_lo_u32_b32 %0, -1, 0\n\tv_mbcnt_hi_u32_b32 %0, -1, %0" : "=v"(l)); return l; }
__device__ __forceinline__ unsigned f2bf(float f) { unsigned u = __builtin_bit_cast(unsigned, f); return (u + 0x7fffu + ((u >> 16) & 1u)) >> 16; }
__device__ __forceinline__ unsigned pk2(float lo, float hi) { f32x2 v = {lo, hi}; bf16x2_t b = __builtin_convertvector(v, bf16x2_t); return __builtin_bit_cast(unsigned, b); }
__device__ __forceinline__ float bflo(unsigned w) { return __uint_as_float(w << 16); }
__device__ __forceinline__ float bfhi(unsigned w) { return __uint_as_float(w & 0xffff0000u); }
__device__ __forceinline__ float bf2f(bf16 v) { return __uint_as_float(((unsigned)v) << 16); }
__device__ __forceinline__ float fexp2(float x) { return __builtin_amdgcn_exp2f(x); }
__device__ __forceinline__ float sigmoidf_(float x) { return 1.0f / (1.0f + __expf(-x)); }
__device__ __forceinline__ float wave_sum(float v) {
#pragma unroll
    for (int o = 1; o < 64; o <<= 1) v += __shfl_xor(v, o);
    return v;
}
__device__ __forceinline__ float hmax(float v) { auto rr = __builtin_amdgcn_permlane32_swap(__float_as_uint(v), __float_as_uint(v), false, false); return fmaxf(__uint_as_float(rr[0]), __uint_as_float(rr[1])); }
__device__ __forceinline__ float hsum(float v) { auto rr = __builtin_amdgcn_permlane32_swap(__float_as_uint(v), __float_as_uint(v), false, false); return __uint_as_float(rr[0]) + __uint_as_float(rr[1]); }

#define XB_TMO      128
#define XB_XCNT(j)  (256  + 64 * (j))
#define XB_XSUB(j)  (1280 + 64 * (j))
#define XB_XGEN(j)  (2304 + 64 * (j))
#define XB_TOP      3328
#define XB_TOPGEN   3392
#define XCD_BAR_WORDS 3456
#define XB_SPIN_CAP (1u << 23)
__device__ __forceinline__ unsigned xb_ld(unsigned* p)              { return __hip_atomic_load(p, __ATOMIC_RELAXED, __HIP_MEMORY_SCOPE_AGENT); }
__device__ __forceinline__ unsigned xb_add(unsigned* p, unsigned v) { return __hip_atomic_fetch_add(p, v, __ATOMIC_RELAXED, __HIP_MEMORY_SCOPE_AGENT); }
__device__ __forceinline__ unsigned xb_xcc_id() { return (unsigned)__builtin_amdgcn_s_getreg((3 << 11) | 20) & 0xFu; }
#define XB_SPIN(cond, bar) do { unsigned _sp = 0; while (cond) { __builtin_amdgcn_s_sleep(1); \
    if ((++_sp & 255u) == 0u) { if (xb_ld(&(bar)[XB_TMO])) break; if (_sp > XB_SPIN_CAP) { atomicAdd(&(bar)[XB_TMO], 1u); break; } } } } while (0)
struct XcdBarrier { unsigned* bar; unsigned x; volatile LAS unsigned* st; };
__device__ __forceinline__ XcdBarrier xcd_barrier_post(unsigned* bar, volatile LAS unsigned* st) {
    XcdBarrier b; b.bar = bar; b.x = xb_xcc_id(); b.st = st;
    if (threadIdx.x == 0) (void)xb_add(&bar[XB_XCNT(b.x)], 1u);
    return b;
}
__device__ __forceinline__ void xcd_barrier_complete(unsigned* bar, unsigned x, unsigned& nloc, unsigned& nx) {
    const unsigned G = gridDim.x * gridDim.y * gridDim.z;
    unsigned sum, cnt, mine, sp = 0u;
    for (;;) {
        sum = 0u; cnt = 0u; mine = 0u;
#pragma unroll
        for (unsigned j = 0; j < 16; ++j) { const unsigned c = xb_ld(&bar[XB_XCNT(j)]); sum += c; cnt += (c > 0u) ? 1u : 0u; mine = (j == x) ? c : mine; }
        if (sum == G) break;
        __builtin_amdgcn_s_sleep(1);
        if ((++sp & 255u) == 0u) { if (xb_ld(&bar[XB_TMO])) break; if (sp > XB_SPIN_CAP) { atomicAdd(&bar[XB_TMO], 1u); break; } }
    }
    nloc = mine > 0u ? mine : 1u; nx = cnt > 0u ? cnt : 1u;
}
__device__ __forceinline__ void xcd_barrier(const XcdBarrier& b) {
    asm volatile("s_waitcnt vmcnt(0)" ::: "memory");
    __syncthreads();
    if (threadIdx.x == 0) {
        unsigned* bar = b.bar;
        __builtin_amdgcn_s_waitcnt(0);
        unsigned nloc = b.st[0], nx = b.st[1];
        if (nloc == 0u) { xcd_barrier_complete(bar, b.x, nloc, nx); b.st[0] = nloc; b.st[1] = nx; }
        const unsigned old = xb_add(&bar[XB_XSUB(b.x)], 1u);
        const unsigned gen = old / nloc;
        if (old + 1u == (gen + 1u) * nloc) {
            __builtin_amdgcn_fence(__ATOMIC_RELEASE, "agent");
            asm volatile("s_waitcnt vmcnt(0)" ::: "memory");
            const unsigned og = xb_add(&bar[XB_TOP], 1u);
            const unsigned tg = og / nx;
            if (og + 1u == (tg + 1u) * nx) xb_add(&bar[XB_TOPGEN], 1u);
            else XB_SPIN(xb_ld(&bar[XB_TOPGEN]) == tg, bar);
            __builtin_amdgcn_fence(__ATOMIC_ACQUIRE, "agent");
            xb_add(&bar[XB_XGEN(b.x)], 1u);
            asm volatile("s_waitcnt vmcnt(0)" ::: "memory");
        } else {
            XB_SPIN(xb_ld(&bar[XB_XGEN(b.x)]) == gen, bar);
            __builtin_amdgcn_fence(__ATOMIC_ACQUIRE, "agent");
            asm volatile("s_waitcnt vmcnt(0)" ::: "memory");
        }
    }
    __syncthreads();
}

namespace pg8 {
constexpr int BM = 256, BK = 64, HALF = 128, HTB = HALF * BK * 2, STAGE_BYTES = 8 * HTB;
__device__ __forceinline__ int lds_byte(int r, int c) { const int st = (r >> 4) * 2 + (c >> 5), rr = r & 15, cc = c & 31, ob = rr * 64 + cc * 2; return st * 1024 + (ob ^ (((ob >> 9) & 1) << 5)); }
__device__ __forceinline__ void stage_rc(int b, int& R, int& C) { const int st = b / 1024, sb = b % 1024, swz = sb ^ (((sb >> 9) & 1) << 5); R = (st >> 1) * 16 + swz / 64; C = (st & 1) * 32 + (swz % 64) / 2; }
__device__ __forceinline__ int perm32(int rho) { const int n = rho >> 4, i = rho & 15; return 8 * (i >> 2) + 4 * n + (i & 3); }
struct Unit { int pm, pn, e; };
__device__ __forceinline__ void glds16_s(const void* sbase, unsigned voff, unsigned lds_dst) { unsigned keep;
    asm volatile("s_mov_b32 %0, m0\n\ts_mov_b32 m0, %3\n\ts_nop 0\n\tglobal_load_lds_dwordx4 %1, %2\n\ts_mov_b32 m0, %0" : "=&s"(keep) : "v"(voff), "s"(sbase), "s"(lds_dst) : "memory"); }
template <class Epi, class Sched, bool ALIGN_EPI>
__device__ __forceinline__ void gemm_phase(LAS unsigned char* lds, const int wid_in, const int K, const unsigned kstepA, const Sched& S, const Epi& E) {
    const int wid = wid_in, lane = lane_id_v(), tid = wid * 64 + lane, wr = wid >> 2, wc = wid & 3, fr = lane & 15, fq = lane >> 4;
    const int nt = K / BK;
    int Rr[2], Cc[2]; unsigned voffB[2];
#pragma unroll
    for (int i = 0; i < 2; ++i) { int R, C; stage_rc(tid * 16 + i * 8192, R, C); Rr[i] = R; Cc[i] = C; const int Rb = (R & ~31) + perm32(R & 31); voffB[i] = (unsigned)(Rb * K + C) * 2u; }
    const size_t kstepB = (size_t)(BK * 2);
    const size_t hstepB = (size_t)HALF * K * 2;
    const unsigned ldsb = (unsigned)(uintptr_t)lds + (unsigned)wid * 1024u;
    const int aoff = lds_byte(wr * 64 + fr, fq * 8), boff = lds_byte(wc * 32 + fr, fq * 8);
#define PG8_SA(b, h) (((b) * 2 + (h)) * HTB)
#define PG8_SB(b, h) ((4 + (b) * 2 + (h)) * HTB)
#define PG8_STAGE(bufoff, gbase, voff) do { _Pragma("unroll") for (int _i = 0; _i < 2; ++_i) \
        glds16_s((const void*)(gbase), (voff)[_i], ldsb + (unsigned)((bufoff) + _i * 8192)); } while (0)
#define PG8_LDA(dst, b, h) do { _Pragma("unroll") for (int m = 0; m < 4; ++m) _Pragma("unroll") for (int k = 0; k < 2; ++k) dst[m][k] = *(const LAS bf16x8*)(lds + PG8_SA(b, h) + aoff + m * 2048 + k * 1024); } while (0)
#define PG8_LDB(dst, b, h) do { _Pragma("unroll") for (int n = 0; n < 2; ++n) _Pragma("unroll") for (int k = 0; k < 2; ++k) dst[n][k] = *(const LAS bf16x8*)(lds + PG8_SB(b, h) + boff + n * 2048 + k * 1024); } while (0)
#define PG8_MMA(ai, bj, At, Bt) do { __builtin_amdgcn_s_setprio(1); _Pragma("unroll") for (int m = 0; m < 4; ++m) _Pragma("unroll") for (int n = 0; n < 2; ++n) _Pragma("unroll") for (int k = 0; k < 2; ++k) \
        acc[ai][bj][m][n] = __builtin_amdgcn_mfma_f32_16x16x32_bf16(Bt[n][k], At[m][k], acc[ai][bj][m][n], 0, 0, 0); __builtin_amdgcn_s_setprio(0); } while (0)
#define PG8_WAIT_V(n) asm volatile("s_waitcnt vmcnt(" #n ")" ::: "memory")
#define PG8_WAIT_L(n) asm volatile("s_waitcnt lgkmcnt(" #n ")" ::: "memory")
#define PG8_BAR __builtin_amdgcn_s_barrier()
#define PG8_SCHED __builtin_amdgcn_sched_barrier(0)
    Unit cur, nxt; int ui = 0;
    if (!S.next(0, cur)) return;
    f32x4 acc[2][2][4][2];
#pragma unroll
    for (int a = 0; a < 2; ++a)
#pragma unroll
        for (int b = 0; b < 2; ++b)
#pragma unroll
            for (int m = 0; m < 4; ++m)
#pragma unroll
                for (int n = 0; n < 2; ++n) acc[a][b][m][n] = (f32x4){0.f, 0.f, 0.f, 0.f};
    bf16x8 At[4][2], B0[2][2], B1[2][2];
    const char* cA; const char* cB; unsigned vc[2][2], vn[2][2];
    S.ptrs(cur, cA, cB); S.aoff(cur, Rr, Cc, vc);
    unsigned ksA = kstepA, ksN = kstepA;
    if constexpr (Sched::VAR_KSTEP) { ksA = S.kstep(cur); ksN = ksA; }
    PG8_STAGE(PG8_SB(0, 0), cB, voffB); PG8_STAGE(PG8_SB(0, 1), cB + hstepB, voffB); PG8_STAGE(PG8_SA(0, 0), cA, vc[0]); PG8_STAGE(PG8_SA(0, 1), cA, vc[1]);
    if (wr == 1) PG8_BAR;
    PG8_WAIT_V(2); PG8_BAR;
    PG8_STAGE(PG8_SB(1, 0), cB + kstepB, voffB); PG8_STAGE(PG8_SA(1, 0), cA + ksA, vc[0]); PG8_STAGE(PG8_SB(1, 1), cB + hstepB + kstepB, voffB);
    PG8_WAIT_V(6); PG8_BAR;
    for (;;) {
        const bool has_next = S.next(ui + 1, nxt);
        const char* nA = cA; const char* nB = cB;
        if (has_next) { S.ptrs(nxt, nA, nB); if constexpr (Sched::PER_UNIT_AOFF && !Sched::AOFF_CHEAP) S.aoff(nxt, Rr, Cc, vn); if constexpr (Sched::VAR_KSTEP) ksN = S.kstep(nxt); }
        else if constexpr (Sched::PER_UNIT_AOFF) {
            if constexpr (Sched::AOFF_CHEAP) nxt = cur;
#pragma unroll
            for (int h = 0; h < 2; ++h)
#pragma unroll
                for (int i = 0; i < 2; ++i) vn[h][i] = vc[h][i];
        }
        for (int t = 0; t < nt; t += 2) {
            const bool last = (t == nt - 2);
            const char* a1 = cA + (size_t)(t + 1) * ksA;
            const char* a2 = last ? nA : cA + (size_t)(t + 2) * ksA; const char* b2 = last ? nB : cB + (size_t)(t + 2) * kstepB;
            const char* a3 = a2 + (last ? ksN : ksA); const char* b3 = b2 + kstepB;
#define PG8_STAGE_A2(bufoff, gbase, h) do { if constexpr (Sched::PER_UNIT_AOFF) { if (last) { if constexpr (Sched::AOFF_CHEAP) { unsigned vt_[2][2]; S.aoff(nxt, Rr, Cc, vt_); PG8_STAGE(bufoff, gbase, vt_[h]); } else PG8_STAGE(bufoff, gbase, vn[h]); } else PG8_STAGE(bufoff, gbase, vc[h]); } else PG8_STAGE(bufoff, gbase, vc[h]); } while (0)
            PG8_LDB(B0, 0, 0); PG8_LDB(B1, 0, 1); PG8_SCHED; PG8_LDA(At, 0, 0); PG8_STAGE(PG8_SA(1, 1), a1, vc[1]);
            PG8_WAIT_V(8); PG8_WAIT_L(0); PG8_BAR; PG8_MMA(0, 0, At, B0); PG8_MMA(0, 1, At, B1); PG8_BAR; PG8_SCHED;
            PG8_LDA(At, 0, 1); PG8_STAGE(PG8_SB(0, 0), b2, voffB); PG8_STAGE(PG8_SB(0, 1), b2 + hstepB, voffB); PG8_STAGE_A2(PG8_SA(0, 0), a2, 0);
            PG8_WAIT_V(8); PG8_WAIT_L(0); PG8_BAR; PG8_MMA(1, 0, At, B0); PG8_MMA(1, 1, At, B1); PG8_BAR; PG8_SCHED;
            PG8_LDB(B0, 1, 0); PG8_LDB(B1, 1, 1); PG8_SCHED; PG8_LDA(At, 1, 0); PG8_STAGE_A2(PG8_SA(0, 1), a2, 1);
            PG8_WAIT_V(8); PG8_WAIT_L(0); PG8_BAR; PG8_MMA(0, 0, At, B0); PG8_MMA(0, 1, At, B1); PG8_BAR; PG8_SCHED;
            PG8_LDA(At, 1, 1); PG8_STAGE(PG8_SB(1, 0), b3, voffB); PG8_STAGE(PG8_SB(1, 1), b3 + hstepB, voffB); PG8_STAGE_A2(PG8_SA(1, 0), a3, 0);
            PG8_WAIT_V(8); PG8_WAIT_L(0); PG8_BAR; PG8_MMA(1, 0, At, B0); PG8_MMA(1, 1, At, B1); PG8_BAR; PG8_SCHED;
        }
        if constexpr (ALIGN_EPI) { if (wr == 0) PG8_BAR; }
        E(acc, cur, wr, wc, fr, fq);
        if (!has_next) break;
        bool keep = false; if constexpr (Epi::CHAIN) keep = E.keep(cur);
        if (!keep) {
#pragma unroll
        for (int a = 0; a < 2; ++a)
#pragma unroll
            for (int b = 0; b < 2; ++b)
#pragma unroll
                for (int m = 0; m < 4; ++m)
#pragma unroll
                    for (int n = 0; n < 2; ++n) acc[a][b][m][n] = (f32x4){0.f, 0.f, 0.f, 0.f};
        }
        cur = nxt; cA = nA; cB = nB; ++ui; ksA = ksN;
        if constexpr (Sched::PER_UNIT_AOFF) {
            if constexpr (Sched::AOFF_CHEAP) S.aoff(cur, Rr, Cc, vc);
            else {
#pragma unroll
            for (int h = 0; h < 2; ++h)
#pragma unroll
                for (int i = 0; i < 2; ++i) vc[h][i] = vn[h][i];
            }
        }
        if constexpr (ALIGN_EPI) { if (wr == 1) PG8_BAR; }
    }
    PG8_WAIT_V(0);
    if constexpr (!ALIGN_EPI) { if (wr == 0) PG8_BAR; }
    PG8_BAR;
#undef PG8_SA
#undef PG8_SB
#undef PG8_STAGE
#undef PG8_STAGE_A2
#undef PG8_LDA
#undef PG8_LDB
#undef PG8_MMA
#undef PG8_WAIT_V
#undef PG8_WAIT_L
#undef PG8_BAR
#undef PG8_SCHED
}

struct TileSched {
    static constexpr bool AOFF_CHEAP = false;
    static constexpr bool VAR_KSTEP = false;
    static constexpr bool PER_UNIT_AOFF = false;
    const char* A; const char* Bt; int lda; int K; int nN; int ntot; int G; int v;
    __device__ __forceinline__ bool next(int i, Unit& u) const { const int L = i * G + v; if (L >= ntot) return false; u.pm = L / nN; u.pn = L % nN; u.e = i; return true; }
    __device__ __forceinline__ void ptrs(const Unit& u, const char*& cA, const char*& cB) const { cA = A + (size_t)u.pm * 256 * lda; cB = Bt + (size_t)u.pn * 256 * K * 2; }
    __device__ __forceinline__ void aoff(const Unit&, const int (&R)[2], const int (&C)[2], unsigned (&vo)[2][2]) const {
#pragma unroll
        for (int h = 0; h < 2; ++h)
#pragma unroll
            for (int i = 0; i < 2; ++i) vo[h][i] = (unsigned)((h * 128 + R[i]) * lda + C[i] * 2);
    }
};
struct CmpSched {
    static constexpr bool AOFF_CHEAP = false;
    static constexpr bool VAR_KSTEP = false;
    static constexpr bool PER_UNIT_AOFF = false;
    const char* P; const char* W; int G; int v;
    __device__ __forceinline__ bool next(int i, Unit& u) const { const int L = i * G + v; if (L >= 64) return false; u.pm = (L >> 1) & 1; u.pn = L & 1; u.e = L >> 2; return true; }
    __device__ __forceinline__ void ptrs(const Unit& u, const char*& cA, const char*& cB) const {
        const int kv = u.e >> 3, b = (u.e >> 1) & 3, g = u.e & 1;
        cA = P + ((size_t)(b * S + u.pm * 4096) * PW + PC_KC + kv * 128 + g * 64) * 2; cB = W + (size_t)kv * (512 * 1024 * 2) + (size_t)u.pn * 256 * 2048; }
    __device__ __forceinline__ void aoff(const Unit&, const int (&R)[2], const int (&C)[2], unsigned (&vo)[2][2]) const {
#pragma unroll
        for (int h = 0; h < 2; ++h)
#pragma unroll
            for (int i = 0; i < 2; ++i) vo[h][i] = (unsigned)((h * 128 + R[i]) * (16 * PW * 2) + C[i] * 2);
    }
};
struct MoeSched {
    static constexpr bool VAR_KSTEP = false, AOFF_CHEAP = false;
    static constexpr bool PER_UNIT_AOFF = true;
    const char* A; const char* W; const int* rowidx; const volatile LAS int* TP; const volatile LAS int* CNT; int lda; int K; size_t wstride; bool gather; int G; int v;
    __device__ __forceinline__ bool next(int i, Unit& u) const {
        const int L = i * G + v; const int rt = L >> 2; if (rt >= __builtin_amdgcn_readfirstlane(TP[16])) return false;
        int e = 0;
#pragma unroll
        for (int j = 1; j < 16; ++j) e += (rt >= TP[j]) ? 1 : 0;
        u.pm = rt; u.pn = L & 3; u.e = __builtin_amdgcn_readfirstlane(e); return true; }
    __device__ __forceinline__ void ptrs(const Unit& u, const char*& cA, const char*& cB) const {
        cA = gather ? A : A + (size_t)u.pm * 256 * lda; cB = W + (size_t)u.e * wstride + (size_t)u.pn * 256 * K * 2; }
    __device__ __forceinline__ void aoff(const Unit& u, const int (&R)[2], const int (&C)[2], unsigned (&vo)[2][2]) const {
        if (gather) {
            const int r0 = (u.pm - __builtin_amdgcn_readfirstlane(TP[u.e])) * 256, cnt = __builtin_amdgcn_readfirstlane(CNT[u.e]);
#pragma unroll
            for (int h = 0; h < 2; ++h)
#pragma unroll
                for (int i = 0; i < 2; ++i) { int r = r0 + h * 128 + R[i]; r = r < cnt ? r : 0; const int tok = rowidx[u.e * CAP + r]; vo[h][i] = (unsigned)(tok * lda + C[i] * 2); }
        } else {
#pragma unroll
            for (int h = 0; h < 2; ++h)
#pragma unroll
                for (int i = 0; i < 2; ++i) vo[h][i] = (unsigned)((h * 128 + R[i]) * lda + C[i] * 2);
        }
    }
};

struct EpiStore {
    static constexpr bool CHAIN = false;
    bf16* O; int ldc; const float* rscale; size_t estride; bool remap160;
    __device__ __forceinline__ void operator()(const f32x4 (&acc)[2][2][4][2], const Unit& u, int wr, int wc, int fr, int fq) const {
        bf16* base = O + (estride ? (size_t)u.e * estride : (size_t)0);
        const int row0 = u.pm * 256 + wr * 64 + fr; int col0 = u.pn * 256 + wc * 32 + 8 * fq; int bjs = 128;
        if (remap160) { const int cm = col0 & 127; col0 = (col0 >> 7) * 160 + (cm < 64 ? cm : cm + 32); bjs = 160; }
#pragma unroll
        for (int ai = 0; ai < 2; ++ai)
#pragma unroll
            for (int m = 0; m < 4; ++m) { const int row = row0 + ai * 128 + m * 16; const float sc = rscale ? rscale[row] : 1.f; bf16* rowp = base + (size_t)row * ldc + col0;
#pragma unroll
                for (int bj = 0; bj < 2; ++bj) { const f32x4 v0 = acc[ai][bj][m][0] * sc, v1 = acc[ai][bj][m][1] * sc;
                    u32x4 w; w.x = pk2(v0[0], v0[1]); w.y = pk2(v0[2], v0[3]); w.z = pk2(v1[0], v1[1]); w.w = pk2(v1[2], v1[3]);
                    *(u32x4*)(rowp + bj * bjs) = w; } }
    }
};
struct EpiRope {
    static constexpr bool CHAIN = false;
    bf16* O; const float* CS;
    __device__ __forceinline__ void operator()(const f32x4 (&acc)[2][2][4][2], const Unit& u, int wr, int wc, int fr, int fq) const {
        const int row0 = u.pm * 256 + wr * 64 + fr, col0 = u.pn * 256 + wc * 32 + 8 * fq;
        int i0v[2]; bool rp[2];
#pragma unroll
        for (int bj = 0; bj < 2; ++bj) { const int cm = (col0 + bj * 128) % 96; rp[bj] = cm >= 64; i0v[bj] = rp[bj] ? (cm - 64) >> 1 : 0; }
#pragma unroll
        for (int ai = 0; ai < 2; ++ai)
#pragma unroll
            for (int m = 0; m < 4; ++m) {
                f32x4 ca[2], cb[2];
                const int row = row0 + ai * 128 + m * 16; const int pos = row & (S - 1);
#pragma unroll
                for (int bj = 0; bj < 2; ++bj) { const f32x4* cs = (const f32x4*)(CS + ((size_t)pos * 16 + i0v[bj]) * 2); ca[bj] = cs[0]; cb[bj] = cs[1]; }
                bf16* rowp = O + (size_t)row * 768 + col0;
#pragma unroll
                for (int bj = 0; bj < 2; ++bj) { f32x4 v[2] = {acc[ai][bj][m][0], acc[ai][bj][m][1]};
                    if (rp[bj]) {
                        const f32x4 a = ca[bj], b = cb[bj];
                        f32x4 r0, r1;
                        r0[0] = v[0][0] * a[0] - v[0][1] * a[1]; r0[1] = v[0][0] * a[1] + v[0][1] * a[0];
                        r0[2] = v[0][2] * a[2] - v[0][3] * a[3]; r0[3] = v[0][2] * a[3] + v[0][3] * a[2];
                        r1[0] = v[1][0] * b[0] - v[1][1] * b[1]; r1[1] = v[1][0] * b[1] + v[1][1] * b[0];
                        r1[2] = v[1][2] * b[2] - v[1][3] * b[3]; r1[3] = v[1][2] * b[3] + v[1][3] * b[2];
                        v[0] = r0; v[1] = r1; }
                    u32x4 w; w.x = pk2(v[0][0], v[0][1]); w.y = pk2(v[0][2], v[0][3]); w.z = pk2(v[1][0], v[1][1]); w.w = pk2(v[1][2], v[1][3]);
                    *(u32x4*)(rowp + bj * 128) = w; }
                asm volatile("" ::: "memory");
            }
    }
};
struct EpiGate {
    static constexpr bool CHAIN = false;
    bf16* GS;
    __device__ __forceinline__ void operator()(const f32x4 (&acc)[2][2][4][2], const Unit& u, int wr, int wc, int fr, int fq) const {
        bf16* base = GS + (size_t)u.e * 65536; const int row0 = wr * 64 + fr, col0 = wc * 32 + 8 * fq;
#pragma unroll
        for (int ai = 0; ai < 2; ++ai)
#pragma unroll
            for (int m = 0; m < 4; ++m) { bf16* rowp = base + (row0 + ai * 128 + m * 16) * 256 + col0;
#pragma unroll
                for (int bj = 0; bj < 2; ++bj) { const f32x4 v0 = acc[ai][bj][m][0], v1 = acc[ai][bj][m][1];
#define SG_(x) fmaxf(sigmoidf_(x), 1.0e-30f)
                    u32x4 w; w.x = pk2(SG_(v0[0]), SG_(v0[1])); w.y = pk2(SG_(v0[2]), SG_(v0[3])); w.z = pk2(SG_(v1[0]), SG_(v1[1])); w.w = pk2(SG_(v1[2]), SG_(v1[3]));
#undef SG_
                    *(u32x4*)(rowp + bj * 128) = w; } }
    }
};
struct EpiBranch {
    static constexpr bool CHAIN = false;
    bf16* Y; const bf16* GS; bool first;
    __device__ __forceinline__ void operator()(const f32x4 (&acc)[2][2][4][2], const Unit& u, int wr, int wc, int fr, int fq) const {
        const bf16* gbase = GS + (size_t)u.e * 65536; const int lrow0 = wr * 64 + fr, lcol0 = wc * 32 + 8 * fq;
#pragma unroll
        for (int ai = 0; ai < 2; ++ai)
#pragma unroll
            for (int mp = 0; mp < 2; ++mp) {
                u32x4 gwv[2][2], yov[2][2];
#pragma unroll
                for (int mm = 0; mm < 2; ++mm)
#pragma unroll
                    for (int bj = 0; bj < 2; ++bj) { const int lrow = lrow0 + ai * 128 + (2 * mp + mm) * 16;
                        gwv[mm][bj] = *(const u32x4*)(gbase + lrow * 256 + lcol0 + bj * 128);
                        if (!first) yov[mm][bj] = *(const u32x4*)(Y + (size_t)(u.pm * 256 + lrow) * DM + u.pn * 256 + lcol0 + bj * 128); }
#pragma unroll
                for (int mm = 0; mm < 2; ++mm) { const int m = 2 * mp + mm; const int lrow = lrow0 + ai * 128 + m * 16; bf16* yrow = Y + (size_t)(u.pm * 256 + lrow) * DM + u.pn * 256 + lcol0;
#pragma unroll
                    for (int bj = 0; bj < 2; ++bj) { const f32x4 v0 = acc[ai][bj][m][0], v1 = acc[ai][bj][m][1]; const u32x4 gw = gwv[mm][bj];
                        float r[8] = {v0[0] * bflo(gw.x), v0[1] * bfhi(gw.x), v0[2] * bflo(gw.y), v0[3] * bfhi(gw.y), v1[0] * bflo(gw.z), v1[1] * bfhi(gw.z), v1[2] * bflo(gw.w), v1[3] * bfhi(gw.w)};
                        if (!first) { const u32x4 yo = yov[mm][bj];
                            r[0] += bflo(yo.x); r[1] += bfhi(yo.x); r[2] += bflo(yo.y); r[3] += bfhi(yo.y); r[4] += bflo(yo.z); r[5] += bfhi(yo.z); r[6] += bflo(yo.w); r[7] += bfhi(yo.w); }
                        u32x4 w; w.x = pk2(r[0], r[1]); w.y = pk2(r[2], r[3]); w.z = pk2(r[4], r[5]); w.w = pk2(r[6], r[7]);
                        *(u32x4*)(yrow + bj * 128) = w; } }
            }
    }
};
struct EpiResid {
    static constexpr bool CHAIN = false;
    bf16* Z; const bf16* H;
    __device__ __forceinline__ void operator()(const f32x4 (&acc)[2][2][4][2], const Unit& u, int wr, int wc, int fr, int fq) const {
        const int row0 = u.pm * 256 + wr * 64 + fr, col0 = u.pn * 256 + wc * 32 + 8 * fq;
#pragma unroll
        for (int ai = 0; ai < 2; ++ai) {
            u32x4 hv[4][2];
#pragma unroll
            for (int m = 0; m < 4; ++m)
#pragma unroll
                for (int bj = 0; bj < 2; ++bj) hv[m][bj] = *(const u32x4*)(H + (size_t)(row0 + ai * 128 + m * 16) * DM + col0 + bj * 128);
#pragma unroll
            for (int m = 0; m < 4; ++m) { const size_t off = (size_t)(row0 + ai * 128 + m * 16) * DM + col0;
#pragma unroll
                for (int bj = 0; bj < 2; ++bj) { const u32x4 hw = hv[m][bj];
                    const f32x4 o0 = acc[ai][bj][m][0], o1 = acc[ai][bj][m][1];
                    u32x4 w; w.x = pk2(o0[0] + ALPHA * bflo(hw.x), o0[1] + ALPHA * bfhi(hw.x)); w.y = pk2(o0[2] + ALPHA * bflo(hw.y), o0[3] + ALPHA * bfhi(hw.y));
                    w.z = pk2(o1[0] + ALPHA * bflo(hw.z), o1[1] + ALPHA * bfhi(hw.z)); w.w = pk2(o1[2] + ALPHA * bflo(hw.w), o1[3] + ALPHA * bfhi(hw.w));
                    *(u32x4*)(Z + off + bj * 128) = w; } }
        }
    }
};
struct EpiSwiglu {
    static constexpr bool CHAIN = false;
    bf16* HS;
    __device__ __forceinline__ void operator()(const f32x4 (&acc)[2][2][4][2], const Unit& u, int wr, int wc, int fr, int fq) const {
        const int row0 = u.pm * 256 + wr * 64 + fr, col0 = u.pn * 128 + wc * 32 + 8 * fq;
#pragma unroll
        for (int ai = 0; ai < 2; ++ai)
#pragma unroll
            for (int m = 0; m < 4; ++m) { bf16* rowp = HS + (size_t)(row0 + ai * 128 + m * 16) * DFF + col0;
                float r[8];
#pragma unroll
                for (int n = 0; n < 2; ++n)
#pragma unroll
                    for (int q = 0; q < 4; ++q) { const float a = acc[ai][0][m][n][q], b = acc[ai][1][m][n][q]; r[n * 4 + q] = a * sigmoidf_(a) * b; }
                u32x4 w; w.x = pk2(r[0], r[1]); w.y = pk2(r[2], r[3]); w.z = pk2(r[4], r[5]); w.w = pk2(r[6], r[7]);
                *(u32x4*)rowp = w; }
    }
};

struct GateSched {
    static constexpr bool AOFF_CHEAP = false;
    static constexpr bool PER_UNIT_AOFF = false, VAR_KSTEP = false;
    const char* A; const char* Wg; int pm, pn; bool valid;
    __device__ __forceinline__ bool next(int i, Unit& u) const { if (!valid || i >= 3) return false; u.pm = pm; u.pn = pn; u.e = i; return true; }
    __device__ __forceinline__ void ptrs(const Unit& u, const char*& cA, const char*& cB) const { cA = A + (size_t)pm * 256 * 2048; cB = Wg + ((size_t)u.e * 1024 + (size_t)pn * 256) * 2048; }
    __device__ __forceinline__ void aoff(const Unit&, const int (&R)[2], const int (&C)[2], unsigned (&vo)[2][2]) const {
#pragma unroll
        for (int h = 0; h < 2; ++h)
#pragma unroll
            for (int i = 0; i < 2; ++i) vo[h][i] = (unsigned)((h * 128 + R[i]) * 2048 + C[i] * 2);
    }
};
struct ChainSched {
    static constexpr bool AOFF_CHEAP = true;
    static constexpr bool PER_UNIT_AOFF = true, VAR_KSTEP = true;
    const char* Pn; const char* Pd; const char* Qm; const char* Wbr; int pm, pn; bool valid;
    __device__ __forceinline__ bool next(int i, Unit& u) const { if (!valid || i >= 3) return false; u.pm = pm; u.pn = pn; u.e = i; return true; }
    __device__ __forceinline__ int lda(const Unit& u) const { return u.e == 2 ? 1536 : PW * 2; }
    __device__ __forceinline__ unsigned kstep(const Unit& u) const { return u.e == 2 ? 192u : 128u; }
    __device__ __forceinline__ void ptrs(const Unit& u, const char*& cA, const char*& cB) const {
        cA = (u.e == 0 ? Pn : (u.e == 1 ? Pd : Qm)) + (size_t)pm * 256 * lda(u); cB = Wbr + (size_t)u.e * (1024 * 512 * 2) + (size_t)pn * 256 * 1024; }
    __device__ __forceinline__ void aoff(const Unit& u, const int (&R)[2], const int (&C)[2], unsigned (&vo)[2][2]) const { const int ld = lda(u);
#pragma unroll
        for (int h = 0; h < 2; ++h)
#pragma unroll
            for (int i = 0; i < 2; ++i) vo[h][i] = (unsigned)((h * 128 + R[i]) * ld + C[i] * 2);
    }
};
struct EpiChain {
    static constexpr bool CHAIN = true;
    bf16* Y; const bf16* GS;
    __device__ __forceinline__ bool keep(const Unit& u) const { return u.e < 2; }
    __device__ __forceinline__ void operator()(f32x4 (&acc)[2][2][4][2], const Unit& u, int wr, int wc, int fr, int fq) const {
        const int j = u.e; const bf16* ga = GS + (size_t)j * 65536; const bf16* gb = GS + (size_t)(j < 2 ? j + 1 : j) * 65536; const int lrow0 = wr * 64 + fr, lcol0 = wc * 32 + 8 * fq;
#pragma unroll
        for (int ai = 0; ai < 2; ++ai)
#pragma unroll
            for (int m = 0; m < 4; ++m) {
#pragma unroll
                for (int bj = 0; bj < 2; ++bj) { const int off = (lrow0 + ai * 128 + m * 16) * 256 + lcol0 + bj * 128;
                    const u32x4 a = *(const u32x4*)(ga + off); float f[8] = {bflo(a.x), bfhi(a.x), bflo(a.y), bfhi(a.y), bflo(a.z), bfhi(a.z), bflo(a.w), bfhi(a.w)};
                    if (j < 2) { const u32x4 b = *(const u32x4*)(gb + off); const float d[8] = {bflo(b.x), bfhi(b.x), bflo(b.y), bfhi(b.y), bflo(b.z), bfhi(b.z), bflo(b.w), bfhi(b.w)};
#pragma unroll
                        for (int q = 0; q < 8; ++q) f[q] *= __builtin_amdgcn_rcpf(d[q]); }
                    f32x4& v0 = acc[ai][bj][m][0]; f32x4& v1 = acc[ai][bj][m][1];
                    v0[0] *= f[0]; v0[1] *= f[1]; v0[2] *= f[2]; v0[3] *= f[3]; v1[0] *= f[4]; v1[1] *= f[5]; v1[2] *= f[6]; v1[3] *= f[7];
                    if (j == 2) { u32x4 w; w.x = pk2(v0[0], v0[1]); w.y = pk2(v0[2], v0[3]); w.z = pk2(v1[0], v1[1]); w.w = pk2(v1[2], v1[3]);
                        *(u32x4*)(Y + (size_t)(u.pm * 256 + lrow0 + ai * 128 + m * 16) * DM + u.pn * 256 + lcol0 + bj * 128) = w; } }
                asm volatile("" ::: "memory");
            }
    }
};
}

namespace fa {
constexpr float NEG = -1.0e30f;
__device__ __forceinline__ int crow(int i, int hb) { return (i & 3) + 8 * (i >> 2) + 4 * hb; }
__device__ __forceinline__ s16x4 vtr(const LAS char* p) { return __builtin_bit_cast(s16x4, __builtin_amdgcn_ds_read_tr16_b64_v4i16((LAS v4i16_t*)p)); }

template <int DQK>
__device__ __forceinline__ void qk_tile(const LAS char* kl, const bf16x8 (&qf)[DQK / 16], f32x16& s0, f32x16& s1, int r32, int hb) {
    constexpr int KSTR = DQK * 2 + 16, KS = DQK / 16;
    const LAS char* kp = kl + r32 * KSTR + hb * 16;
    bf16x8 k0[KS], k1[KS];
#pragma unroll
    for (int s = 0; s < KS; ++s) { k0[s] = *(const LAS bf16x8*)(kp + s * 32); k1[s] = *(const LAS bf16x8*)(kp + 32 * KSTR + s * 32); }
    __builtin_amdgcn_sched_barrier(0);
    const f32x16 z = {0.f, 0.f, 0.f, 0.f, 0.f, 0.f, 0.f, 0.f, 0.f, 0.f, 0.f, 0.f, 0.f, 0.f, 0.f, 0.f};
    s0 = __builtin_amdgcn_mfma_f32_32x32x16_bf16(k0[0], qf[0], z, 0, 0, 0);
    s1 = __builtin_amdgcn_mfma_f32_32x32x16_bf16(k1[0], qf[0], z, 0, 0, 0);
#pragma unroll
    for (int s = 1; s < KS; ++s) {
        s0 = __builtin_amdgcn_mfma_f32_32x32x16_bf16(k0[s], qf[s], s0, 0, 0, 0);
        s1 = __builtin_amdgcn_mfma_f32_32x32x16_bf16(k1[s], qf[s], s1, 0, 0, 0);
    }
}
template <bool CHECK>
__device__ __forceinline__ void score_tile(f32x16& s0, f32x16& s1, float d0, float kstep, float c1, float slope2, float wlim, bool lanevalid, int hb) {
#pragma unroll
    for (int i = 0; i < 16; ++i) {
        const float k0 = (float)crow(i, hb) * kstep;
        const float da = d0 - k0, db = d0 - k0 - 32.f * kstep;
        float va = __builtin_fmaf(s0[i], c1, -slope2 * da), vb = __builtin_fmaf(s1[i], c1, -slope2 * db);
        if (CHECK) { va = (da >= 0.f && da < wlim && lanevalid) ? va : NEG; vb = (db >= 0.f && db < wlim && lanevalid) ? vb : NEG; }
        s0[i] = va; s1[i] = vb;
    }
}
__device__ __forceinline__ float tile_max(const f32x16& s0, const f32x16& s1) {
    float a = fmaxf(fmaxf(s0[0], s0[1]), s1[0]), b = fmaxf(fmaxf(s0[2], s0[3]), s1[1]);
    a = fmaxf(fmaxf(a, s1[2]), s1[3]);
#pragma unroll
    for (int i = 4; i < 16; i += 4) { a = fmaxf(fmaxf(a, s0[i]), s0[i + 1]); b = fmaxf(fmaxf(b, s0[i + 2]), s0[i + 3]); a = fmaxf(fmaxf(a, s1[i]), s1[i + 1]); b = fmaxf(fmaxf(b, s1[i + 2]), s1[i + 3]); }
    return hmax(fmaxf(a, b));
}
__device__ __forceinline__ void pack_p(const f32x16& s0, const f32x16& s1, bf16x8 (&pa)[4]) {
#pragma unroll
    for (int sp = 0; sp < 2; ++sp) {
        u32x4 w0, w1;
        w0.x = pk2(s0[8 * sp + 0], s0[8 * sp + 1]); w0.y = pk2(s0[8 * sp + 2], s0[8 * sp + 3]); w0.z = pk2(s0[8 * sp + 4], s0[8 * sp + 5]); w0.w = pk2(s0[8 * sp + 6], s0[8 * sp + 7]);
        w1.x = pk2(s1[8 * sp + 0], s1[8 * sp + 1]); w1.y = pk2(s1[8 * sp + 2], s1[8 * sp + 3]); w1.z = pk2(s1[8 * sp + 4], s1[8 * sp + 5]); w1.w = pk2(s1[8 * sp + 6], s1[8 * sp + 7]);
        pa[sp] = __builtin_bit_cast(bf16x8, w0); pa[2 + sp] = __builtin_bit_cast(bf16x8, w1);
    }
}
__device__ __forceinline__ float softmax_step(f32x16& s0, f32x16& s1, float& m, float& l) {
    const float mx = tile_max(s0, s1);
    const float mn = fmaxf(m, mx);
    const float alpha = fexp2(m - mn);
    m = mn;
    float ra = 0.f, rb = 0.f;
#pragma unroll
    for (int i = 0; i < 16; ++i) { s0[i] = fexp2(s0[i] - mn); s1[i] = fexp2(s1[i] - mn); ra += s0[i]; rb += s1[i]; }
    l = l * alpha + hsum(ra + rb);
    return alpha;
}
template <int DV>
__device__ __forceinline__ int v_swz(int key) { return DV == 64 ? (((key >> 1) & 1) << 6) : ((key & 3) << 6); }
template <int DV>
__device__ __forceinline__ void v_load(const LAS char* vl, int lane, int dvb0, bf16x8 (&vf)[2][4]) {
    constexpr int VSTR = DV * 2;
    const int g16 = lane >> 4, i16 = lane & 15, q = i16 >> 2, p = i16 & 3, hb = lane >> 5;
    const int f = (DV == 64) ? ((q >> 1) & 1) : q;
    const int rowb = (4 * hb + q) * VSTR + 2 * (16 * (g16 & 1) + 4 * p);
#pragma unroll
    for (int d = 0; d < 2; ++d) {
        unsigned vba = (unsigned)(uintptr_t)vl + (unsigned)(rowb + (((dvb0 + d) ^ f) << 6));
        asm volatile("" : "+v"(vba));
        const LAS char* vb = (const LAS char*)vba;
#pragma unroll
        for (int ks = 0; ks < 4; ++ks) {
            const s16x4 lo = vtr(vb + (16 * ks) * VSTR), hi = vtr(vb + (16 * ks + 8) * VSTR);
            vf[d][ks] = (bf16x8){lo[0], lo[1], lo[2], lo[3], hi[0], hi[1], hi[2], hi[3]};
        }
    }
}
__device__ __forceinline__ void pv_mma(const bf16x8 (&vf)[2][4], const bf16x8 (&pa)[4], f32x16& oa, f32x16& ob) {
#pragma unroll
    for (int ks = 0; ks < 4; ++ks) {
        oa = __builtin_amdgcn_mfma_f32_32x32x16_bf16(vf[0][ks], pa[ks], oa, 0, 0, 0);
        ob = __builtin_amdgcn_mfma_f32_32x32x16_bf16(vf[1][ks], pa[ks], ob, 0, 0, 0);
    }
}
template <int DV>
__device__ __forceinline__ void pv_tile(const LAS char* vl, const bf16x8 (&pa)[4], f32x16 (&o)[DV / 32], int lane) {
#pragma unroll
    for (int d0 = 0; d0 < DV / 32; d0 += 2) { bf16x8 vf[2][4]; v_load<DV>(vl, lane, d0, vf); __builtin_amdgcn_sched_barrier(0); pv_mma(vf, pa, o[d0], o[d0 + 1]); }
}
}

constexpr int A_KB = 13312, A_VB0 = 26624, A_VB = 16384;
constexpr int A_SC = 61440, A_SM = 129920, A_UN = 130944;
__device__ __forceinline__ float alibi_slope(int idx) { return fexp2(-8.0f * (float)(idx + 1) / 12.0f); }
__device__ __forceinline__ unsigned getw(const u32x4& w, int i) { return i == 0 ? w.x : (i == 1 ? w.y : (i == 2 ? w.z : w.w)); }
__device__ __forceinline__ int next_bit(const u32x4& w, int from) {
    int res = 128;
#pragma unroll
    for (int wi = 3; wi >= 0; --wi) { unsigned x = getw(w, wi); const int lo = wi * 32;
        if (from > lo + 31) x = 0u; else if (from > lo) x &= (~0u) << (from - lo);
        if (x) res = lo + __builtin_ctz(x); }
    return res;
}

struct Ld64 {
    const char* kp; const char* vp; int kstr, vstr; u32x4 rk, rv;
    __device__ __forceinline__ void issue(int key0, int tid, bool withV) { const int row = tid >> 3, ch = tid & 7;
        rk = *(const u32x4*)(kp + (size_t)(key0 + row) * kstr + ch * 16); if (withV) rv = *(const u32x4*)(vp + (size_t)(key0 + row) * vstr + ch * 16); }
    __device__ __forceinline__ void commit(LAS char* kl, LAS char* vl, int tid, bool withV) { const int row = tid >> 3, ch = tid & 7;
        *(LAS u32x4*)(kl + row * 144 + ch * 16) = rk; if (withV) *(LAS u32x4*)(vl + row * 128 + ((ch * 16) ^ fa::v_swz<64>(row))) = rv; }
};
struct LdDiff {
    const char* kp; const char* vp; u32x4 rk, rv0, rv1;
    __device__ __forceinline__ void issue(int key0, int tid) {
        rk = *(const u32x4*)(kp + (size_t)(key0 + (tid >> 3)) * (PW * 2) + (tid & 7) * 16);
        const char* v = vp + (size_t)(key0 + (tid >> 4)) * (PW * 2) + (tid & 15) * 16; rv0 = *(const u32x4*)v; rv1 = *(const u32x4*)(v + (size_t)32 * PW * 2); }
    __device__ __forceinline__ void commit(LAS char* kl, LAS char* vl, int tid) {
        *(LAS u32x4*)(kl + (tid >> 3) * 144 + (tid & 7) * 16) = rk;
        const int row = tid >> 4, off = ((tid & 15) * 16) ^ fa::v_swz<128>(row);
        *(LAS u32x4*)(vl + row * 256 + off) = rv0; *(LAS u32x4*)(vl + (row + 32) * 256 + off) = rv1; }
};
struct LdMla {
    const char* knp; const char* krp; const char* vp; u32x4 rk0, rk1, rv;
    __device__ __forceinline__ const char* ksrc(int key0, int c) const { const int row = c / 12, ch = c - row * 12;
        return ch < 8 ? knp + (size_t)(key0 + row) * 2048 + ch * 16 : krp + (size_t)(key0 + row) * (PW * 2) + (ch - 8) * 16; }
    __device__ __forceinline__ void issue(int key0, int tid) {
        rk0 = *(const u32x4*)ksrc(key0, tid); if (tid < 256) rk1 = *(const u32x4*)ksrc(key0, tid + 512);
        rv = *(const u32x4*)(vp + (size_t)(key0 + (tid >> 3)) * 2048 + (tid & 7) * 16); }
    __device__ __forceinline__ void commit(LAS char* kl, LAS char* vl, int tid) {
        { const int row = tid / 12, ch = tid - row * 12; *(LAS u32x4*)(kl + row * 208 + ch * 16) = rk0; }
        if (tid < 256) { const int c = tid + 512, row = c / 12, ch = c - row * 12; *(LAS u32x4*)(kl + row * 208 + ch * 16) = rk1; }
        const int row = tid >> 3; *(LAS u32x4*)(vl + row * 128 + (((tid & 7) * 16) ^ fa::v_swz<64>(row))) = rv; }
};

template <int DQK, int DV, class Ld>
__device__ __forceinline__ void flash_causal(LAS char* lds, Ld& ld, const bf16x8 (&qf)[DQK / 16], f32x16 (&o)[DV / 32], float& m, float& l,
                                             int q0, int wq0, int t, float c1, float slope2, int tid, int lane, int r32, int hb) {
    const int nt = (q0 + 256) >> 6;
    ld.issue(0, tid); ld.commit(lds, lds + A_VB0, tid); __syncthreads();
    for (int kt = 0; kt < nt; ++kt) {
        const int buf = kt & 1, key0 = 64 * kt;
        if (kt + 1 < nt) ld.issue(key0 + 64, tid);
        if (key0 <= wq0 + 31) {
            f32x16 s0, s1; fa::qk_tile<DQK>(lds + buf * A_KB, qf, s0, s1, r32, hb);
            if (key0 + 63 > wq0) fa::score_tile<true>(s0, s1, (float)(t - key0), 1.f, c1, slope2, 1.0e9f, true, hb);
            else fa::score_tile<false>(s0, s1, (float)(t - key0), 1.f, c1, slope2, 1.0e9f, true, hb);
            const float alpha = fa::softmax_step(s0, s1, m, l);
#pragma unroll
            for (int d = 0; d < DV / 32; ++d) o[d] = o[d] * alpha;
            bf16x8 pa[4]; fa::pack_p(s0, s1, pa);
            fa::pv_tile<DV>(lds + A_VB0 + buf * A_VB, pa, o, lane);
        }
        if (kt + 1 < nt) ld.commit(lds + (buf ^ 1) * A_KB, lds + A_VB0 + (buf ^ 1) * A_VB, tid);
        __syncthreads();
    }
}


#ifndef DIFF_PIPE
#define DIFF_PIPE false
#endif
#ifndef MLA_PIPE
#define MLA_PIPE false
#endif
#ifndef PROBE_VAR
#define PROBE_VAR 0
#endif
namespace fr {
template <int DQK, int DV> struct Geo {
    static constexpr int KS = DQK / 16, NDV = DV / 32;
    static constexpr int KROWB = (DQK == 64) ? 128 : 256;
    static constexpr int KSLOT = 64 * KROWB, VSLOT = 64 * DV * 2;
    static constexpr int KBASE = 0, VBASE = 3 * KSLOT;
    static constexpr int PK = KSLOT / 8192, PV = VSLOT / 8192;
};
template <int DQK> __device__ __forceinline__ void k_offsets(unsigned* vo, int wid, int lane, int strideB) {
    if constexpr (DQK == 64) { const int row = 8 * wid + (lane >> 3), cp = lane & 7, c = cp ^ ((row >> 1) & 7); vo[0] = (unsigned)(row * strideB + c * 16); }
    else {
#pragma unroll
        for (int j = 0; j < 2; ++j) { const int p = wid + 8 * j, row = 4 * p + (lane >> 4), cp = lane & 15; int c = cp ^ (row & 15); if (c >= 12) c = 0; vo[j] = (unsigned)(row * strideB + c * 16); }
    }
}
template <int DV> __device__ __forceinline__ void v_offsets(unsigned* vo, int wid, int lane, int strideB) {
    if constexpr (DV == 64) { const int row = 8 * wid + (lane >> 3), pp = lane & 7, lg = ((((pp >> 2) ^ ((row >> 1) & 1))) << 2) | (pp & 3); vo[0] = (unsigned)(row * strideB + lg * 16); }
    else {
#pragma unroll
        for (int j = 0; j < 2; ++j) { const int p = wid + 8 * j, row = 4 * p + (lane >> 4), pp = lane & 15, lg = (((pp >> 2) ^ (row & 3)) << 2) | (pp & 3); vo[j] = (unsigned)(row * strideB + lg * 16); }
    }
}
template <int DQK, bool BATCH = true>
__device__ __forceinline__ void qk_ring(const LAS char* kl, const int (&ka)[DQK / 16], const bf16x8 (&qf)[DQK / 16], f32x16& s0, f32x16& s1) {
    constexpr int KROWB = (DQK == 64) ? 128 : 256, KS = DQK / 16;
    bf16x8 k0[KS], k1[KS];
#pragma unroll
    for (int s = 0; s < KS; ++s) { unsigned a = (unsigned)(uintptr_t)kl + (unsigned)ka[s]; asm volatile("" : "+v"(a)); const LAS char* kp = (const LAS char*)a;
        k0[s] = *(const LAS bf16x8*)kp; k1[s] = *(const LAS bf16x8*)(kp + 32 * KROWB); }
    if constexpr (BATCH) __builtin_amdgcn_sched_barrier(0);
    const f32x16 z = {0.f, 0.f, 0.f, 0.f, 0.f, 0.f, 0.f, 0.f, 0.f, 0.f, 0.f, 0.f, 0.f, 0.f, 0.f, 0.f};
    s0 = __builtin_amdgcn_mfma_f32_32x32x16_bf16(k0[0], qf[0], z, 0, 0, 0);
    s1 = __builtin_amdgcn_mfma_f32_32x32x16_bf16(k1[0], qf[0], z, 0, 0, 0);
#pragma unroll
    for (int s = 1; s < KS; ++s) {
        s0 = __builtin_amdgcn_mfma_f32_32x32x16_bf16(k0[s], qf[s], s0, 0, 0, 0);
        s1 = __builtin_amdgcn_mfma_f32_32x32x16_bf16(k1[s], qf[s], s1, 0, 0, 0);
    }
}
template <bool ALIBI, bool CHECK, int NDV>
__device__ __forceinline__ void soft_tile(f32x16& s0, f32x16& s1, float c1, float slope2, float d0, int hb, float& m, float& l, f32x16 (&o)[NDV], bf16x8 (&pa)[4]) {
    const float dh = d0 - (float)(4 * hb);
    const float E = ALIBI ? -slope2 * d0 : 0.f;
    if constexpr (CHECK) {
#pragma unroll
        for (int i = 0; i < 16; ++i) { const float ci = (float)((i & 3) + 8 * (i >> 2)); if (ci > dh) s0[i] = fa::NEG; if (ci + 32.f > dh) s1[i] = fa::NEG; }
    }
    const float mx = fa::tile_max(s0, s1) + E;
    const float mn = fmaxf(m, mx);
    if (NDV > 2 || __builtin_amdgcn_ballot_w64(mn > m) != 0ull) {
        const float alpha = fexp2(m - mn); l *= alpha;
#pragma unroll
        for (int d = 0; d < NDV; ++d) o[d] = o[d] * alpha;
    }
    m = mn;
    float ra = 0.f, rb = 0.f; const float sub = mn - E;
#pragma unroll
    for (int i = 0; i < 16; ++i) {
        s0[i] = fexp2(s0[i] - sub); s1[i] = fexp2(s1[i] - sub);
        ra += s0[i]; rb += s1[i]; }
    l += hsum(ra + rb);
    fa::pack_p(s0, s1, pa);
}
#define FR_WAITBAR(N) asm volatile("s_waitcnt vmcnt(" #N ") lgkmcnt(0)\n\ts_barrier" ::: "memory")
template <int DQK, int DV, bool ALIBI, bool PIPE, int VAR = 0>
__device__ __forceinline__ void flash_ring(LAS char* lds, const char* kbase, const char* vbase, const int strideB, const bf16x8 (&qf)[DQK / 16], f32x16 (&o)[DV / 32], float& m, float& l,
                                           const int q0, const int wq0, const int t, const float c1, const float slope2, const int wid, const int lane) {
    typedef Geo<DQK, DV> GG;
    constexpr int PK = GG::PK, PV = GG::PV, NDV = DV / 32;
    const int r32 = lane & 31, hb = lane >> 5;
    const int nt = (q0 + 256) >> 6, tmax = (wq0 + 31) >> 6;
    const int iskip = nt - 1 - tmax;
    unsigned voK[PK], voV[PV];
    k_offsets<DQK>(voK, wid, lane, strideB); v_offsets<DV>(voV, wid, lane, strideB);
    int ka[DQK / 16];
    { const int f = (DQK == 64) ? ((r32 >> 1) & 7) : (r32 & 15);
#pragma unroll
      for (int s = 0; s < DQK / 16; ++s) ka[s] = r32 * GG::KROWB + (((2 * s + hb) ^ f) << 4); }
    const unsigned ldsb = (unsigned)(uintptr_t)lds + (unsigned)wid * 1024u;
#define FR_ISSUE_K(it) do { const int it_ = (it); const char* b_ = kbase + (size_t)(nt - 1 - it_) * 64 * strideB; const unsigned d_ = ldsb + GG::KBASE + (unsigned)(it_ % 3) * GG::KSLOT; \
        _Pragma("unroll") for (int j_ = 0; j_ < PK; ++j_) pg8::glds16_s(b_, voK[j_], d_ + j_ * 8192); } while (0)
#define FR_ISSUE_V(it) do { const int it_ = (it); const char* b_ = vbase + (size_t)(nt - 1 - it_) * 64 * strideB; const unsigned d_ = ldsb + GG::VBASE + (unsigned)(it_ % 3) * GG::VSLOT; \
        _Pragma("unroll") for (int j_ = 0; j_ < PV; ++j_) pg8::glds16_s(b_, voV[j_], d_ + j_ * 8192); } while (0)
    constexpr bool KPRE = PIPE;
    constexpr int KA = KPRE ? 1 : 0, KS = DQK / 16;
#define FR_ISSUE(i_) do { if ((i_) + 2 + KA < nt) FR_ISSUE_K((i_) + 2 + KA); if ((i_) + 2 < nt) FR_ISSUE_V((i_) + 2); } while (0)
#define FR_END(i_) do { if ((i_) + 2 + KA < nt) { if constexpr (PK + PV == 2) FR_WAITBAR(2); else FR_WAITBAR(3); } \
        else if ((i_) + 2 < nt) { if constexpr (PV == 1) FR_WAITBAR(1); else FR_WAITBAR(2); } else FR_WAITBAR(0); } while (0)
#define FR_KSLOT(i_) (lds + GG::KBASE + ((i_) % 3) * GG::KSLOT)
#define FR_VSLOT(i_) (lds + GG::VBASE + ((i_) % 3) * GG::VSLOT)
    bf16x8 kf0[KS], kf1[KS];
    bf16x8 kx0 = {0, 0, 0, 0, 0, 0, 0, 0}, kx1 = {0, 0, 0, 0, 0, 0, 0, 0}, qx = {0, 0, 0, 0, 0, 0, 0, 0};
    if constexpr (ALIBI) { if (hb == 0) { const short a0 = (short)f2bf((float)r32), a1 = (short)f2bf((float)(r32 + 32)); kx0[0] = a0; kx0[1] = a0; kx1[0] = a1; kx1[1] = a1;
        float sl_ = slope2; asm volatile("" : "+v"(sl_));
        const unsigned hi = f2bf(sl_); const float lo = sl_ - __uint_as_float(hi << 16); qx[0] = (short)hi; qx[1] = (short)f2bf(lo); } }
#define FR_KLOAD(i_) do { const LAS char* kl_ = FR_KSLOT(i_); _Pragma("unroll") for (int s_ = 0; s_ < KS; ++s_) { unsigned a_ = (unsigned)(uintptr_t)kl_ + (unsigned)ka[s_]; asm volatile("" : "+v"(a_)); \
        const LAS char* kp_ = (const LAS char*)a_; kf0[s_] = *(const LAS bf16x8*)kp_; kf1[s_] = *(const LAS bf16x8*)(kp_ + 32 * GG::KROWB); } } while (0)
#define FR_QKMMA(S0_, S1_) do { const f32x16 z_ = {0.f, 0.f, 0.f, 0.f, 0.f, 0.f, 0.f, 0.f, 0.f, 0.f, 0.f, 0.f, 0.f, 0.f, 0.f, 0.f}; \
        S0_ = __builtin_amdgcn_mfma_f32_32x32x16_bf16(kf0[0], qf[0], z_, 0, 0, 0); S1_ = __builtin_amdgcn_mfma_f32_32x32x16_bf16(kf1[0], qf[0], z_, 0, 0, 0); \
        _Pragma("unroll") for (int s_ = 1; s_ < KS; ++s_) { S0_ = __builtin_amdgcn_mfma_f32_32x32x16_bf16(kf0[s_], qf[s_], S0_, 0, 0, 0); S1_ = __builtin_amdgcn_mfma_f32_32x32x16_bf16(kf1[s_], qf[s_], S1_, 0, 0, 0); } \
        if constexpr (ALIBI) { S0_ = __builtin_amdgcn_mfma_f32_32x32x16_bf16(kx0, qx, S0_, 0, 0, 0); S1_ = __builtin_amdgcn_mfma_f32_32x32x16_bf16(kx1, qx, S1_, 0, 0, 0); } } while (0)
    FR_ISSUE_K(0); if constexpr (KPRE) FR_ISSUE_K(1); FR_ISSUE_V(0);
    FR_ISSUE_K(1 + KA); FR_ISSUE_V(1);
    if constexpr (PK + PV == 2) FR_WAITBAR(2); else FR_WAITBAR(3);
    int i = 0;
    if (KPRE && iskip == 0) FR_KLOAD(0);
    for (; i < iskip; ++i) { FR_ISSUE(i); if (KPRE && i == iskip - 1) FR_KLOAD(i + 1); FR_END(i); }
    f32x16 sc0, sc1;
#define FR_TILE(CHK) do { FR_ISSUE(i); bf16x8 pa[4], vf[2][4]; const float d0f = (float)(t - 64 * (nt - 1 - i)); \
        if constexpr (!KPRE) { FR_KLOAD(i); } \
        if constexpr (VAR != 3 && VAR != 5) FR_QKMMA(sc0, sc1); \
        if constexpr (DV == 64 && VAR != 2 && VAR != 5) { fa::v_load<DV>(FR_VSLOT(i), lane, 0, vf); __builtin_amdgcn_sched_barrier(0); } \
        if constexpr (CHK || (VAR != 1 && VAR != 5)) soft_tile<ALIBI, CHK, NDV>(sc0, sc1, c1, slope2, d0f, hb, m, l, o, pa); else fa::pack_p(sc0, sc1, pa); \
        if constexpr (KPRE) { if (i + 1 < nt) FR_KLOAD(i + 1); __builtin_amdgcn_sched_barrier(0); } \
        if constexpr (!CHK && (VAR == 2 || VAR == 5)) { o[0][0] += __builtin_bit_cast(float, (int)pa[0][0] + (int)pa[1][1] + (int)pa[2][2] + (int)pa[3][3]); } else { \
        _Pragma("unroll") for (int d0 = 0; d0 < NDV; d0 += 2) { if (DV != 64 || d0 != 0) { fa::v_load<DV>(FR_VSLOT(i), lane, d0, vf); __builtin_amdgcn_sched_barrier(0); } fa::pv_mma(vf, pa, o[d0], o[d0 + 1]); } } \
        FR_END(i); } while (0)
    FR_TILE(true); ++i;
    for (; i < nt; ++i) FR_TILE(false);
#undef FR_TILE
#undef FR_KLOAD
#undef FR_QKMMA
#undef FR_ISSUE_K
#undef FR_ISSUE_V
#undef FR_ISSUE
#undef FR_END
#undef FR_KSLOT
#undef FR_VSLOT
}
}

__device__ __forceinline__ void diff_unit(LAS char* lds, int b, int h, int qt, bf16* P, float lam, float lam_init, const float* subg, bf16* scratch, int wid, bool dry = false) {
    const int lane = lane_id_v(), r32 = lane & 31, hb = lane >> 5;
    const int q0 = 256 * qt, wq0 = q0 + 32 * wid, t = wq0 + r32;
    bf16* prow = P + ((size_t)b * S + t) * PW;
    const char* pb = (const char*)(P + (size_t)b * S * PW);
    const float slope2 = alibi_slope(8 + h) * LOG2E, c1 = 0.125f * LOG2E;
    u32x4* o1g = (u32x4*)scratch + wid * 64 + lane;
    f32x16 o[4]; float m = 0.f, l = 0.f;
    for (int map = 0; map < 2; ++map) {
        bf16x8 qf[4];
#pragma unroll
        for (int s = 0; s < 4; ++s) { const u32x4 w = *(const u32x4*)(prow + PC_DQ + h * 128 + map * 64 + 16 * s + 8 * hb); u32x4 r;
            r.x = pk2(bflo(w.x) * c1, bfhi(w.x) * c1); r.y = pk2(bflo(w.y) * c1, bfhi(w.y) * c1); r.z = pk2(bflo(w.z) * c1, bfhi(w.z) * c1); r.w = pk2(bflo(w.w) * c1, bfhi(w.w) * c1);
            qf[s] = __builtin_bit_cast(bf16x8, r); }
#pragma unroll
        for (int d = 0; d < 4; ++d)
#pragma unroll
            for (int i = 0; i < 16; ++i) o[d][i] = 0.f;
        m = fa::NEG; l = 0.f;
        fr::flash_ring<64, 128, true, DIFF_PIPE>(lds, pb + (PC_DK + h * 128 + map * 64) * 2, pb + (PC_DV + h * 128) * 2, PW * 2, qf, o, m, l, q0, wq0, t, c1, slope2, wid, lane);
        if (map == 0) { const float inv = 1.f / l;
#pragma unroll
            for (int d = 0; d < 4; ++d)
#pragma unroll
                for (int k = 0; k < 2; ++k) { u32x4 w; w.x = pk2(o[d][8 * k] * inv, o[d][8 * k + 1] * inv); w.y = pk2(o[d][8 * k + 2] * inv, o[d][8 * k + 3] * inv);
                    w.z = pk2(o[d][8 * k + 4] * inv, o[d][8 * k + 5] * inv); w.w = pk2(o[d][8 * k + 6] * inv, o[d][8 * k + 7] * inv); o1g[512 * (2 * d + k)] = w; } }
    }
    const float inv2 = lam / l; float ss = 0.f;
#pragma unroll
    for (int d = 0; d < 4; ++d)
#pragma unroll
        for (int k = 0; k < 2; ++k) { u32x4 w;
            { const unsigned long long* p64 = (const unsigned long long*)(o1g + 512 * (2 * d + k));
              const unsigned long long x0 = __hip_atomic_load(p64, __ATOMIC_RELAXED, __HIP_MEMORY_SCOPE_AGENT), x1 = __hip_atomic_load(p64 + 1, __ATOMIC_RELAXED, __HIP_MEMORY_SCOPE_AGENT);
              w.x = (unsigned)x0; w.y = (unsigned)(x0 >> 32); w.z = (unsigned)x1; w.w = (unsigned)(x1 >> 32); }
            const float a0 = bflo(w.x) - o[d][8 * k] * inv2, a1 = bfhi(w.x) - o[d][8 * k + 1] * inv2, a2 = bflo(w.y) - o[d][8 * k + 2] * inv2, a3 = bfhi(w.y) - o[d][8 * k + 3] * inv2;
            const float a4 = bflo(w.z) - o[d][8 * k + 4] * inv2, a5 = bfhi(w.z) - o[d][8 * k + 5] * inv2, a6 = bflo(w.w) - o[d][8 * k + 6] * inv2, a7 = bfhi(w.w) - o[d][8 * k + 7] * inv2;
            o[d][8 * k] = a0; o[d][8 * k + 1] = a1; o[d][8 * k + 2] = a2; o[d][8 * k + 3] = a3; o[d][8 * k + 4] = a4; o[d][8 * k + 5] = a5; o[d][8 * k + 6] = a6; o[d][8 * k + 7] = a7;
            ss += (a0 * a0 + a1 * a1) + (a2 * a2 + a3 * a3) + (a4 * a4 + a5 * a5) + (a6 * a6 + a7 * a7); }
    ss = hsum(ss);
    const float rs = __builtin_amdgcn_rsqf(ss * (1.f / 128.f) + 1e-6f) * (1.f - lam_init);
#pragma unroll
    for (int d = 0; d < 4; ++d)
#pragma unroll
        for (int k = 0; k < 4; ++k) { const int dv = 32 * d + 8 * k + 4 * hb; const f32x4 g = *(const f32x4*)(subg + dv);
            u32x2 w; w.x = pk2(o[d][4 * k] * rs * g[0], o[d][4 * k + 1] * rs * g[1]); w.y = pk2(o[d][4 * k + 2] * rs * g[2], o[d][4 * k + 3] * rs * g[3]);
            if (!dry) *(u32x2*)(prow + PC_DQ + h * 128 + dv) = w; }
}

constexpr int KVW = 1280;
__device__ __forceinline__ void mla_unit(LAS char* lds, int b, int h, int qt, bf16* QM, const bf16* KVM, const float* rsq, int wid, bool dry = false) {
    const int lane = lane_id_v(), r32 = lane & 31, hb = lane >> 5;
    const int q0 = 256 * qt, wq0 = q0 + 32 * wid, t = wq0 + r32; const size_t mrow = (size_t)b * S + t;
    bf16* qrow = QM + mrow * 768 + h * 96;
    bf16x8 qf[6];
#pragma unroll
    for (int s = 0; s < 6; ++s) qf[s] = *(const bf16x8*)(qrow + 16 * s + 8 * hb);
    const float c1 = 0.10206207261596575f * LOG2E * rsq[mrow];
#pragma unroll
    for (int s = 0; s < 6; ++s) { const u32x4 w = __builtin_bit_cast(u32x4, qf[s]); u32x4 r;
        r.x = pk2(bflo(w.x) * c1, bfhi(w.x) * c1); r.y = pk2(bflo(w.y) * c1, bfhi(w.y) * c1); r.z = pk2(bflo(w.z) * c1, bfhi(w.z) * c1); r.w = pk2(bflo(w.w) * c1, bfhi(w.w) * c1);
        qf[s] = __builtin_bit_cast(bf16x8, r); }
    const char* kb = (const char*)(KVM + (size_t)b * S * KVW + h * 160);
    f32x16 o[2];
#pragma unroll
    for (int d = 0; d < 2; ++d)
#pragma unroll
        for (int i = 0; i < 16; ++i) o[d][i] = 0.f;
    float m = fa::NEG, l = 0.f;
    if (PROBE_VAR != 0 && dry) fr::flash_ring<96, 64, false, MLA_PIPE, PROBE_VAR>(lds, kb, kb + 192, KVW * 2, qf, o, m, l, q0, wq0, t, c1, 0.f, wid, lane); else
    fr::flash_ring<96, 64, false, MLA_PIPE>(lds, kb, kb + 192, KVW * 2, qf, o, m, l, q0, wq0, t, c1, 0.f, wid, lane);
    const float inv = 1.f / l;
#pragma unroll
    for (int d = 0; d < 2; ++d)
#pragma unroll
        for (int k = 0; k < 4; ++k) { u32x2 w; w.x = pk2(o[d][4 * k] * inv, o[d][4 * k + 1] * inv); w.y = pk2(o[d][4 * k + 2] * inv, o[d][4 * k + 3] * inv);
            if (!dry) *(u32x2*)(qrow + 32 * d + 8 * k + 4 * hb) = w; }
}

#define LAUNDER(x) asm volatile("" : "+v"(x))
#define NSA_IDS const int lane = lane_id_v(), tid = wid * 64 + lane, r32 = lane & 31, hb = lane >> 5, h4 = r32 >> 3, qi = r32 & 7; (void)h4; (void)qi; (void)hb; (void)r32;
__device__ __forceinline__ void nsa_unit(LAS char* lds, int b, int g, int j, bf16* P, const bf16* KCMP, const bf16* VCMP, int wid, bool dry = false) {
    const int lane = lane_id_v(), r32 = lane & 31, hb = lane >> 5, h4 = r32 >> 3, qi = r32 & 7;
    const int head = 4 * g + h4, t0 = 64 * j, t = t0 + 8 * wid + qi;
    bf16* prow = P + ((size_t)b * S + t) * PW;
    const char* pb = (const char*)(P + (size_t)b * S * PW);
    bf16x8 qf[4];
#pragma unroll
    for (int s = 0; s < 4; ++s) qf[s] = *(const bf16x8*)(prow + PC_NQ + head * 64 + 16 * s + 8 * hb);
    const float slope2 = alibi_slope(head) * LOG2E, c1 = 0.125f * LOG2E;
    const float gc = sigmoidf_(bf2f(prow[PC_NG + head * 3 + 0])), gs = sigmoidf_(bf2f(prow[PC_NG + head * 3 + 1])), gw = sigmoidf_(bf2f(prow[PC_NG + head * 3 + 2]));
    LAS float* sc = (LAS float*)(lds + A_SC + wid * 4096);
    { float z = 0.f; LAUNDER(z);
#pragma unroll
    for (int k = 0; k < 4; ++k) *(LAS f32x4*)(sc + lane * 16 + 4 * k) = (f32x4){z, z, z, z}; }
    f32x16 ob[2];
#pragma unroll
    for (int d = 0; d < 2; ++d)
#pragma unroll
        for (int i = 0; i < 16; ++i) ob[d][i] = 0.f;
    {
        NSA_IDS
        const int ntc = (4 * j + 3 + 63) >> 6;
        Ld64 ld; ld.kp = (const char*)(KCMP + (size_t)(b * 2 + g) * 512 * 64); ld.vp = (const char*)(VCMP + (size_t)(b * 2 + g) * 512 * 64); ld.kstr = 128; ld.vstr = 128;
        float mc = fa::NEG, lc = 0.f;
        ld.issue(0, tid, false); ld.commit(lds, lds + A_VB0, tid, false); __syncthreads();
        for (int kt = 0; kt < ntc; ++kt) {
            const int buf = kt & 1;
            if (kt + 1 < ntc) ld.issue(64 * (kt + 1), tid, false);
            f32x16 s0, s1; fa::qk_tile<64>(lds + buf * A_KB, qf, s0, s1, r32, hb);
            fa::score_tile<true>(s0, s1, (float)(t - 31 - 1024 * kt), 16.f, c1, slope2, 1.0e9f, true, hb);
            (void)fa::softmax_step(s0, s1, mc, lc);
            if (kt + 1 < ntc) ld.commit(lds + (buf ^ 1) * A_KB, lds + A_VB0, tid, false);
            __syncthreads();
        }
        const float inv = (mc > -1.0e29f) ? 1.f / lc : 0.f;
        float carry = 0.f;
        ld.issue(0, tid, true); ld.commit(lds, lds + A_VB0, tid, true); __syncthreads();
        for (int kt = 0; kt < ntc; ++kt) {
            const int buf = kt & 1;
            if (kt + 1 < ntc) ld.issue(64 * (kt + 1), tid, true);
            f32x16 s0, s1; fa::qk_tile<64>(lds + buf * A_KB, qf, s0, s1, r32, hb);
            fa::score_tile<true>(s0, s1, (float)(t - 31 - 1024 * kt), 16.f, c1, slope2, 1.0e9f, true, hb);
#pragma unroll
            for (int i = 0; i < 16; ++i) { s0[i] = fexp2(s0[i] - mc) * inv; s1[i] = fexp2(s1[i] - mc) * inv; }
            { float mainv[8], ps[8];
#pragma unroll
              for (int gq = 0; gq < 8; ++gq) { const int kb = gq >> 2, k = gq & 3;
                  const float p0 = kb ? s1[4 * k] : s0[4 * k], p1 = kb ? s1[4 * k + 1] : s0[4 * k + 1], p2 = kb ? s1[4 * k + 2] : s0[4 * k + 2], p3 = kb ? s1[4 * k + 3] : s0[4 * k + 3];
                  float mv = 2.f * (p0 + p1 + p2) + p3, sv = p3;
                  mv += __shfl_xor(mv, 8); mv += __shfl_xor(mv, 16); sv += __shfl_xor(sv, 8); sv += __shfl_xor(sv, 16);
                  mainv[gq] = mv;
                  auto rr = __builtin_amdgcn_permlane32_swap(__float_as_uint(sv), __float_as_uint(sv), false, false);
                  ps[gq] = __uint_as_float(hb ? rr[0] : rr[1]); }
#pragma unroll
              for (int gq = 0; gq < 8; ++gq) { const float prev = gq ? ps[gq - 1] : carry; const float fin = mainv[gq] + (hb ? ps[gq] : prev);
                  if (h4 == 0) sc[qi * 128 + 16 * kt + 8 * (gq >> 2) + 2 * (gq & 3) + hb] = fin; }
              carry = ps[7]; }
            bf16x8 pa[4]; fa::pack_p(s0, s1, pa);
            fa::pv_tile<64>(lds + A_VB0 + buf * A_VB, pa, ob, lane);
            if (kt + 1 < ntc) ld.commit(lds + (buf ^ 1) * A_KB, lds + A_VB0 + (buf ^ 1) * A_VB, tid, true);
            __syncthreads();
        }
#pragma unroll
        for (int d = 0; d < 2; ++d)
#pragma unroll
            for (int i = 0; i < 16; ++i) ob[d][i] = gc * ob[d][i];
    }
    {
        NSA_IDS
        asm volatile("s_waitcnt lgkmcnt(0)" ::: "memory");
        const int qq = lane >> 3, sub = lane & 7, cur = j;
        float v[16];
#pragma unroll
        for (int k = 0; k < 4; ++k) { const f32x4 x = *(const LAS f32x4*)(sc + qq * 128 + 16 * sub + 4 * k); v[4 * k] = x[0]; v[4 * k + 1] = x[1]; v[4 * k + 2] = x[2]; v[4 * k + 3] = x[3]; }
        unsigned bits = 0u;
        if (cur < 16) {
#pragma unroll
            for (int jj = 0; jj < 16; ++jj) if (16 * sub + jj <= cur) bits |= 1u << jj;
        } else {
#pragma unroll
            for (int jj = 0; jj < 16; ++jj) { const int blk = 16 * sub + jj; if (!(blk >= 1 && blk <= cur - 2)) v[jj] = -1.f; }
            for (int round = 0; round < 13; ++round) {
                float bm = v[0]; int bi = 0;
#pragma unroll
                for (int jj = 1; jj < 16; ++jj) if (v[jj] > bm) { bm = v[jj]; bi = jj; }
                int gi = 16 * sub + bi;
#pragma unroll
                for (int st = 1; st < 8; st <<= 1) { const float ov = __shfl_xor(bm, st); const int oi = __shfl_xor(gi, st); if (ov > bm || (ov == bm && oi < gi)) { bm = ov; gi = oi; } }
                const bool own = (gi >> 4) == sub; const int wj = gi & 15;
#pragma unroll
                for (int jj = 0; jj < 16; ++jj) if (own && jj == wj) { v[jj] = -1.f; bits |= 1u << jj; }
            }
#pragma unroll
            for (int jj = 0; jj < 16; ++jj) { const int blk = 16 * sub + jj; if (blk == 0 || blk == cur || blk == cur - 1) bits |= 1u << jj; }
        }
        ((LAS unsigned short*)(lds + A_SM + wid * 128))[qq * 8 + sub] = (unsigned short)bits;
        unsigned ub = bits; ub |= __shfl_xor(ub, 8); ub |= __shfl_xor(ub, 16); ub |= __shfl_xor(ub, 32);
        if (lane < 8) ((LAS unsigned short*)(lds + A_UN))[wid * 8 + lane] = (unsigned short)ub;
    }
    __syncthreads();
    LAS float* otl = (LAS float*)(lds + A_SC + wid * 8192) + lane;
#pragma unroll
    for (int d = 0; d < 2; ++d)
#pragma unroll
        for (int i = 0; i < 16; ++i) { otl[64 * (16 * d + i)] = ob[d][i]; ob[d][i] = 0.f; }
    {
        NSA_IDS
        u32x4 un = (u32x4){0u, 0u, 0u, 0u};
#pragma unroll
        for (int w = 0; w < 8; ++w) { const u32x4 x = *(const LAS u32x4*)(lds + A_UN + w * 16); un.x |= x.x; un.y |= x.y; un.z |= x.z; un.w |= x.w; }
        un.x = __builtin_amdgcn_readfirstlane(un.x); un.y = __builtin_amdgcn_readfirstlane(un.y); un.z = __builtin_amdgcn_readfirstlane(un.z); un.w = __builtin_amdgcn_readfirstlane(un.w);
        u32x4 wv = *(const LAS u32x4*)(lds + A_UN + wid * 16);
        wv.x = __builtin_amdgcn_readfirstlane(wv.x); wv.y = __builtin_amdgcn_readfirstlane(wv.y); wv.z = __builtin_amdgcn_readfirstlane(wv.z); wv.w = __builtin_amdgcn_readfirstlane(wv.w);
        const u32x4 mq = *(const LAS u32x4*)(lds + A_SM + wid * 128 + qi * 16);
        Ld64 ld; ld.kp = pb + (PC_KS + g * 64) * 2; ld.vp = pb + (PC_VS + g * 64) * 2; ld.kstr = PW * 2; ld.vstr = PW * 2;
        float ms = fa::NEG, ls = 0.f;
        int blk = next_bit(un, 0), buf = 0;
        ld.issue(64 * blk, tid, true); ld.commit(lds, lds + A_VB0, tid, true); __syncthreads();
        while (blk < 128) {
            const int nblk = next_bit(un, blk + 1);
            if (nblk < 128) ld.issue(64 * nblk, tid, true);
            if ((getw(wv, blk >> 5) >> (blk & 31)) & 1u) {
                f32x16 s0, s1; fa::qk_tile<64>(lds + buf * A_KB, qf, s0, s1, r32, hb);
                const bool lsel = ((getw(mq, blk >> 5) >> (blk & 31)) & 1u) != 0u;
                fa::score_tile<true>(s0, s1, (float)(t - 64 * blk), 1.f, c1, slope2, 1.0e9f, lsel, hb);
                const float alpha = fa::softmax_step(s0, s1, ms, ls);
                ob[0] = ob[0] * alpha; ob[1] = ob[1] * alpha;
                bf16x8 pa[4]; fa::pack_p(s0, s1, pa);
                fa::pv_tile<64>(lds + A_VB0 + buf * A_VB, pa, ob, lane);
            }
            if (nblk < 128) ld.commit(lds + (buf ^ 1) * A_KB, lds + A_VB0 + (buf ^ 1) * A_VB, tid, true);
            __syncthreads(); buf ^= 1; blk = nblk;
        }
        const float f = (ms > -1.0e29f) ? gs / ls : 0.f;
#pragma unroll
        for (int d = 0; d < 2; ++d)
#pragma unroll
            for (int i = 0; i < 16; ++i) { otl[64 * (16 * d + i)] += f * ob[d][i]; ob[d][i] = 0.f; }
    }
    {
        NSA_IDS
        Ld64 ld; ld.kp = pb + (PC_KW + g * 64) * 2; ld.vp = pb + (PC_VW + g * 64) * 2; ld.kstr = PW * 2; ld.vstr = PW * 2;
        float mw = fa::NEG, lw = 0.f;
        const int b0 = j >= 8 ? j - 8 : 0; int buf = 0;
        ld.issue(64 * b0, tid, true); ld.commit(lds, lds + A_VB0, tid, true); __syncthreads();
        for (int blk = b0; blk <= j; ++blk) {
            if (blk < j) ld.issue(64 * (blk + 1), tid, true);
            f32x16 s0, s1; fa::qk_tile<64>(lds + buf * A_KB, qf, s0, s1, r32, hb);
            if (blk == j || blk == j - 8) fa::score_tile<true>(s0, s1, (float)(t - 64 * blk), 1.f, c1, slope2, 512.f, true, hb);
            else fa::score_tile<false>(s0, s1, (float)(t - 64 * blk), 1.f, c1, slope2, 512.f, true, hb);
            const float alpha = fa::softmax_step(s0, s1, mw, lw);
            ob[0] = ob[0] * alpha; ob[1] = ob[1] * alpha;
            bf16x8 pa[4]; fa::pack_p(s0, s1, pa);
            fa::pv_tile<64>(lds + A_VB0 + buf * A_VB, pa, ob, lane);
            if (blk < j) ld.commit(lds + (buf ^ 1) * A_KB, lds + A_VB0 + (buf ^ 1) * A_VB, tid, true);
            __syncthreads(); buf ^= 1;
        }
        const float f = (mw > -1.0e29f) ? gw / lw : 0.f;
#pragma unroll
        for (int d = 0; d < 2; ++d)
#pragma unroll
            for (int i = 0; i < 16; ++i) ob[d][i] = otl[64 * (16 * d + i)] + f * ob[d][i];
    }
#pragma unroll
    for (int d = 0; d < 2; ++d)
#pragma unroll
        for (int k = 0; k < 4; ++k) { u32x2 w; w.x = pk2(ob[d][4 * k], ob[d][4 * k + 1]); w.y = pk2(ob[d][4 * k + 2], ob[d][4 * k + 3]);
            if (!dry) *(u32x2*)(prow + PC_NQ + head * 64 + 32 * d + 8 * k + 4 * hb) = w; }
    __syncthreads();
}

__device__ __forceinline__ int srccol(int mode, int n) {
    if (mode == 0) return n;
    if (mode == 1) {
        if (n < 1280) return n;
        if (n < 2816) return n - 1280 + 1304;
        if (n < 3200) return n - 2816 + 2840;
        if (n < 3232) { const int i = n - 3200; return 3224 + (i & 1) * 16 + (i >> 1); }
        if (n < 3256) return 1280 + (n - 3232);
        return -1; }
    { const int h = n / 96, c = n - h * 96; if (c < 64) return n; const int i = c - 64; return h * 96 + 64 + (i & 1) * 16 + (i >> 1); }
}
__device__ __forceinline__ void tconv_item(const float* W, int ldw, const float* kscale, bf16* WT, int K, int N, int mode, int item, LAS float* scr, int lane) {
    const int nblk = N / 32, kb = item / nblk, nb = item - kb * nblk, k0 = 64 * kb, n0 = 32 * nb;
    if (mode == 0 || (mode == 1 && n0 + 31 < 3200)) {
        const int c0 = srccol(mode, n0), kq = lane >> 3, n4 = (lane & 7) * 4;
        f32x4 x[8];
#pragma unroll
        for (int i = 0; i < 8; ++i) x[i] = *(const f32x4*)(W + (size_t)(k0 + kq + 8 * i) * ldw + c0 + n4);
#pragma unroll
        for (int i = 0; i < 8; ++i) { const int kk = kq + 8 * i; const float ksc = kscale ? kscale[k0 + kk] : 1.f; LAS float* d = scr + kk * 33 + n4;
            d[0] = x[i][0] * ksc; d[1] = x[i][1] * ksc; d[2] = x[i][2] * ksc; d[3] = x[i][3] * ksc; }
    } else {
    const int sc = srccol(mode, n0 + (lane & 31));
#pragma unroll 8
    for (int i = 0; i < 32; ++i) { const int kk = 2 * i + (lane >> 5); float x = 0.f; if (sc >= 0) { x = W[(size_t)(k0 + kk) * ldw + sc]; if (kscale) x *= kscale[k0 + kk]; } scr[kk * 33 + (lane & 31)] = x; }
    }
    asm volatile("s_waitcnt lgkmcnt(0)" ::: "memory");
    const int c = lane & 7;
#pragma unroll
    for (int j = 0; j < 4; ++j) { const int n = (lane >> 3) + 8 * j; const LAS float* s = scr + (8 * c) * 33 + n;
        u32x4 o; o.x = pk2(s[0 * 33], s[1 * 33]); o.y = pk2(s[2 * 33], s[3 * 33]); o.z = pk2(s[4 * 33], s[5 * 33]); o.w = pk2(s[6 * 33], s[7 * 33]);
        *(u32x4*)(WT + (size_t)(n0 + n) * K + k0 + 8 * c) = o; }
    asm volatile("s_waitcnt lgkmcnt(0)" ::: "memory");
}
struct TJob { const float* W; const float* ks; bf16* WT; int ldw, K, N, mode, item; };
__device__ __forceinline__ bool tjob_fast(const TJob& j) { const int nblk = j.N / 32, kb = j.item / nblk, n0 = 32 * (j.item - kb * nblk); return j.mode == 0 || (j.mode == 1 && n0 + 31 < 3200); }
__device__ __forceinline__ void tconv_load(const TJob& j, f32x4 (&x)[8], int lane) {
    if (!tjob_fast(j)) return;
    const int nblk = j.N / 32, kb = j.item / nblk, nb = j.item - kb * nblk, k0 = 64 * kb, n0 = 32 * nb;
    const int c0 = srccol(j.mode, n0), kq = lane >> 3, n4 = (lane & 7) * 4;
#pragma unroll
    for (int i = 0; i < 8; ++i) x[i] = *(const f32x4*)(j.W + (size_t)(k0 + kq + 8 * i) * j.ldw + c0 + n4);
}
__device__ __forceinline__ void tconv_finish(const TJob& j, const f32x4 (&x)[8], LAS float* scr, int lane) {
    if (!tjob_fast(j)) { tconv_item(j.W, j.ldw, j.ks, j.WT, j.K, j.N, j.mode, j.item, scr, lane); return; }
    const int nblk = j.N / 32, kb = j.item / nblk, nb = j.item - kb * nblk, k0 = 64 * kb, n0 = 32 * nb;
    const int kq = lane >> 3, n4 = (lane & 7) * 4;
#pragma unroll
    for (int i = 0; i < 8; ++i) { const int kk = kq + 8 * i; const float ksc = j.ks ? j.ks[k0 + kk] : 1.f; LAS float* d = scr + kk * 33 + n4;
        d[0] = x[i][0] * ksc; d[1] = x[i][1] * ksc; d[2] = x[i][2] * ksc; d[3] = x[i][3] * ksc; }
    asm volatile("s_waitcnt lgkmcnt(0)" ::: "memory");
    const int c = lane & 7;
#pragma unroll
    for (int q = 0; q < 4; ++q) { const int n = (lane >> 3) + 8 * q; const LAS float* sp = scr + (8 * c) * 33 + n;
        u32x4 o; o.x = pk2(sp[0 * 33], sp[1 * 33]); o.y = pk2(sp[2 * 33], sp[3 * 33]); o.z = pk2(sp[4 * 33], sp[5 * 33]); o.w = pk2(sp[6 * 33], sp[7 * 33]);
        *(u32x4*)(j.WT + (size_t)(n0 + n) * j.K + k0 + 8 * c) = o; }
    asm volatile("s_waitcnt lgkmcnt(0)" ::: "memory");
}
#define TCONV_LOOP(NITEMS, DECODE) do { int it_ = gw; if (it_ < (NITEMS)) { TJob cur_; f32x4 xc_[8]; DECODE(it_, cur_); tconv_load(cur_, xc_, lane); \
        for (;;) { const int nit_ = it_ + NGW; const bool hn_ = nit_ < (NITEMS); TJob nx_ = cur_; f32x4 xn_[8]; \
            _Pragma("unroll") for (int q_ = 0; q_ < 8; ++q_) xn_[q_] = xc_[q_]; \
            if (hn_) { DECODE(nit_, nx_); tconv_load(nx_, xn_, lane); } \
            tconv_finish(cur_, xc_, scr, lane); if (!hn_) break; cur_ = nx_; it_ = nit_; \
            _Pragma("unroll") for (int q_ = 0; q_ < 8; ++q_) xc_[q_] = xn_[q_]; } } } while (0)
__device__ __forceinline__ void ln_row(f32x4 (&v)[4], const float* g, const float* b, int lane) {
    float s = 0.f, s2 = 0.f;
#pragma unroll
    for (int j = 0; j < 4; ++j) { s += (v[j][0] + v[j][1]) + (v[j][2] + v[j][3]); s2 += (v[j][0] * v[j][0] + v[j][1] * v[j][1]) + (v[j][2] * v[j][2] + v[j][3] * v[j][3]); }
#pragma unroll
    for (int o = 1; o < 64; o <<= 1) { const float a = __shfl_xor(s, o), c = __shfl_xor(s2, o); s += a; s2 += c; }
    const float mean = s * (1.f / 1024.f); const float var = fmaxf(s2 * (1.f / 1024.f) - mean * mean, 0.f);
    const float rstd = 1.f / sqrtf(var + 1e-5f);
#pragma unroll
    for (int j = 0; j < 4; ++j) { const f32x4 gg = *(const f32x4*)(g + 4 * lane + 256 * j), bb = *(const f32x4*)(b + 4 * lane + 256 * j); v[j] = (v[j] - mean) * rstd * gg + bb; }
}
__device__ __forceinline__ void store_row_bf16(bf16* row, const f32x4 (&v)[4], int lane) {
#pragma unroll
    for (int j = 0; j < 4; ++j) { u32x2 w; w.x = pk2(v[j][0], v[j][1]); w.y = pk2(v[j][2], v[j][3]); *(u32x2*)(row + 4 * lane + 256 * j) = w; }
}

struct InPtrs { const float* const* p; __device__ __forceinline__ const float* operator[](int i) const { return (const float*)(GAS const float*)p[i]; } };
#define PHASE_IDS int wid_l_ = wid_k; asm volatile("" : "+s"(wid_l_)); const int lane_l_ = lane_id_v(); \
    const int wid = wid_l_, lane = lane_l_, tid = wid * 64 + lane, gw = c * 8 + wid; (void)lane; (void)gw; (void)wid; (void)tid; \
    GAS unsigned char* ws_l_ = (GAS unsigned char*)ws_k; GAS unsigned char* dout_l_ = (GAS unsigned char*)dout_k; asm volatile("" : "+s"(ws_l_), "+s"(dout_l_)); \
    unsigned char* const ws = (unsigned char*)ws_l_; unsigned char* const dout = (unsigned char*)dout_l_; (void)dout;
struct Args { const float* in[29]; float* out; unsigned char* ws; int ph_lo, ph_hi; };

__global__ void __launch_bounds__(512, 2) fwd(Args a) {
    extern __shared__ __attribute__((aligned(16))) unsigned char lds_[];
    LAS unsigned char* lds = (LAS unsigned char*)lds_;
    LAS char* ldc = (LAS char*)lds_;
    const int wid_k = __builtin_amdgcn_readfirstlane((int)threadIdx.x >> 6);
    const int G = gridDim.x, c = blockIdx.x, v = (G % 8 == 0) ? (c % 8) * (G / 8) + c / 8 : c;
    const int NGW = G * 8;
    volatile LAS unsigned* MISC = (volatile LAS unsigned*)(lds + LDS_MISC);
    if (threadIdx.x < 256) MISC[threadIdx.x] = 0u;
    __syncthreads();
    const InPtrs INP{a.in};
    unsigned char* const ws_k = a.ws;
    unsigned* ctl = (unsigned*)(ws_k + WS_CTL);
#if !MK_PER_PHASE
    XcdBarrier bar = xcd_barrier_post(ctl + CW_BAR, MISC + 8);
#define GRID_BAR() do { xcd_barrier(bar); if (PROBE_REPEAT == 17) xcd_barrier(bar); if (PROBE_STAMP >= 0) { ++st_ph; if (st_ph == PROBE_STAMP) st_t0 = __builtin_amdgcn_s_memrealtime(); if (st_ph == PROBE_STAMP + 1) st_t1 = __builtin_amdgcn_s_memrealtime(); } } while (0)
#else
#define GRID_BAR() do {} while (0)
#endif
    const int lo = a.ph_lo, hi = a.ph_hi;
#define STAMP_POINT(id) do { if (PROBE_STAMP == (id)) st_t0 = __builtin_amdgcn_s_memrealtime(); if (PROBE_STAMP + 1 == (id)) st_t1 = __builtin_amdgcn_s_memrealtime(); } while (0)
    int st_ph = 0; unsigned long long st_t0 = 0ull, st_t1 = 0ull; if (PROBE_STAMP == 0) st_t0 = __builtin_amdgcn_s_memrealtime(); (void)st_ph;
#define IN(k) (lo <= (k) && (k) < hi)
#define BOTH(k) (IN(k) && IN((k) + 1))
    unsigned char* const dout_k = (unsigned char*)a.out;
#define CS ((float*)(ws + WS_CS))
#define MISCF ((float*)(ws + WS_MISC))
#define RSQ ((float*)(ws + WS_RSQ))
#define RSKV ((float*)(ws + WS_RSKV))
#define RTE ((int*)(ws + WS_RTE))
#define RTP ((int*)(ws + WS_RTP))
#define RTG ((float*)(ws + WS_RTG))
#define ROWIDX ((int*)(ws + WS_ROWIDX))
#define KCMP ((bf16*)(ws + WS_KCMP))
#define VCMP ((bf16*)(ws + WS_VCMP))
#define UL ((bf16*)(ws + WS_UL))
#define Hb ((bf16*)(ws + WS_HB))
#define P ((bf16*)(ws + WS_P))
#define Z ((bf16*)(ws + WS_P))
#define YS ((bf16*)(ws + WS_P))
#define HS ((bf16*)(ws + WS_HS))
#define GSwg ((bf16*)(ws + WS_GS) + (size_t)c * 3 * 65536)
#define QM ((bf16*)(dout + DO_QM))
#define KVM ((bf16*)(dout + DO_KVM))
#define Y ((bf16*)(dout + DO_KVM))
#define W13T ((bf16*)(dout + DO_W13))
#define W2T ((bf16*)(dout + DO_W2))
#define LAYER_W unsigned char* wl = ws + WS_WTS + (size_t)l * WL_STRIDE; \
        const bf16* WinT = (const bf16*)(wl + WL_WIN); const bf16* WgT = (const bf16*)(wl + WL_WG); const bf16* WbrT = (const bf16*)(wl + WL_WBR); const bf16* WoutT = (const bf16*)(wl + WL_WOUT); \
        const bf16* WuqT = (const bf16*)(wl + WL_WUQ); const bf16* WukvT = (const bf16*)(wl + WL_WUKV); const bf16* Wc1T = (const bf16*)(wl + WL_WC1); \
        unsigned* gcnt = (unsigned*)(ws + WS_CTL) + CW_CNT + l * 16 * 64; (void)WinT; (void)WgT; (void)WbrT; (void)WoutT; (void)WuqT; (void)WukvT; (void)Wc1T; (void)gcnt;
    if (PHON(0) && IN(0)) { PHASE_IDS
        for (int rep_ = (PROBE_REPEAT == 15 ? 0 : 1); rep_ < 2; ++rep_) {
        LAS float* scr = (LAS float*)(lds + wid * 8704);
#define DEC_PRO(it, J) do { const int l_ = (it) / 5152; int r_ = (it) - l_ * 5152; unsigned char* wl_ = ws + WS_WTS + (size_t)l_ * WL_STRIDE; \
            if (r_ < 1664) { J = TJob{INP[3] + (size_t)l_ * 1024 * IN_W, nullptr, (bf16*)(wl_ + WL_WIN), IN_W, 1024, 3328, 1, r_}; } \
            else if ((r_ -= 1664) < 1536) { J = TJob{INP[3] + (size_t)l_ * 1024 * IN_W + 3256, nullptr, (bf16*)(wl_ + WL_WG), IN_W, 1024, 3072, 0, r_}; } \
            else if ((r_ -= 1536) < 768) { const int jb_ = r_ / 256; J = TJob{INP[16 + jb_] + (size_t)l_ * 512 * 1024, nullptr, (bf16*)(wl_ + WL_WBR) + (size_t)jb_ * 1024 * 512, 1024, 512, 1024, 0, r_ - jb_ * 256}; } \
            else if ((r_ -= 768) < 512) { J = TJob{INP[19] + (size_t)l_ * 1024 * 1024, nullptr, (bf16*)(wl_ + WL_WOUT), 1024, 1024, 1024, 0, r_}; } \
            else if ((r_ -= 512) < 96) { J = TJob{INP[14] + (size_t)l_ * 256 * 768, INP[12] + l_ * 256, (bf16*)(wl_ + WL_WUQ), 768, 256, 768, 2, r_}; } \
            else if ((r_ -= 96) < 64) { J = TJob{INP[15] + (size_t)l_ * 128 * 1024, INP[13] + l_ * 128, (bf16*)(wl_ + WL_WUKV), 1024, 128, 1024, 0, r_}; } \
            else { r_ -= 64; const int job_ = r_ / 128, kv_ = job_ >> 1, half_ = job_ & 1; \
                J = TJob{INP[kv_ ? 8 : 5] + (size_t)l_ * 2048 * 256 + (size_t)half_ * 1024 * 256, nullptr, (bf16*)(wl_ + WL_WC1) + (size_t)kv_ * 512 * 1024 + (size_t)half_ * 256 * 1024, 256, 1024, 256, 0, r_ - job_ * 128}; } } while (0)
        TCONV_LOOP(2 * 5152, DEC_PRO);
#undef DEC_PRO
        for (int i = c * 512 + tid; i < S * 16; i += G * 512) { const int pos = i >> 4, k = i & 15;
            const float freq = fexp2(-(float)k * (13.287712379549449f / 16.f)); const float ang = (float)pos * freq;
            const double rev = (double)ang * 0.15915494309189535; const float fr = (float)(rev - __builtin_rint(rev));
            CS[2 * i] = __builtin_amdgcn_cosf(fr); CS[2 * i + 1] = __builtin_amdgcn_sinf(fr); }
        for (int jt = c * 512 + tid; jt < 32768; jt += G * 512) { const int i = jt & 1023, ch = jt >> 10; const int l = i >> 9, kv = (i >> 8) & 1, n = i & 255;
            const float* pos = INP[kv ? 7 : 4] + l * 2048 + ch * 64; const float* w1 = INP[kv ? 8 : 5] + (size_t)l * 2048 * 256 + (size_t)ch * 64 * 256 + n; float s = 0.f;
#pragma unroll 8
            for (int k = 0; k < 64; ++k) s += pos[k] * w1[(size_t)k * 256];
            MISCF[2048 + ch * 1024 + i] = s; }
        if (c == 0 && tid < 2) { const float* lp = INP[10] + tid * 256; float s1 = 0.f, s2 = 0.f;
            for (int k = 0; k < 64; ++k) { s1 += lp[k] * lp[64 + k]; s2 += lp[128 + k] * lp[192 + k]; }
            const float li = 0.8f - 0.6f * __expf(-0.3f * (float)tid); MISCF[1024 + tid] = __expf(s1) - __expf(s2) + li; MISCF[1026 + tid] = li; }
        { f32x4 xn[4];
          if (gw < T) {
#pragma unroll
              for (int j = 0; j < 4; ++j) xn[j] = *(const f32x4*)(INP[0] + (size_t)gw * 1024 + 4 * lane + 256 * j); }
          for (int m = gw; m < T; m += NGW) { f32x4 x[4];
#pragma unroll
            for (int j = 0; j < 4; ++j) x[j] = xn[j];
            const int mn_ = m + NGW < T ? m + NGW : m;
#pragma unroll
            for (int j = 0; j < 4; ++j) xn[j] = *(const f32x4*)(INP[0] + (size_t)mn_ * 1024 + 4 * lane + 256 * j);
            ln_row(x, INP[1], INP[2], lane); store_row_bf16(Hb + (size_t)m * 1024, x, lane); } }
        }
        if (BOTH(0)) GRID_BAR();
    }

    for (int l = 0; l < NLAYER; ++l) {
        const int pbase = 1 + 11 * l;
        if (PHON(1) && IN(pbase + 0)) { PHASE_IDS LAYER_W
            for (int rep_ = (PROBE_REPEAT == 1 ? 0 : 1); rep_ < 2; ++rep_) {
            pg8::TileSched Sd{(const char*)Hb, (const char*)WinT, 2048, 1024, 13, 128 * 13, G, v}; pg8::EpiStore E{P, PW, nullptr, 0, false};
            pg8::gemm_phase<pg8::EpiStore, pg8::TileSched, true>(lds, wid, 1024, 128u, Sd, E);
            }
            if (BOTH(pbase + 0)) GRID_BAR();
        }
        if (PHON(2) && IN(pbase + 1)) { PHASE_IDS LAYER_W
            for (int i = gw; i < 512; i += NGW) {
                float sacc = lane < 32 ? MISCF[2048 + lane * 1024 + l * 512 + i] : 0.f;
#pragma unroll
                for (int o2 = 1; o2 < 32; o2 <<= 1) sacc += __shfl_xor(sacc, o2);
                if (lane == 0) MISCF[l * 512 + i] = sacc; }
            {
                const int grp = lane >> 4, q = lane & 15;
                const int nquad = (T + 3) >> 2;
                for (int qd = gw; qd < nquad; qd += NGW) {
                    const int m = 4 * qd + grp < T ? 4 * qd + grp : T - 1; const bf16* pr = P + (size_t)m * PW;
                    const u32x4 wa = *(const u32x4*)(pr + PC_CQ + 16 * q), wb = *(const u32x4*)(pr + PC_CQ + 16 * q + 8), wc = *(const u32x4*)(pr + PC_CKV + 8 * q);
                    const u32x4 wk = *(const u32x4*)(pr + PC_KR + 8 * (q & 3));
#define SQ8_(V_) (bflo((V_).x) * bflo((V_).x) + bfhi((V_).x) * bfhi((V_).x) + bflo((V_).y) * bflo((V_).y) + bfhi((V_).y) * bfhi((V_).y) + bflo((V_).z) * bflo((V_).z) + bfhi((V_).z) * bfhi((V_).z) + bflo((V_).w) * bflo((V_).w) + bfhi((V_).w) * bfhi((V_).w))
                    float sq = SQ8_(wa) + SQ8_(wb), skv = SQ8_(wc);
#undef SQ8_
                    if (q < 4) { const int i0 = q * 4, pos = m & (S - 1);
                        const f32x4* cs = (const f32x4*)(CS + ((size_t)pos * 16 + i0) * 2); const f32x4 ca = cs[0], cb = cs[1];
                        u32x4 o;
                        o.x = pk2(bflo(wk.x) * ca[0] - bfhi(wk.x) * ca[1], bflo(wk.x) * ca[1] + bfhi(wk.x) * ca[0]);
                        o.y = pk2(bflo(wk.y) * ca[2] - bfhi(wk.y) * ca[3], bflo(wk.y) * ca[3] + bfhi(wk.y) * ca[2]);
                        o.z = pk2(bflo(wk.z) * cb[0] - bfhi(wk.z) * cb[1], bflo(wk.z) * cb[1] + bfhi(wk.z) * cb[0]);
                        o.w = pk2(bflo(wk.w) * cb[2] - bfhi(wk.w) * cb[3], bflo(wk.w) * cb[3] + bfhi(wk.w) * cb[2]);
                        bf16* kr = KVM + (size_t)m * KVW + 64 + i0 * 2;
#pragma unroll
                        for (int hh = 0; hh < 8; ++hh) *(u32x4*)(kr + hh * 160) = o; }
#pragma unroll
                    for (int o2 = 1; o2 < 16; o2 <<= 1) { const float a2 = __shfl_xor(sq, o2), b2 = __shfl_xor(skv, o2); sq += a2; skv += b2; }
                    if (q == 0) { RSQ[m] = 1.f / sqrtf(sq * (1.f / 256.f) + 1e-6f); RSKV[m] = 1.f / sqrtf(skv * (1.f / 128.f) + 1e-6f); } }
            }
            if (BOTH(pbase + 1)) GRID_BAR();
        }
        if (PHON(3) && IN(pbase + 2)) { PHASE_IDS LAYER_W
            for (int rep_ = (PROBE_REPEAT == 3 ? 0 : 1); rep_ < 2; ++rep_) {
            const bool cmpwg = G > 64 && v >= G - 64; const int Gs = G > 64 ? G - 64 : G;
            { pg8::TileSched Sd{(const char*)(P + PC_CQ), (const char*)WuqT, PW * 2, 256, 3, cmpwg ? 0 : 384, Gs, v}; pg8::EpiRope E{QM, CS};
              pg8::gemm_phase<pg8::EpiRope, pg8::TileSched, true>(lds, wid, 256, 128u, Sd, E); }
            { pg8::TileSched Sd{(const char*)(P + PC_CKV), (const char*)WukvT, PW * 2, 128, 4, cmpwg ? 0 : 512, Gs, v}; pg8::EpiStore E{KVM, KVW, RSKV, 0, true};
              pg8::gemm_phase<pg8::EpiStore, pg8::TileSched, true>(lds, wid, 128, 128u, Sd, E); }
            { pg8::CmpSched Sd{(const char*)P, (const char*)Wc1T, G, v >= G - 64 ? v - (G - 64) : 64 + v}; pg8::EpiStore E{UL, 512, nullptr, (size_t)512 * 512, false};
              pg8::gemm_phase<pg8::EpiStore, pg8::CmpSched, true>(lds, wid, 1024, (unsigned)(PW * 2), Sd, E); }
            }
            if (BOTH(pbase + 2)) GRID_BAR();
        }
        if (PHON(4) && IN(pbase + 3)) { PHASE_IDS LAYER_W
            for (int rep_ = (PROBE_REPEAT == 4 ? 0 : 1); rep_ < 2; ++rep_) {
            LAS float* w2l = (LAS float*)lds;
            for (int q = tid; q < 2 * 4096; q += 512) { const int kv = q >> 12, idx = q & 4095; *(LAS f32x4*)(w2l + kv * 16384 + idx * 4) = *(const f32x4*)(INP[kv ? 9 : 6] + (size_t)l * 256 * 64 + idx * 4); }
            __syncthreads();
            LAS float* hid = (LAS float*)(lds + 132096 + wid * 1024);
            {
                float xin[4] = {0.f, 0.f, 0.f, 0.f};
#define C_FETCH(r_) do { const int kv_ = (r_) >> 12, bg_ = ((r_) >> 9) & 7, i_ = (r_) & 511; const int ic_ = i_ < 511 ? i_ : 510; \
                    const bf16* u_ = UL + ((size_t)(kv_ * 8 + bg_) * 512 + ic_) * 512; const float* pbv_ = MISCF + l * 512 + kv_ * 256; \
                    _Pragma("unroll") for (int q_ = 0; q_ < 4; ++q_) { const int n_ = lane + 64 * q_; xin[q_] = bf2f(u_[n_]) + bf2f(u_[512 + 256 + n_]) + pbv_[n_]; } } while (0)
                if (gw < 2 * 8 * 512) C_FETCH(gw);
                for (int r = gw; r < 2 * 8 * 512; r += NGW) { const int kv = r >> 12, bg = (r >> 9) & 7, i = r & 511;
                    bf16* out = (kv ? VCMP : KCMP) + ((size_t)bg * 512 + i) * 64;
                    float xc[4];
#pragma unroll
                    for (int q = 0; q < 4; ++q) xc[q] = xin[q];
                    if (r + NGW < 2 * 8 * 512) C_FETCH(r + NGW);
                    if (i == 511) { out[lane] = 0; continue; }
#pragma unroll
                    for (int q = 0; q < 4; ++q) { const int n = lane + 64 * q; const float x = xc[q];
                        const float y = 0.7978845608028654f * (x + 0.044715f * x * x * x); const float th = 1.f - 2.f / (__expf(2.f * y) + 1.f);
                        hid[n] = 0.5f * x * (1.f + th); }
                    asm volatile("s_waitcnt lgkmcnt(0)" ::: "memory");
                    const LAS float* w2 = w2l + kv * 16384 + lane; float acc0 = 0.f, acc1 = 0.f, acc2 = 0.f, acc3 = 0.f;
#pragma unroll 4
                    for (int n = 0; n < 256; n += 4) { const f32x4 hv = *(const LAS f32x4*)(hid + n);
                        acc0 += hv[0] * w2[n * 64]; acc1 += hv[1] * w2[(n + 1) * 64]; acc2 += hv[2] * w2[(n + 2) * 64]; acc3 += hv[3] * w2[(n + 3) * 64]; }
                    out[lane] = (bf16)f2bf((acc0 + acc1) + (acc2 + acc3));
                    asm volatile("s_waitcnt lgkmcnt(0)" ::: "memory"); }
#undef C_FETCH
            }
            __syncthreads();
            }
            if (BOTH(pbase + 3)) GRID_BAR();
        }
        if (PHON(5) && IN(pbase + 4)) { PHASE_IDS LAYER_W
            const int xcd = c & 7, ii = c >> 3;
            if (G == 256) {
                if (l == 0) STAMP_POINT(100);
                if (l == 0) STAMP_POINT(110);
                for (int rep = (PROBE_REPEAT == 11 ? 0 : 1); rep < 2; ++rep)
                if (PHON(11)) for (int k = 0; k < 4; ++k) { const int bh = xcd + 8 * k; mla_unit(ldc, bh >> 3, bh & 7, (k & 1) ? ii : 31 - ii, QM, KVM, RSQ, wid, rep == 0); }
                if (l == 0) STAMP_POINT(101);
                for (int rep = (PROBE_REPEAT == 12 ? 0 : 1); rep < 2; ++rep)
                if (PHON(12)) for (int k = 0; k < 2; ++k) { const int bh = xcd + 8 * k; diff_unit(ldc, bh >> 2, bh & 3, k ? ii : 31 - ii, P, MISCF[1024 + l], MISCF[1026 + l], INP[11] + l * 128, GSwg, wid, rep == 0); }
                if (l == 0) STAMP_POINT(102);
                if (PHON(13)) for (int k = (PROBE_REPEAT == 13 ? -4 : 0); k < 4; ++k) { const int kk = k & 3; const int tile = (kk == 0) ? ii : (kk == 1) ? 63 - ii : (kk == 2) ? 64 + ii : 127 - ii; nsa_unit(ldc, xcd >> 1, xcd & 1, tile, P, KCMP, VCMP, wid, k < 0); }
                if (l == 0) STAMP_POINT(103);
                if (l == 0) STAMP_POINT(111);
            } else {
                if (PHON(11)) for (int u = c; u < 1024; u += G) { const int bh = u & 31; mla_unit(ldc, bh >> 3, bh & 7, 31 - (u >> 5), QM, KVM, RSQ, wid); }
                if (PHON(12)) for (int u = c; u < 512; u += G) { const int bh = u & 15; diff_unit(ldc, bh >> 2, bh & 3, 31 - (u >> 4), P, MISCF[1024 + l], MISCF[1026 + l], INP[11] + l * 128, GSwg, wid); }
                if (PHON(13)) for (int u = c; u < 1024; u += G) { const int bg = u & 7; nsa_unit(ldc, bg >> 1, bg & 1, 127 - (u >> 3), P, KCMP, VCMP, wid); }
            }
            if (BOTH(pbase + 4)) GRID_BAR();
        }
        if (PHON(6) && IN(pbase + 5)) { PHASE_IDS LAYER_W
            for (int rep_ = (PROBE_REPEAT == 6 ? 0 : 1); rep_ < 2; ++rep_) {
            for (int tl = v; tl < 512; tl += G) {
                const int pm = tl >> 2, pn = tl & 3;
                { pg8::GateSched Sd{(const char*)Hb, (const char*)WgT, pm, pn, true}; pg8::EpiGate E{GSwg};
                  pg8::gemm_phase<pg8::EpiGate, pg8::GateSched, true>(lds, wid, 1024, 128u, Sd, E); }
                { pg8::ChainSched Sd{(const char*)(P + PC_NQ), (const char*)(P + PC_DQ), (const char*)QM, (const char*)WbrT, pm, pn, true}; pg8::EpiChain E{Y, GSwg};
                  pg8::gemm_phase<pg8::EpiChain, pg8::ChainSched, true>(lds, wid, 512, 128u, Sd, E); }
            }
            }
            if (BOTH(pbase + 5)) GRID_BAR();
        }
        if (PHON(7) && IN(pbase + 6)) { PHASE_IDS LAYER_W
            for (int rep_ = (PROBE_REPEAT == 7 ? 0 : 1); rep_ < 2; ++rep_) {
            pg8::TileSched Sd{(const char*)Y, (const char*)WoutT, 2048, 1024, 4, 512, G, v}; pg8::EpiResid E{Z, Hb};
            pg8::gemm_phase<pg8::EpiResid, pg8::TileSched, true>(lds, wid, 1024, 128u, Sd, E);
            }
            if (BOTH(pbase + 6)) GRID_BAR();
        }
        if (PHON(8) && IN(pbase + 7)) { PHASE_IDS LAYER_W
            LAS float* rwT = (LAS float*)lds;
            for (int i = tid; i < 16384; i += 512) rwT[(i & 15) * 1024 + (i >> 4)] = INP[22][i];
            volatile LAS int* cntL = (volatile LAS int*)(MISC + 16); volatile LAS int* cbase = (volatile LAS int*)(MISC + 32);
            const float* g1 = INP[20] + l * 1024; const float* b1 = INP[21] + l * 1024; const float* rb = INP[23];
            LAS float* scr = (LAS float*)(lds + (wid < 7 ? 65536 + wid * 8448 : 132096));
#define DEC_MOE(it, J) do { const int e_ = (it) / 768; const int r_ = (it) - e_ * 768; \
                if (r_ < 512) { const int job_ = r_ >> 6, pn_ = job_ >> 1, half_ = job_ & 1; \
                    J = TJob{INP[half_ ? 25 : 24] + ((size_t)l * 16 + e_) * 1024 * 512 + pn_ * 128, nullptr, W13T + (size_t)e_ * 1024 * 1024 + (size_t)(pn_ * 256 + half_ * 128) * 1024, 512, 1024, 128, 0, r_ & 63}; } \
                else { J = TJob{INP[26] + ((size_t)l * 16 + e_) * 512 * 1024, nullptr, W2T + (size_t)e_ * 1024 * 512, 1024, 512, 1024, 0, r_ - 512}; } } while (0)
            int cv_it = gw; bool cv_has = cv_it < 16 * 768; f32x4 cv_x[8];
#pragma unroll
            for (int q = 0; q < 8; ++q) cv_x[q] = (f32x4){0.f, 0.f, 0.f, 0.f};
            if (cv_has) { TJob j0_; DEC_MOE(cv_it, j0_); tconv_load(j0_, cv_x, lane); }
#define CV_STEP() do { if (cv_has) { TJob cur_; DEC_MOE(cv_it, cur_); const int nit_ = cv_it + NGW; const bool hn_ = nit_ < 16 * 768; f32x4 xn_[8]; \
                _Pragma("unroll") for (int q_ = 0; q_ < 8; ++q_) xn_[q_] = cv_x[q_]; \
                if (hn_) { TJob nx_; DEC_MOE(nit_, nx_); tconv_load(nx_, xn_, lane); } \
                tconv_finish(cur_, cv_x, scr, lane); cv_it = nit_; cv_has = hn_; \
                _Pragma("unroll") for (int q_ = 0; q_ < 8; ++q_) cv_x[q_] = xn_[q_]; } } while (0)
            const int nit = (T + G * 128 - 1) / (G * 128);
            for (int rep_ = (PROBE_REPEAT == 8 ? 0 : 1); rep_ < 2; ++rep_)
            for (int it = 0; it < nit; ++it) {
                if (tid < 16) cntL[tid] = 0;
                __syncthreads();
                const int base = (it * G + c) * 128 + wid * 16;
                int e0 = -1, e1 = -1; float g0 = 0.f, g1v = 0.f;
                const int half = lane >> 5, l32 = lane & 31;
                u32x2 zn[8];
                { const int m0_ = base + half < T ? base + half : T - 1;
#pragma unroll
                  for (int j = 0; j < 8; ++j) zn[j] = *(const u32x2*)(Z + (size_t)m0_ * 1024 + 4 * l32 + 128 * j); }
                for (int k = 0; k < 8; ++k) { if (base + 2 * k >= T) break;
                    const int m = base + 2 * k + half < T ? base + 2 * k + half : T - 1;
                    f32x4 x[8];
#pragma unroll
                    for (int j = 0; j < 8; ++j) { const u32x2 zw = zn[j]; x[j] = (f32x4){bflo(zw.x), bfhi(zw.x), bflo(zw.y), bfhi(zw.y)}; }
                    { const int mn_ = (k + 1 < 8 && m + 2 < T) ? m + 2 : m;
#pragma unroll
                      for (int j = 0; j < 8; ++j) zn[j] = *(const u32x2*)(Z + (size_t)mn_ * 1024 + 4 * l32 + 128 * j); }
                    { float s_ = 0.f, s2_ = 0.f;
#pragma unroll
                      for (int j = 0; j < 8; ++j) { s_ += (x[j][0] + x[j][1]) + (x[j][2] + x[j][3]); s2_ += (x[j][0] * x[j][0] + x[j][1] * x[j][1]) + (x[j][2] * x[j][2] + x[j][3] * x[j][3]); }
#pragma unroll
                      for (int o2 = 1; o2 < 32; o2 <<= 1) { const float a_ = __shfl_xor(s_, o2), c_ = __shfl_xor(s2_, o2); s_ += a_; s2_ += c_; }
                      const float mean = s_ * (1.f / 1024.f), var = fmaxf(s2_ * (1.f / 1024.f) - mean * mean, 0.f), rstd = 1.f / sqrtf(var + 1e-5f);
#pragma unroll
                      for (int j = 0; j < 8; ++j) { const f32x4 gg = *(const f32x4*)(g1 + 4 * l32 + 128 * j), bb = *(const f32x4*)(b1 + 4 * l32 + 128 * j); x[j] = (x[j] - mean) * rstd * gg + bb;
                          u32x2 w; w.x = pk2(x[j][0], x[j][1]); w.y = pk2(x[j][2], x[j][3]); *(u32x2*)(Hb + (size_t)m * 1024 + 4 * l32 + 128 * j) = w; } }
                    float sel[16], aff[16];
                    { float acc[16];
#pragma unroll
                      for (int e = 0; e < 16; ++e) { float a_ = 0.f;
#pragma unroll
                          for (int j = 0; j < 8; ++j) { const f32x4 w = *(const LAS f32x4*)(rwT + e * 1024 + 4 * l32 + 128 * j); a_ += x[j][0] * w[0] + x[j][1] * w[1] + x[j][2] * w[2] + x[j][3] * w[3]; }
                          acc[e] = a_; }
                      float v8[8], v4[4], v2[2], v1;
                      { const bool hi = (l32 & 16) != 0;
#pragma unroll
                        for (int e = 0; e < 8; ++e) { const float rcv = __shfl_xor(hi ? acc[e] : acc[e + 8], 16); v8[e] = (hi ? acc[e + 8] : acc[e]) + rcv; } }
                      { const bool hi = (l32 & 8) != 0;
#pragma unroll
                        for (int e = 0; e < 4; ++e) { const float rcv = __shfl_xor(hi ? v8[e] : v8[e + 4], 8); v4[e] = (hi ? v8[e + 4] : v8[e]) + rcv; } }
                      { const bool hi = (l32 & 4) != 0;
#pragma unroll
                        for (int e = 0; e < 2; ++e) { const float rcv = __shfl_xor(hi ? v4[e] : v4[e + 2], 4); v2[e] = (hi ? v4[e + 2] : v4[e]) + rcv; } }
                      { const bool hi = (l32 & 2) != 0; const float rcv = __shfl_xor(hi ? v2[0] : v2[1], 2); v1 = (hi ? v2[1] : v2[0]) + rcv; }
                      v1 += __shfl_xor(v1, 1);
#pragma unroll
                      for (int e = 0; e < 16; ++e) { const int le = 16 * (e >> 3) + 8 * ((e >> 2) & 1) + 4 * ((e >> 1) & 1) + 2 * (e & 1);
                          const float lgA = __uint_as_float(__builtin_amdgcn_readlane(__float_as_uint(v1), le)), lgB = __uint_as_float(__builtin_amdgcn_readlane(__float_as_uint(v1), 32 + le));
                          const float lg = half ? lgB : lgA; aff[e] = sigmoidf_(lg); sel[e] = aff[e] + rb[e]; } }
                    int grp = 0; float best = -1e30f;
#pragma unroll
                    for (int gq = 0; gq < 4; ++gq) { float m1 = sel[4 * gq], m2 = -1e30f;
#pragma unroll
                        for (int q = 1; q < 4; ++q) { const float s = sel[4 * gq + q]; if (s > m1) { m2 = m1; m1 = s; } else if (s > m2) m2 = s; }
                        const float sc = m1 + m2; if (sc > best) { best = sc; grp = gq; } }
                    float s4[4], a4[4];
#pragma unroll
                    for (int q = 0; q < 4; ++q) { s4[q] = grp == 0 ? sel[q] : grp == 1 ? sel[4 + q] : grp == 2 ? sel[8 + q] : sel[12 + q]; a4[q] = grp == 0 ? aff[q] : grp == 1 ? aff[4 + q] : grp == 2 ? aff[8 + q] : aff[12 + q]; }
                    int i1 = 0;
#pragma unroll
                    for (int q = 1; q < 4; ++q) if (s4[q] > s4[i1 == 0 ? 0 : i1 == 1 ? 1 : i1 == 2 ? 2 : 3]) i1 = q;
                    int i2 = -1; float b2 = -1e30f;
#pragma unroll
                    for (int q = 0; q < 4; ++q) if (q != i1 && s4[q] > b2) { b2 = s4[q]; i2 = q; }
                    const float a1 = i1 == 0 ? a4[0] : i1 == 1 ? a4[1] : i1 == 2 ? a4[2] : a4[3], a2 = i2 == 0 ? a4[0] : i2 == 1 ? a4[1] : i2 == 2 ? a4[2] : a4[3];
                    const float inv = 1.f / (a1 + a2);
                    { const int te0 = grp * 4 + i1, te1 = grp * 4 + i2; const float tg0 = a1 * inv, tg1 = a2 * inv;
                      const int e0A = __builtin_amdgcn_readlane(te0, 0), e0B = __builtin_amdgcn_readlane(te0, 32), e1A = __builtin_amdgcn_readlane(te1, 0), e1B = __builtin_amdgcn_readlane(te1, 32);
                      const float g0A = __uint_as_float(__builtin_amdgcn_readlane(__float_as_uint(tg0), 0)), g0B = __uint_as_float(__builtin_amdgcn_readlane(__float_as_uint(tg0), 32));
                      const float g1A = __uint_as_float(__builtin_amdgcn_readlane(__float_as_uint(tg1), 0)), g1B = __uint_as_float(__builtin_amdgcn_readlane(__float_as_uint(tg1), 32));
                      if (lane == 2 * k) { e0 = e0A; e1 = e1A; g0 = g0A; g1v = g1A; }
                      if (lane == 2 * k + 1 && base + 2 * k + 1 < T) { e0 = e0B; e1 = e1B; g0 = g0B; g1v = g1B; } }
                    if (rep_) CV_STEP(); }
                int p0 = 0, p1 = 0, mycount = 0; const unsigned long long lt = (1ull << lane) - 1ull;
#pragma unroll
                for (int e = 0; e < 16; ++e) { const unsigned long long b0 = __ballot(e0 == e), bb1 = __ballot(e1 == e); const int c0 = __popcll(b0);
                    if (lane == e) mycount = c0 + __popcll(bb1); if (e0 == e) p0 = __popcll(b0 & lt); if (e1 == e) p1 = c0 + __popcll(bb1 & lt); }
                int woff = 0; if (lane < 16) woff = __hip_atomic_fetch_add((LAS int*)(MISC + 16) + lane, mycount, __ATOMIC_RELAXED, __HIP_MEMORY_SCOPE_WORKGROUP);
                __syncthreads();
                if (tid < 16 && rep_) cbase[tid] = (int)xb_add(gcnt + tid * 64, (unsigned)cntL[tid]);
                __syncthreads();
                const int wo0 = __shfl(woff, e0 < 0 ? 0 : e0), wo1 = __shfl(woff, e1 < 0 ? 0 : e1);
                if (e0 >= 0 && rep_) { const int m = base + lane; const int q0 = cbase[e0] + wo0 + p0, q1 = cbase[e1] + wo1 + p1;
                    ROWIDX[e0 * CAP + q0] = m; ROWIDX[e1 * CAP + q1] = m; RTE[2 * m] = e0; RTE[2 * m + 1] = e1; RTP[2 * m] = q0; RTP[2 * m + 1] = q1; RTG[2 * m] = g0; RTG[2 * m + 1] = g1v; }
                __syncthreads();
            }
            while (cv_has) CV_STEP();
#undef CV_STEP
#undef DEC_MOE
            if (BOTH(pbase + 7)) GRID_BAR();
        }
        if (PHON(9) && (IN(pbase + 8) || IN(pbase + 9))) { PHASE_IDS LAYER_W
            volatile LAS int* TP = (volatile LAS int*)(MISC + 64); volatile LAS int* CNT = (volatile LAS int*)(MISC + 96);
            if (tid == 0) { int acc = 0; for (int e = 0; e < 16; ++e) { const int cn = (int)xb_ld(gcnt + e * 64); CNT[e] = cn; TP[e] = acc; acc += (cn + 255) >> 8; } TP[16] = acc; }
            __syncthreads();
            if (IN(pbase + 8)) {
                pg8::MoeSched Sd{(const char*)Hb, (const char*)W13T, ROWIDX, TP, CNT, 2048, 1024, (size_t)1024 * 1024 * 2, true, G, v}; pg8::EpiSwiglu E{HS};
                for (int rep_ = (PROBE_REPEAT == 9 ? 0 : 1); rep_ < 2; ++rep_)
                pg8::gemm_phase<pg8::EpiSwiglu, pg8::MoeSched, true>(lds, wid, 1024, 128u, Sd, E);
                if (BOTH(pbase + 8)) GRID_BAR();
            }
            if (IN(pbase + 9)) {
                pg8::MoeSched Sd{(const char*)HS, (const char*)W2T, ROWIDX, TP, CNT, 1024, 512, (size_t)1024 * 512 * 2, false, G, v}; pg8::EpiStore E{YS, 1024, nullptr, 0, false};
                for (int rep_ = (PROBE_REPEAT == 14 ? 0 : 1); rep_ < 2; ++rep_)
                pg8::gemm_phase<pg8::EpiStore, pg8::MoeSched, true>(lds, wid, 512, 128u, Sd, E);
                if (BOTH(pbase + 9)) GRID_BAR();
            }
        }
        if (PHON(10) && IN(pbase + 10)) { PHASE_IDS LAYER_W
            int tp = 0;
            { const int cn = lane < 16 ? (int)xb_ld(gcnt + lane * 64) : 0; const int tl = (cn + 255) >> 8; int inc = tl;
#pragma unroll
              for (int o = 1; o < 16; o <<= 1) { const int n = __shfl_up(inc, o); if (lane >= o) inc += n; }
              tp = inc - tl; }
            const float* g2 = INP[27] + l * 1024; const float* b2 = INP[28] + l * 1024;
            {
                auto clampm = [&](int mm) { return mm < T ? mm : (T - 1); };
                int m = gw;
                int2 re_n, rp_n; float2 rg_n;
                u32x2 hw_c[4], y0_c[4], y1_c[4]; float g0_c, g1_c;
                { const int mc = clampm(m); const int2 re = *(const int2*)(RTE + 2 * mc), rp = *(const int2*)(RTP + 2 * mc); const float2 rg = *(const float2*)(RTG + 2 * mc);
                  const int r0 = __shfl(tp, re.x) * 256 + rp.x, r1 = __shfl(tp, re.y) * 256 + rp.y; g0_c = rg.x; g1_c = rg.y;
#pragma unroll
                  for (int j = 0; j < 4; ++j) { const int col = 4 * lane + 256 * j; hw_c[j] = *(const u32x2*)(Hb + (size_t)mc * 1024 + col); y0_c[j] = *(const u32x2*)(YS + (size_t)r0 * 1024 + col); y1_c[j] = *(const u32x2*)(YS + (size_t)r1 * 1024 + col); }
                  const int mn = clampm(m + NGW); re_n = *(const int2*)(RTE + 2 * mn); rp_n = *(const int2*)(RTP + 2 * mn); rg_n = *(const float2*)(RTG + 2 * mn); }
                for (; m < T; m += NGW) {
                    u32x2 hw_n[4], y0_n[4], y1_n[4]; const float g0_n = rg_n.x, g1_n = rg_n.y;
                    { const int mn = clampm(m + NGW); const int r0 = __shfl(tp, re_n.x) * 256 + rp_n.x, r1 = __shfl(tp, re_n.y) * 256 + rp_n.y;
#pragma unroll
                      for (int j = 0; j < 4; ++j) { const int col = 4 * lane + 256 * j; hw_n[j] = *(const u32x2*)(Hb + (size_t)mn * 1024 + col); y0_n[j] = *(const u32x2*)(YS + (size_t)r0 * 1024 + col); y1_n[j] = *(const u32x2*)(YS + (size_t)r1 * 1024 + col); }
                      const int m2 = clampm(m + 2 * NGW); re_n = *(const int2*)(RTE + 2 * m2); rp_n = *(const int2*)(RTP + 2 * m2); rg_n = *(const float2*)(RTG + 2 * m2); }
                    f32x4 x[4];
#pragma unroll
                    for (int j = 0; j < 4; ++j) { const u32x2 hw = hw_c[j], y0 = y0_c[j], y1 = y1_c[j];
                        x[j][0] = ALPHA * bflo(hw.x) + g0_c * bflo(y0.x) + g1_c * bflo(y1.x); x[j][1] = ALPHA * bfhi(hw.x) + g0_c * bfhi(y0.x) + g1_c * bfhi(y1.x);
                        x[j][2] = ALPHA * bflo(hw.y) + g0_c * bflo(y0.y) + g1_c * bflo(y1.y); x[j][3] = ALPHA * bfhi(hw.y) + g0_c * bfhi(y0.y) + g1_c * bfhi(y1.y); }
                    ln_row(x, g2, b2, lane);
                    if (l == NLAYER - 1) {
#pragma unroll
                        for (int j = 0; j < 4; ++j) *(f32x4*)((float*)dout + (size_t)m * 1024 + 4 * lane + 256 * j) = x[j];
                    } else store_row_bf16(Hb + (size_t)m * 1024, x, lane);
#pragma unroll
                    for (int j = 0; j < 4; ++j) { hw_c[j] = hw_n[j]; y0_c[j] = y0_n[j]; y1_c[j] = y1_n[j]; }
                    g0_c = g0_n; g1_c = g1_n;
                }
            }
            if (BOTH(pbase + 10)) GRID_BAR();
        }
    }
    if (PROBE_STAMP >= 0 && blockIdx.x == PROBE_BLOCK && threadIdx.x == 0) {
        if (st_t1 == 0ull) st_t1 = __builtin_amdgcn_s_memrealtime();
        const unsigned long long d = st_t1 - st_t0, tend = __builtin_amdgcn_s_memrealtime();
        while (__builtin_amdgcn_s_memrealtime() - tend < 8ull * d) __builtin_amdgcn_s_sleep(8);
    }
#undef IN
#undef BOTH
}

extern "C" void kernel_launch(void* const* d_in, const int* in_sizes, int n_in, void* d_out, int out_size, void* d_ws, size_t ws_size, hipStream_t stream) {
    static int grid = 0;
    if (grid == 0) {
        if (n_in != 29 || out_size != T * DM || ws_size < WS_END) { fprintf(stderr, "kernel_launch: unexpected shapes (n_in %d out %d ws %zu)\n", n_in, out_size, ws_size); grid = -1; return; }
        int dev = 0, cus = 0, per_cu = 0;
        if (hipGetDevice(&dev) != hipSuccess || hipDeviceGetAttribute(&cus, hipDeviceAttributeMultiprocessorCount, dev) != hipSuccess) { grid = -1; return; }
        if (hipFuncSetAttribute((const void*)fwd, hipFuncAttributeMaxDynamicSharedMemorySize, LDS_BYTES) != hipSuccess) { fprintf(stderr, "kernel_launch: hipFuncSetAttribute failed\n"); grid = -1; return; }
        if (hipOccupancyMaxActiveBlocksPerMultiprocessor(&per_cu, (const void*)fwd, 512, LDS_BYTES) != hipSuccess || per_cu < 1) fprintf(stderr, "kernel_launch: occupancy query reports %d\n", per_cu);
        (void)hipGetLastError();
        grid = cus;
    }
    if (grid < 0) return;
    (void)hipMemsetAsync((char*)d_ws + WS_CTL, 0, CTL_BYTES, stream);
    Args a{};
    for (int i = 0; i < 29; ++i) a.in[i] = (const float*)d_in[i];
    a.out = (float*)d_out; a.ws = (unsigned char*)d_ws;
#if MK_PER_PHASE
    for (int p = 0; p < NPHASE; ++p) { a.ph_lo = p; a.ph_hi = p + 1; hipLaunchKernelGGL(fwd, dim3(grid), dim3(512), LDS_BYTES, stream, a); }
#else
    a.ph_lo = 0; a.ph_hi = NPHASE; hipLaunchKernelGGL(fwd, dim3(grid), dim3(512), LDS_BYTES, stream, a);
#endif
}
```

```cpp
#include <hip/hip_runtime.h>
#include <cstdio>
#include <cstdint>

#ifndef CHAIN_MB
#define CHAIN_MB 4
#endif
#ifndef MK_PER_PHASE
#define MK_PER_PHASE 0
#endif

#ifndef PROBE_REPEAT
#define PROBE_REPEAT 0
#endif
#ifndef PROBE_STAMP
#define PROBE_STAMP -1
#endif
#ifndef PROBE_WAVE
#define PROBE_WAVE 0
#endif
#ifndef PROBE_BLOCK
#define PROBE_BLOCK 0
#endif
#ifndef PHMASK
#define PHMASK 0xFFFF
#endif
#define PHON(i) (((PHMASK) >> (i)) & 1)
#define LAS __attribute__((address_space(3)))
#define GAS __attribute__((address_space(1)))
typedef unsigned short bf16;
typedef short bf16x8 __attribute__((ext_vector_type(8)));
typedef short s16x4 __attribute__((ext_vector_type(4)));
typedef float f32x2 __attribute__((ext_vector_type(2)));
typedef float f32x4 __attribute__((ext_vector_type(4)));
typedef float f32x16 __attribute__((ext_vector_type(16)));
typedef unsigned u32x2 __attribute__((ext_vector_type(2)));
typedef unsigned u32x4 __attribute__((ext_vector_type(4)));
typedef __bf16 bf16x2_t __attribute__((ext_vector_type(2)));
typedef short v4i16_t __attribute__((ext_vector_type(4)));

constexpr int T = 32768, S = 8192, NB = 4, DM = 1024, NLAYER = 2;
constexpr int IN_W = 6328;
constexpr int PW = 3328;
constexpr int PC_NQ = 0, PC_KC = 512, PC_VC = 640, PC_KS = 768, PC_VS = 896, PC_KW = 1024, PC_VW = 1152, PC_DQ = 1280, PC_DK = 1792, PC_DV = 2304,
              PC_CQ = 2816, PC_CKV = 3072, PC_KR = 3200, PC_NG = 3232;
constexpr float LOG2E = 1.4426950408889634f;
constexpr float ALPHA = 1.4142135623730951f;
constexpr int NEXP = 16, CAP = 32768, DFF = 512;

constexpr size_t MiB = 1u << 20;
constexpr size_t WS_CTL = 0, CTL_BYTES = 128 * 1024;
constexpr size_t WS_CS = 1 * MiB;
constexpr size_t WS_MISC = 2 * MiB;
constexpr size_t WS_RSQ = 3 * MiB;
constexpr size_t WS_RSKV = WS_RSQ + 256 * 1024;
constexpr size_t WS_RTE = 4 * MiB;
constexpr size_t WS_RTP = WS_RTE + 512 * 1024;
constexpr size_t WS_RTG = WS_RTP + 512 * 1024;
constexpr size_t WS_ROWIDX = 6 * MiB;
constexpr size_t WS_KCMP = 8 * MiB;
constexpr size_t WS_VCMP = WS_KCMP + 512 * 1024;
constexpr size_t WS_UL = 10 * MiB;
constexpr size_t WS_WTS = 32 * MiB;
constexpr size_t WL_WIN = 0, WL_WG = 7 * MiB, WL_WBR = 13 * MiB, WL_WOUT = 16 * MiB, WL_WUQ = 18 * MiB, WL_WUKV = 18 * MiB + 512 * 1024, WL_WC1 = 19 * MiB, WL_STRIDE = 22 * MiB;
constexpr size_t WS_HB = 76 * MiB;
constexpr size_t WS_P = 140 * MiB;
constexpr size_t WS_HS = WS_P + 136 * MiB;
constexpr size_t WS_GS = 348 * MiB;
constexpr size_t WS_W13 = 444 * MiB, WS_W2 = 476 * MiB;
constexpr size_t WS_END = 492 * MiB;
constexpr size_t DO_QM = 0, DO_KVM = 48 * MiB, DO_W13 = 0, DO_W2 = 32 * MiB;

constexpr int CW_BAR = 4096;
constexpr int CW_CVQ = 24576;
constexpr int CW_ATQ = 25600;
constexpr int CW_CNT = 16384;

constexpr int LDS_RING = 131072, LDS_MISC = 131072, LDS_BYTES = 147456;
constexpr int NPHASE = 1 + 11 * NLAYER;

__device__ __forceinline__ int lane_id_v() { int l; asm volatile("v_mbcnt_lo_u32_b32 %0, -1, 0\n\tv_mbcnt_hi_u32_b32 %0, -1, %0" : "=v"(l)); return l; }
__device__ __forceinline__ unsigned f2bf(float f) { unsigned u = __builtin_bit_cast(unsigned, f); return (u + 0x7fffu + ((u >> 16) & 1u)) >> 16; }
__device__ __forceinline__ unsigned pk2(float lo, float hi) { f32x2 v = {lo, hi}; bf16x2_t b = __builtin_convertvector(v, bf16x2_t); return __builtin_bit_cast(unsigned, b); }
__device__ __forceinline__ float bflo(unsigned w) { return __uint_as_float(w << 16); }
__device__ __forceinline__ float bfhi(unsigned w) { return __uint_as_float(w & 0xffff0000u); }
__device__ __forceinline__ float bf2f(bf16 v) { return __uint_as_float(((unsigned)v) << 16); }
__device__ __forceinline__ float fexp2(float x) { return __builtin_amdgcn_exp2f(x); }
__device__ __forceinline__ float sigmoidf_(float x) { return __builtin_amdgcn_rcpf(1.0f + fexp2(-LOG2E * x)); }
__device__ __forceinline__ float wave_sum(float v) {
#pragma unroll
    for (int o = 1; o < 64; o <<= 1) v += __shfl_xor(v, o);
    return v;
}
__device__ __forceinline__ float hmax(float v) { auto rr = __builtin_amdgcn_permlane32_swap(__float_as_uint(v), __float_as_uint(v), false, false); return fmaxf(__uint_as_float(rr[0]), __uint_as_float(rr[1])); }
__device__ __forceinline__ float hsum(float v) { auto rr = __builtin_amdgcn_permlane32_swap(__float_as_uint(v), __float_as_uint(v), false, false); return __uint_as_float(rr[0]) + __uint_as_float(rr[1]); }

__device__ __forceinline__ float xsum8(float v) { return v + __int_as_float(__builtin_amdgcn_update_dpp(0, __float_as_int(v), 0x128, 0xf, 0xf, false)); }
__device__ __forceinline__ float xsum16(float v) { auto rr = __builtin_amdgcn_permlane16_swap(__float_as_uint(v), __float_as_uint(v), false, false); return __uint_as_float(rr[0]) + __uint_as_float(rr[1]); }
__device__ __forceinline__ int xl1(int v) { return __builtin_amdgcn_update_dpp(0, v, 0xB1, 0xf, 0xf, false); }
__device__ __forceinline__ int xl2(int v) { return __builtin_amdgcn_update_dpp(0, v, 0x4E, 0xf, 0xf, false); }
__device__ __forceinline__ int xl4(int v) { return __builtin_amdgcn_update_dpp(0, __builtin_amdgcn_update_dpp(0, v, 0x141, 0xf, 0xf, false), 0x1B, 0xf, 0xf, false); }
__device__ __forceinline__ float xsum1(float v) { return v + __int_as_float(xl1(__float_as_int(v))); }
__device__ __forceinline__ float xsum2(float v) { return v + __int_as_float(xl2(__float_as_int(v))); }
__device__ __forceinline__ float xsum4(float v) { return v + __int_as_float(xl4(__float_as_int(v))); }
__device__ __forceinline__ float xsum_lo16(float v) { return xsum8(xsum4(xsum2(xsum1(v)))); }
#define XB_TMO      128
#define XB_XCNT(j)  (256  + 64 * (j))
#define XB_XSUB(j)  (1280 + 64 * (j))
#define XB_XGEN(j)  (2304 + 64 * (j))
#define XB_TOP      3328
#define XB_TOPGEN   3392
#define XCD_BAR_WORDS 3456
#define XB_SPIN_CAP (1u << 23)
__device__ __forceinline__ unsigned xb_ld(unsigned* p)              { return __hip_atomic_load(p, __ATOMIC_RELAXED, __HIP_MEMORY_SCOPE_AGENT); }
__device__ __forceinline__ unsigned xb_add(unsigned* p, unsigned v) { return __hip_atomic_fetch_add(p, v, __ATOMIC_RELAXED, __HIP_MEMORY_SCOPE_AGENT); }
__device__ __forceinline__ unsigned xb_xcc_id() { return (unsigned)__builtin_amdgcn_s_getreg((3 << 11) | 20) & 0xFu; }
#define XB_SPIN(cond, bar) do { unsigned _sp = 0; while (cond) { __builtin_amdgcn_s_sleep(1); \
    if ((++_sp & 255u) == 0u) { if (xb_ld(&(bar)[XB_TMO])) break; if (_sp > XB_SPIN_CAP) { atomicAdd(&(bar)[XB_TMO], 1u); break; } } } } while (0)
struct XcdBarrier { unsigned* bar; unsigned x; volatile LAS unsigned* st; };
__device__ __forceinline__ XcdBarrier xcd_barrier_post(unsigned* bar, volatile LAS unsigned* st) {
    XcdBarrier b; b.bar = bar; b.x = xb_xcc_id(); b.st = st;
    if (threadIdx.x == 0) (void)xb_add(&bar[XB_XCNT(b.x)], 1u);
    return b;
}
__device__ __forceinline__ void xcd_barrier_complete(unsigned* bar, unsigned x, unsigned& nloc, unsigned& nx) {
    const unsigned G = gridDim.x * gridDim.y * gridDim.z;
    unsigned sum, cnt, mine, sp = 0u;
    for (;;) {
        sum = 0u; cnt = 0u; mine = 0u;
#pragma unroll
        for (unsigned j = 0; j < 16; ++j) { const unsigned c = xb_ld(&bar[XB_XCNT(j)]); sum += c; cnt += (c > 0u) ? 1u : 0u; mine = (j == x) ? c : mine; }
        if (sum == G) break;
        __builtin_amdgcn_s_sleep(1);
        if ((++sp & 255u) == 0u) { if (xb_ld(&bar[XB_TMO])) break; if (sp > XB_SPIN_CAP) { atomicAdd(&bar[XB_TMO], 1u); break; } }
    }
    nloc = mine > 0u ? mine : 1u; nx = cnt > 0u ? cnt : 1u;
}
__device__ __forceinline__ void xcd_barrier(const XcdBarrier& b) {
    asm volatile("s_waitcnt vmcnt(0)" ::: "memory");
    __syncthreads();
    if (threadIdx.x == 0) {
        unsigned* bar = b.bar;
        __builtin_amdgcn_s_waitcnt(0);
        unsigned nloc = b.st[0], nx = b.st[1];
        if (nloc == 0u) { xcd_barrier_complete(bar, b.x, nloc, nx); b.st[0] = nloc; b.st[1] = nx; }
        const unsigned old = xb_add(&bar[XB_XSUB(b.x)], 1u);
        const unsigned gen = old / nloc;
        if (old + 1u == (gen + 1u) * nloc) {
            __builtin_amdgcn_fence(__ATOMIC_RELEASE, "agent");
            asm volatile("s_waitcnt vmcnt(0)" ::: "memory");
            const unsigned og = xb_add(&bar[XB_TOP], 1u);
            const unsigned tg = og / nx;
            if (og + 1u == (tg + 1u) * nx) xb_add(&bar[XB_TOPGEN], 1u);
            else XB_SPIN(xb_ld(&bar[XB_TOPGEN]) == tg, bar);
            __builtin_amdgcn_fence(__ATOMIC_ACQUIRE, "agent");
            xb_add(&bar[XB_XGEN(b.x)], 1u);
            asm volatile("s_waitcnt vmcnt(0)" ::: "memory");
        } else {
            XB_SPIN(xb_ld(&bar[XB_XGEN(b.x)]) == gen, bar);
            __builtin_amdgcn_fence(__ATOMIC_ACQUIRE, "agent");
            asm volatile("s_waitcnt vmcnt(0)" ::: "memory");
        }
    }
    __syncthreads();
}

namespace pg8 {
constexpr int BM = 256, BK = 64, HALF = 128, HTB = HALF * BK * 2, STAGE_BYTES = 8 * HTB;
__device__ __forceinline__ int lds_byte(int r, int c) { const int st = (r >> 4) * 2 + (c >> 5), rr = r & 15, cc = c & 31, ob = rr * 64 + cc * 2; return st * 1024 + (ob ^ (((ob >> 9) & 1) << 5)); }
__device__ __forceinline__ void stage_rc(int b, int& R, int& C) { const int st = b / 1024, sb = b % 1024, swz = sb ^ (((sb >> 9) & 1) << 5); R = (st >> 1) * 16 + swz / 64; C = (st & 1) * 32 + (swz % 64) / 2; }
__device__ __forceinline__ int perm32(int rho) { const int n = rho >> 4, i = rho & 15; return 8 * (i >> 2) + 4 * n + (i & 3); }
struct Unit { int pm, pn, e; };
__device__ __forceinline__ void glds16_s(const void* sbase, unsigned voff, unsigned lds_dst) { unsigned keep;
    asm volatile("s_mov_b32 %0, m0\n\ts_mov_b32 m0, %3\n\ts_nop 0\n\tglobal_load_lds_dwordx4 %1, %2\n\ts_mov_b32 m0, %0" : "=&s"(keep) : "v"(voff), "s"(sbase), "s"(lds_dst) : "memory"); }
template <class Epi, class Sched, bool ALIGN_EPI>
__device__ __forceinline__ void gemm_phase(LAS unsigned char* lds, const int wid_in, const int K, const unsigned kstepA, const Sched& S, const Epi& E) {
    const int wid = wid_in, lane = lane_id_v(), tid = wid * 64 + lane, wr = wid >> 2, wc = wid & 3, fr = lane & 15, fq = lane >> 4;
    const int nt = K / BK;
    int Rr[2], Cc[2]; unsigned voffB[2];
#pragma unroll
    for (int i = 0; i < 2; ++i) { int R, C; stage_rc(tid * 16 + i * 8192, R, C); Rr[i] = R; Cc[i] = C; const int Rb = (R & ~31) + perm32(R & 31); voffB[i] = (unsigned)(Rb * K + C) * 2u; }
    const size_t kstepB = (size_t)(BK * 2);
    const size_t hstepB = (size_t)HALF * K * 2;
    const unsigned ldsb = (unsigned)(uintptr_t)lds + (unsigned)wid * 1024u;
    const int aoff = lds_byte(wr * 64 + fr, fq * 8), boff = lds_byte(wc * 32 + fr, fq * 8);
#define PG8_SA(b, h) (((b) * 2 + (h)) * HTB)
#define PG8_SB(b, h) ((4 + (b) * 2 + (h)) * HTB)
#define PG8_STAGE(bufoff, gbase, voff) do { _Pragma("unroll") for (int _i = 0; _i < 2; ++_i) \
        glds16_s((const void*)(gbase), (voff)[_i], ldsb + (unsigned)((bufoff) + _i * 8192)); } while (0)
#define PG8_LDA(dst, b, h) do { _Pragma("unroll") for (int m = 0; m < 4; ++m) _Pragma("unroll") for (int k = 0; k < 2; ++k) dst[m][k] = *(const LAS bf16x8*)(lds + PG8_SA(b, h) + aoff + m * 2048 + k * 1024); } while (0)
#define PG8_LDB(dst, b, h) do { _Pragma("unroll") for (int n = 0; n < 2; ++n) _Pragma("unroll") for (int k = 0; k < 2; ++k) dst[n][k] = *(const LAS bf16x8*)(lds + PG8_SB(b, h) + boff + n * 2048 + k * 1024); } while (0)
#define PG8_MMA(ai, bj, At, Bt) do { __builtin_amdgcn_s_setprio(1); _Pragma("unroll") for (int m = 0; m < 4; ++m) _Pragma("unroll") for (int n = 0; n < 2; ++n) _Pragma("unroll") for (int k = 0; k < 2; ++k) \
        acc[ai][bj][m][n] = __builtin_amdgcn_mfma_f32_16x16x32_bf16(Bt[n][k], At[m][k], acc[ai][bj][m][n], 0, 0, 0); __builtin_amdgcn_s_setprio(0); } while (0)
#define PG8_WAIT_V(n) asm volatile("s_waitcnt vmcnt(" #n ")" ::: "memory")
#define PG8_WAIT_L(n) asm volatile("s_waitcnt lgkmcnt(" #n ")" ::: "memory")
#define PG8_BAR __builtin_amdgcn_s_barrier()
#define PG8_SCHED __builtin_amdgcn_sched_barrier(0)
    Unit cur, nxt; int ui = 0;
    if (!S.next(0, cur)) return;
    f32x4 acc[2][2][4][2];
#pragma unroll
    for (int a = 0; a < 2; ++a)
#pragma unroll
        for (int b = 0; b < 2; ++b)
#pragma unroll
            for (int m = 0; m < 4; ++m)
#pragma unroll
                for (int n = 0; n < 2; ++n) acc[a][b][m][n] = (f32x4){0.f, 0.f, 0.f, 0.f};
    bf16x8 At[4][2], B0[2][2], B1[2][2];
    const char* cA; const char* cB; unsigned vc[2][2], vn[2][2];
    S.ptrs(cur, cA, cB); S.aoff(cur, Rr, Cc, vc);
    unsigned ksA = kstepA, ksN = kstepA;
    if constexpr (Sched::VAR_KSTEP) { ksA = S.kstep(cur); ksN = ksA; }
    PG8_STAGE(PG8_SB(0, 0), cB, voffB); PG8_STAGE(PG8_SB(0, 1), cB + hstepB, voffB); PG8_STAGE(PG8_SA(0, 0), cA, vc[0]); PG8_STAGE(PG8_SA(0, 1), cA, vc[1]);
    if (wr == 1) PG8_BAR;
    PG8_WAIT_V(2); PG8_BAR;
    PG8_STAGE(PG8_SB(1, 0), cB + kstepB, voffB); PG8_STAGE(PG8_SA(1, 0), cA + ksA, vc[0]); PG8_STAGE(PG8_SB(1, 1), cB + hstepB + kstepB, voffB);
    PG8_WAIT_V(6); PG8_BAR;
    for (;;) {
        const bool has_next = S.next(ui + 1, nxt);
        const char* nA = cA; const char* nB = cB;
        if (has_next) { S.ptrs(nxt, nA, nB); if constexpr (Sched::PER_UNIT_AOFF && !Sched::AOFF_CHEAP) S.aoff(nxt, Rr, Cc, vn); if constexpr (Sched::VAR_KSTEP) ksN = S.kstep(nxt); }
        else if constexpr (Sched::PER_UNIT_AOFF) {
            if constexpr (Sched::AOFF_CHEAP) nxt = cur;
#pragma unroll
            for (int h = 0; h < 2; ++h)
#pragma unroll
                for (int i = 0; i < 2; ++i) vn[h][i] = vc[h][i];
        }
        for (int t = 0; t < nt; t += 2) {
            const bool last = (t == nt - 2);
            const char* a1 = cA + (size_t)(t + 1) * ksA;
            const char* a2 = last ? nA : cA + (size_t)(t + 2) * ksA; const char* b2 = last ? nB : cB + (size_t)(t + 2) * kstepB;
            const char* a3 = a2 + (last ? ksN : ksA); const char* b3 = b2 + kstepB;
#define PG8_STAGE_A2(bufoff, gbase, h) do { if constexpr (Sched::PER_UNIT_AOFF) { if (last) { if constexpr (Sched::AOFF_CHEAP) { unsigned vt_[2][2]; S.aoff(nxt, Rr, Cc, vt_); PG8_STAGE(bufoff, gbase, vt_[h]); } else PG8_STAGE(bufoff, gbase, vn[h]); } else PG8_STAGE(bufoff, gbase, vc[h]); } else PG8_STAGE(bufoff, gbase, vc[h]); } while (0)
            PG8_LDB(B0, 0, 0); PG8_LDB(B1, 0, 1); PG8_SCHED; PG8_LDA(At, 0, 0); PG8_STAGE(PG8_SA(1, 1), a1, vc[1]);
            PG8_WAIT_V(8); PG8_WAIT_L(0); PG8_BAR; PG8_MMA(0, 0, At, B0); PG8_MMA(0, 1, At, B1); PG8_BAR; PG8_SCHED;
            PG8_LDA(At, 0, 1); PG8_STAGE(PG8_SB(0, 0), b2, voffB); PG8_STAGE(PG8_SB(0, 1), b2 + hstepB, voffB); PG8_STAGE_A2(PG8_SA(0, 0), a2, 0);
            PG8_WAIT_V(8); PG8_WAIT_L(0); PG8_BAR; PG8_MMA(1, 0, At, B0); PG8_MMA(1, 1, At, B1); PG8_BAR; PG8_SCHED;
            PG8_LDB(B0, 1, 0); PG8_LDB(B1, 1, 1); PG8_SCHED; PG8_LDA(At, 1, 0); PG8_STAGE_A2(PG8_SA(0, 1), a2, 1);
            PG8_WAIT_V(8); PG8_WAIT_L(0); PG8_BAR; PG8_MMA(0, 0, At, B0); PG8_MMA(0, 1, At, B1); PG8_BAR; PG8_SCHED;
            PG8_LDA(At, 1, 1); PG8_STAGE(PG8_SB(1, 0), b3, voffB); PG8_STAGE(PG8_SB(1, 1), b3 + hstepB, voffB); PG8_STAGE_A2(PG8_SA(1, 0), a3, 0);
            PG8_WAIT_V(8); PG8_WAIT_L(0); PG8_BAR; PG8_MMA(1, 0, At, B0); PG8_MMA(1, 1, At, B1); PG8_BAR; PG8_SCHED;
        }
        if constexpr (ALIGN_EPI) { if (wr == 0) PG8_BAR; }
        E(acc, cur, wr, wc, fr, fq);
        if (!has_next) break;
        bool keep = false; if constexpr (Epi::CHAIN) keep = E.keep(cur);
        if (!keep) {
#pragma unroll
        for (int a = 0; a < 2; ++a)
#pragma unroll
            for (int b = 0; b < 2; ++b)
#pragma unroll
                for (int m = 0; m < 4; ++m)
#pragma unroll
                    for (int n = 0; n < 2; ++n) acc[a][b][m][n] = (f32x4){0.f, 0.f, 0.f, 0.f};
        }
        cur = nxt; cA = nA; cB = nB; ++ui; ksA = ksN;
        if constexpr (Sched::PER_UNIT_AOFF) {
            if constexpr (Sched::AOFF_CHEAP) S.aoff(cur, Rr, Cc, vc);
            else {
#pragma unroll
            for (int h = 0; h < 2; ++h)
#pragma unroll
                for (int i = 0; i < 2; ++i) vc[h][i] = vn[h][i];
            }
        }
        if constexpr (ALIGN_EPI) { if (wr == 1) PG8_BAR; }
    }
    PG8_WAIT_V(0);
    if constexpr (!ALIGN_EPI) { if (wr == 0) PG8_BAR; }
    PG8_BAR;
#undef PG8_SA
#undef PG8_SB
#undef PG8_STAGE
#undef PG8_STAGE_A2
#undef PG8_LDA
#undef PG8_LDB
#undef PG8_MMA
#undef PG8_WAIT_V
#undef PG8_WAIT_L
#undef PG8_BAR
#undef PG8_SCHED
}

struct TileSched {
    static constexpr bool AOFF_CHEAP = false;
    static constexpr bool VAR_KSTEP = false;
    static constexpr bool PER_UNIT_AOFF = false;
    const char* A; const char* Bt; int lda; int K; int nN; int ntot; int G; int v;
    __device__ __forceinline__ bool next(int i, Unit& u) const { const int L = i * G + v; if (L >= ntot) return false; u.pm = L / nN; u.pn = L % nN; u.e = i; return true; }
    __device__ __forceinline__ void ptrs(const Unit& u, const char*& cA, const char*& cB) const { cA = A + (size_t)u.pm * 256 * lda; cB = Bt + (size_t)u.pn * 256 * K * 2; }
    __device__ __forceinline__ void aoff(const Unit&, const int (&R)[2], const int (&C)[2], unsigned (&vo)[2][2]) const {
#pragma unroll
        for (int h = 0; h < 2; ++h)
#pragma unroll
            for (int i = 0; i < 2; ++i) vo[h][i] = (unsigned)((h * 128 + R[i]) * lda + C[i] * 2);
    }
};
struct CmpSched {
    static constexpr bool AOFF_CHEAP = false;
    static constexpr bool VAR_KSTEP = false;
    static constexpr bool PER_UNIT_AOFF = false;
    const char* P; const char* W; int G; int v;
    __device__ __forceinline__ bool next(int i, Unit& u) const { const int L = i * G + v; if (L >= 64) return false; u.pm = (L >> 1) & 1; u.pn = L & 1; u.e = L >> 2; return true; }
    __device__ __forceinline__ void ptrs(const Unit& u, const char*& cA, const char*& cB) const {
        const int kv = u.e >> 3, b = (u.e >> 1) & 3, g = u.e & 1;
        cA = P + ((size_t)(b * S + u.pm * 4096) * PW + PC_KC + kv * 128 + g * 64) * 2; cB = W + (size_t)kv * (512 * 1024 * 2) + (size_t)u.pn * 256 * 2048; }
    __device__ __forceinline__ void aoff(const Unit&, const int (&R)[2], const int (&C)[2], unsigned (&vo)[2][2]) const {
#pragma unroll
        for (int h = 0; h < 2; ++h)
#pragma unroll
            for (int i = 0; i < 2; ++i) vo[h][i] = (unsigned)((h * 128 + R[i]) * (16 * PW * 2) + C[i] * 2);
    }
};
struct MoeSched {
    static constexpr bool VAR_KSTEP = false, AOFF_CHEAP = false;
    static constexpr bool PER_UNIT_AOFF = true;
    const char* A; const char* W; const int* rowidx; const volatile LAS int* TP; const volatile LAS int* CNT; int lda; int K; size_t wstride; bool gather; int G; int v;
    __device__ __forceinline__ bool next(int i, Unit& u) const {
        const int L = i * G + v; const int rt = L >> 2; if (rt >= __builtin_amdgcn_readfirstlane(TP[16])) return false;
        int e = 0;
#pragma unroll
        for (int j = 1; j < 16; ++j) e += (rt >= TP[j]) ? 1 : 0;
        u.pm = rt; u.pn = L & 3; u.e = __builtin_amdgcn_readfirstlane(e); return true; }
    __device__ __forceinline__ void ptrs(const Unit& u, const char*& cA, const char*& cB) const {
        cA = gather ? A : A + (size_t)u.pm * 256 * lda; cB = W + (size_t)u.e * wstride + (size_t)u.pn * 256 * K * 2; }
    __device__ __forceinline__ void aoff(const Unit& u, const int (&R)[2], const int (&C)[2], unsigned (&vo)[2][2]) const {
        if (gather) {
            const int r0 = (u.pm - __builtin_amdgcn_readfirstlane(TP[u.e])) * 256, cnt = __builtin_amdgcn_readfirstlane(CNT[u.e]);
#pragma unroll
            for (int h = 0; h < 2; ++h)
#pragma unroll
                for (int i = 0; i < 2; ++i) { int r = r0 + h * 128 + R[i]; r = r < cnt ? r : 0; const int tok = rowidx[u.e * CAP + r]; vo[h][i] = (unsigned)(tok * lda + C[i] * 2); }
        } else {
#pragma unroll
            for (int h = 0; h < 2; ++h)
#pragma unroll
                for (int i = 0; i < 2; ++i) vo[h][i] = (unsigned)((h * 128 + R[i]) * lda + C[i] * 2);
        }
    }
};

struct EpiStore {
    static constexpr bool CHAIN = false;
    bf16* O; int ldc; const float* rscale; size_t estride; bool remap160;
    __device__ __forceinline__ void operator()(const f32x4 (&acc)[2][2][4][2], const Unit& u, int wr, int wc, int fr, int fq) const {
        bf16* base = O + (estride ? (size_t)u.e * estride : (size_t)0);
        const int row0 = u.pm * 256 + wr * 64 + fr; int col0 = u.pn * 256 + wc * 32 + 8 * fq; int bjs = 128;
        if (remap160) { const int cm = col0 & 127; col0 = (col0 >> 7) * 160 + (cm < 64 ? cm : cm + 32); bjs = 160; }
#pragma unroll
        for (int ai = 0; ai < 2; ++ai)
#pragma unroll
            for (int m = 0; m < 4; ++m) { const int row = row0 + ai * 128 + m * 16; const float sc = rscale ? rscale[row] : 1.f; bf16* rowp = base + (size_t)row * ldc + col0;
#pragma unroll
                for (int bj = 0; bj < 2; ++bj) { const f32x4 v0 = acc[ai][bj][m][0] * sc, v1 = acc[ai][bj][m][1] * sc;
                    u32x4 w; w.x = pk2(v0[0], v0[1]); w.y = pk2(v0[2], v0[3]); w.z = pk2(v1[0], v1[1]); w.w = pk2(v1[2], v1[3]);
                    *(u32x4*)(rowp + bj * bjs) = w; } }
    }
};
struct EpiRope {
    static constexpr bool CHAIN = false;
    bf16* O; const float* CS;
    __device__ __forceinline__ void operator()(const f32x4 (&acc)[2][2][4][2], const Unit& u, int wr, int wc, int fr, int fq) const {
        const int row0 = u.pm * 256 + wr * 64 + fr, col0 = u.pn * 256 + wc * 32 + 8 * fq;
        int i0v[2]; bool rp[2];
#pragma unroll
        for (int bj = 0; bj < 2; ++bj) { const int cm = (col0 + bj * 128) % 96; rp[bj] = cm >= 64; i0v[bj] = rp[bj] ? (cm - 64) >> 1 : 0; }
#pragma unroll
        for (int ai = 0; ai < 2; ++ai)
#pragma unroll
            for (int m = 0; m < 4; ++m) {
                f32x4 ca[2], cb[2];
                const int row = row0 + ai * 128 + m * 16; const int pos = row & (S - 1);
#pragma unroll
                for (int bj = 0; bj < 2; ++bj) { const f32x4* cs = (const f32x4*)(CS + ((size_t)pos * 16 + i0v[bj]) * 2); ca[bj] = cs[0]; cb[bj] = cs[1]; }
                bf16* rowp = O + (size_t)row * 768 + col0;
#pragma unroll
                for (int bj = 0; bj < 2; ++bj) { f32x4 v[2] = {acc[ai][bj][m][0], acc[ai][bj][m][1]};
                    if (rp[bj]) {
                        const f32x4 a = ca[bj], b = cb[bj];
                        f32x4 r0, r1;
                        r0[0] = v[0][0] * a[0] - v[0][1] * a[1]; r0[1] = v[0][0] * a[1] + v[0][1] * a[0];
                        r0[2] = v[0][2] * a[2] - v[0][3] * a[3]; r0[3] = v[0][2] * a[3] + v[0][3] * a[2];
                        r1[0] = v[1][0] * b[0] - v[1][1] * b[1]; r1[1] = v[1][0] * b[1] + v[1][1] * b[0];
                        r1[2] = v[1][2] * b[2] - v[1][3] * b[3]; r1[3] = v[1][2] * b[3] + v[1][3] * b[2];
                        v[0] = r0; v[1] = r1; }
                    u32x4 w; w.x = pk2(v[0][0], v[0][1]); w.y = pk2(v[0][2], v[0][3]); w.z = pk2(v[1][0], v[1][1]); w.w = pk2(v[1][2], v[1][3]);
                    *(u32x4*)(rowp + bj * 128) = w; }
                asm volatile("" ::: "memory");
            }
    }
};
struct EpiGate {
    static constexpr bool CHAIN = false;
    unsigned char* GS;
    __device__ __forceinline__ void operator()(const f32x4 (&acc)[2][2][4][2], const Unit& u, int wr, int wc, int fr, int fq) const {
        unsigned char* base = GS + (size_t)u.e * 65536; const int row0 = wr * 64 + fr, col0 = wc * 32 + 8 * fq;
#pragma unroll
        for (int ai = 0; ai < 2; ++ai)
#pragma unroll
            for (int m = 0; m < 4; ++m) { unsigned char* rowp = base + (row0 + ai * 128 + m * 16) * 256 + col0;
#pragma unroll
                for (int bj = 0; bj < 2; ++bj) { const f32x4 v0 = acc[ai][bj][m][0], v1 = acc[ai][bj][m][1];
#define GQ_(x) ((unsigned)fmaxf(sigmoidf_(x) * 255.f + 0.5f, 1.f))
                    u32x2 w; w.x = GQ_(v0[0]) | (GQ_(v0[1]) << 8) | (GQ_(v0[2]) << 16) | (GQ_(v0[3]) << 24); w.y = GQ_(v1[0]) | (GQ_(v1[1]) << 8) | (GQ_(v1[2]) << 16) | (GQ_(v1[3]) << 24);
#undef GQ_
                    *(u32x2*)(rowp + bj * 128) = w; } }
    }
};
struct EpiBranch {
    static constexpr bool CHAIN = false;
    bf16* Y; const bf16* GS; bool first;
    __device__ __forceinline__ void operator()(const f32x4 (&acc)[2][2][4][2], const Unit& u, int wr, int wc, int fr, int fq) const {
        const bf16* gbase = GS + (size_t)u.e * 65536; const int lrow0 = wr * 64 + fr, lcol0 = wc * 32 + 8 * fq;
#pragma unroll
        for (int ai = 0; ai < 2; ++ai)
#pragma unroll
            for (int mp = 0; mp < 2; ++mp) {
                u32x4 gwv[2][2], yov[2][2];
#pragma unroll
                for (int mm = 0; mm < 2; ++mm)
#pragma unroll
                    for (int bj = 0; bj < 2; ++bj) { const int lrow = lrow0 + ai * 128 + (2 * mp + mm) * 16;
                        gwv[mm][bj] = *(const u32x4*)(gbase + lrow * 256 + lcol0 + bj * 128);
                        if (!first) yov[mm][bj] = *(const u32x4*)(Y + (size_t)(u.pm * 256 + lrow) * DM + u.pn * 256 + lcol0 + bj * 128); }
#pragma unroll
                for (int mm = 0; mm < 2; ++mm) { const int m = 2 * mp + mm; const int lrow = lrow0 + ai * 128 + m * 16; bf16* yrow = Y + (size_t)(u.pm * 256 + lrow) * DM + u.pn * 256 + lcol0;
#pragma unroll
                    for (int bj = 0; bj < 2; ++bj) { const f32x4 v0 = acc[ai][bj][m][0], v1 = acc[ai][bj][m][1]; const u32x4 gw = gwv[mm][bj];
                        float r[8] = {v0[0] * bflo(gw.x), v0[1] * bfhi(gw.x), v0[2] * bflo(gw.y), v0[3] * bfhi(gw.y), v1[0] * bflo(gw.z), v1[1] * bfhi(gw.z), v1[2] * bflo(gw.w), v1[3] * bfhi(gw.w)};
                        if (!first) { const u32x4 yo = yov[mm][bj];
                            r[0] += bflo(yo.x); r[1] += bfhi(yo.x); r[2] += bflo(yo.y); r[3] += bfhi(yo.y); r[4] += bflo(yo.z); r[5] += bfhi(yo.z); r[6] += bflo(yo.w); r[7] += bfhi(yo.w); }
                        u32x4 w; w.x = pk2(r[0], r[1]); w.y = pk2(r[2], r[3]); w.z = pk2(r[4], r[5]); w.w = pk2(r[6], r[7]);
                        *(u32x4*)(yrow + bj * 128) = w; } }
            }
    }
};
struct EpiResid {
    static constexpr bool CHAIN = false;
    bf16* Z; const bf16* H;
    __device__ __forceinline__ void operator()(const f32x4 (&acc)[2][2][4][2], const Unit& u, int wr, int wc, int fr, int fq) const {
        const int row0 = u.pm * 256 + wr * 64 + fr, col0 = u.pn * 256 + wc * 32 + 8 * fq;
#pragma unroll
        for (int ai = 0; ai < 2; ++ai) {
            u32x4 hv[4][2];
#pragma unroll
            for (int m = 0; m < 4; ++m)
#pragma unroll
                for (int bj = 0; bj < 2; ++bj) hv[m][bj] = *(const u32x4*)(H + (size_t)(row0 + ai * 128 + m * 16) * DM + col0 + bj * 128);
#pragma unroll
            for (int m = 0; m < 4; ++m) { const size_t off = (size_t)(row0 + ai * 128 + m * 16) * DM + col0;
#pragma unroll
                for (int bj = 0; bj < 2; ++bj) { const u32x4 hw = hv[m][bj];
                    const f32x4 o0 = acc[ai][bj][m][0], o1 = acc[ai][bj][m][1];
                    u32x4 w; w.x = pk2(o0[0] + ALPHA * bflo(hw.x), o0[1] + ALPHA * bfhi(hw.x)); w.y = pk2(o0[2] + ALPHA * bflo(hw.y), o0[3] + ALPHA * bfhi(hw.y));
                    w.z = pk2(o1[0] + ALPHA * bflo(hw.z), o1[1] + ALPHA * bfhi(hw.z)); w.w = pk2(o1[2] + ALPHA * bflo(hw.w), o1[3] + ALPHA * bfhi(hw.w));
                    *(u32x4*)(Z + off + bj * 128) = w; } }
        }
    }
};
struct EpiSwiglu {
    static constexpr bool CHAIN = false;
    bf16* HS;
    __device__ __forceinline__ void operator()(const f32x4 (&acc)[2][2][4][2], const Unit& u, int wr, int wc, int fr, int fq) const {
        const int row0 = u.pm * 256 + wr * 64 + fr, col0 = u.pn * 128 + wc * 32 + 8 * fq;
#pragma unroll
        for (int ai = 0; ai < 2; ++ai)
#pragma unroll
            for (int m = 0; m < 4; ++m) { bf16* rowp = HS + (size_t)(row0 + ai * 128 + m * 16) * DFF + col0;
                float r[8];
#pragma unroll
                for (int n = 0; n < 2; ++n)
#pragma unroll
                    for (int q = 0; q < 4; ++q) { const float a = acc[ai][0][m][n][q], b = acc[ai][1][m][n][q]; r[n * 4 + q] = a * sigmoidf_(a) * b; }
                u32x4 w; w.x = pk2(r[0], r[1]); w.y = pk2(r[2], r[3]); w.z = pk2(r[4], r[5]); w.w = pk2(r[6], r[7]);
                *(u32x4*)rowp = w; }
    }
};

struct GateSched {
    static constexpr bool AOFF_CHEAP = false;
    static constexpr bool PER_UNIT_AOFF = false, VAR_KSTEP = false;
    const char* A; const char* Wg; int pm, pn; bool valid;
    __device__ __forceinline__ bool next(int i, Unit& u) const { if (!valid || i >= 3) return false; u.pm = pm; u.pn = pn; u.e = i; return true; }
    __device__ __forceinline__ void ptrs(const Unit& u, const char*& cA, const char*& cB) const { cA = A + (size_t)pm * 256 * 2048; cB = Wg + ((size_t)u.e * 1024 + (size_t)pn * 256) * 2048; }
    __device__ __forceinline__ void aoff(const Unit&, const int (&R)[2], const int (&C)[2], unsigned (&vo)[2][2]) const {
#pragma unroll
        for (int h = 0; h < 2; ++h)
#pragma unroll
            for (int i = 0; i < 2; ++i) vo[h][i] = (unsigned)((h * 128 + R[i]) * 2048 + C[i] * 2);
    }
};
struct ChainSched {
    static constexpr bool AOFF_CHEAP = true;
    static constexpr bool PER_UNIT_AOFF = true, VAR_KSTEP = true;
    const char* Pn; const char* Pd; const char* Qm; const char* Wbr; int pm, pn; bool valid;
    __device__ __forceinline__ bool next(int i, Unit& u) const { if (!valid || i >= 3) return false; u.pm = pm; u.pn = pn; u.e = i; return true; }
    __device__ __forceinline__ int lda(const Unit& u) const { return u.e == 2 ? 1536 : PW * 2; }
    __device__ __forceinline__ unsigned kstep(const Unit& u) const { return u.e == 2 ? 192u : 128u; }
    __device__ __forceinline__ void ptrs(const Unit& u, const char*& cA, const char*& cB) const {
        cA = (u.e == 0 ? Pn : (u.e == 1 ? Pd : Qm)) + (size_t)pm * 256 * lda(u); cB = Wbr + (size_t)u.e * (1024 * 512 * 2) + (size_t)pn * 256 * 1024; }
    __device__ __forceinline__ void aoff(const Unit& u, const int (&R)[2], const int (&C)[2], unsigned (&vo)[2][2]) const { const int ld = lda(u);
#pragma unroll
        for (int h = 0; h < 2; ++h)
#pragma unroll
            for (int i = 0; i < 2; ++i) vo[h][i] = (unsigned)((h * 128 + R[i]) * ld + C[i] * 2);
    }
};
struct EpiChain {
    static constexpr bool CHAIN = true;
    static constexpr int MB = CHAIN_MB;
    bf16* Y; const unsigned char* GS;
    __device__ __forceinline__ bool keep(const Unit& u) const { return u.e < 2; }
    __device__ __forceinline__ void operator()(f32x4 (&acc)[2][2][4][2], const Unit& u, int wr, int wc, int fr, int fq) const {
        const int j = u.e; const unsigned char* ga = GS + (size_t)j * 65536; const unsigned char* gb = GS + (size_t)(j < 2 ? j + 1 : j) * 65536; const int lrow0 = wr * 64 + fr, lcol0 = wc * 32 + 8 * fq;
        const unsigned goff0 = (unsigned)(lrow0 * 256 + lcol0); const char* yb = (const char*)(Y + (size_t)u.pm * 256 * DM + u.pn * 256); const unsigned yoff0 = (unsigned)((lrow0 * DM + lcol0) * 2);
#pragma unroll
        for (int ai = 0; ai < 2; ++ai)
#pragma unroll
            for (int mp = 0; mp < 4; mp += MB) {
                unsigned gob = goff0, yob = yoff0; asm volatile("" : "+v"(gob), "+v"(yob));
                u32x2 av[MB][2], bv[MB][2];
#pragma unroll
                for (int mm = 0; mm < MB; ++mm)
#pragma unroll
                    for (int bj = 0; bj < 2; ++bj) { const unsigned off = gob + (unsigned)((ai * 128 + (mp + mm) * 16) * 256 + bj * 128);
                        av[mm][bj] = *(const u32x2*)(ga + off); bv[mm][bj] = *(const u32x2*)(gb + off); }
#pragma unroll
                for (int mm = 0; mm < MB; ++mm) { const int m = mp + mm;
#pragma unroll
                    for (int bj = 0; bj < 2; ++bj) { const u32x2 a = av[mm][bj];
                        float f[8] = {(float)(a.x & 255u), (float)((a.x >> 8) & 255u), (float)((a.x >> 16) & 255u), (float)(a.x >> 24), (float)(a.y & 255u), (float)((a.y >> 8) & 255u), (float)((a.y >> 16) & 255u), (float)(a.y >> 24)};
                        if (j < 2) { const u32x2 b = bv[mm][bj];
                            const float d[8] = {(float)(b.x & 255u), (float)((b.x >> 8) & 255u), (float)((b.x >> 16) & 255u), (float)(b.x >> 24), (float)(b.y & 255u), (float)((b.y >> 8) & 255u), (float)((b.y >> 16) & 255u), (float)(b.y >> 24)};
#pragma unroll
                            for (int q = 0; q < 8; ++q) f[q] *= __builtin_amdgcn_rcpf(d[q]); }
                        else {
#pragma unroll
                            for (int q = 0; q < 8; ++q) f[q] *= (1.f / 255.f); }
                        f32x4& v0 = acc[ai][bj][m][0]; f32x4& v1 = acc[ai][bj][m][1];
                        v0[0] *= f[0]; v0[1] *= f[1]; v0[2] *= f[2]; v0[3] *= f[3]; v1[0] *= f[4]; v1[1] *= f[5]; v1[2] *= f[6]; v1[3] *= f[7];
                        if (j == 2) { u32x4 w; w.x = pk2(v0[0], v0[1]); w.y = pk2(v0[2], v0[3]); w.z = pk2(v1[0], v1[1]); w.w = pk2(v1[2], v1[3]);
                            *(u32x4*)(yb + (yob + (unsigned)(((ai * 128 + m * 16) * DM + bj * 128) * 2))) = w; } } }
                asm volatile("" ::: "memory");
            }
    }
};
}

namespace fa {
constexpr float NEG = -1.0e30f;
__device__ __forceinline__ int crow(int i, int hb) { return (i & 3) + 8 * (i >> 2) + 4 * hb; }
__device__ __forceinline__ s16x4 vtr(const LAS char* p) { return __builtin_bit_cast(s16x4, __builtin_amdgcn_ds_read_tr16_b64_v4i16((LAS v4i16_t*)p)); }

template <int DQK>
__device__ __forceinline__ void qk_tile(const LAS char* kl, const bf16x8 (&qf)[DQK / 16], f32x16& s0, f32x16& s1, int r32, int hb) {
    constexpr int KSTR = DQK * 2 + 16, KS = DQK / 16;
    const LAS char* kp = kl + r32 * KSTR + hb * 16;
    bf16x8 k0[KS], k1[KS];
#pragma unroll
    for (int s = 0; s < KS; ++s) { k0[s] = *(const LAS bf16x8*)(kp + s * 32); k1[s] = *(const LAS bf16x8*)(kp + 32 * KSTR + s * 32); }
    __builtin_amdgcn_sched_barrier(0);
    const f32x16 z = {0.f, 0.f, 0.f, 0.f, 0.f, 0.f, 0.f, 0.f, 0.f, 0.f, 0.f, 0.f, 0.f, 0.f, 0.f, 0.f};
    s0 = __builtin_amdgcn_mfma_f32_32x32x16_bf16(k0[0], qf[0], z, 0, 0, 0);
    s1 = __builtin_amdgcn_mfma_f32_32x32x16_bf16(k1[0], qf[0], z, 0, 0, 0);
#pragma unroll
    for (int s = 1; s < KS; ++s) {
        s0 = __builtin_amdgcn_mfma_f32_32x32x16_bf16(k0[s], qf[s], s0, 0, 0, 0);
        s1 = __builtin_amdgcn_mfma_f32_32x32x16_bf16(k1[s], qf[s], s1, 0, 0, 0);
    }
}
template <bool CHECK>
__device__ __forceinline__ void score_tile(f32x16& s0, f32x16& s1, float d0, float kstep, float c1, float slope2, float wlim, bool lanevalid, int hb) {
#pragma unroll
    for (int i = 0; i < 16; ++i) {
        const float k0 = (float)crow(i, hb) * kstep;
        const float da = d0 - k0, db = d0 - k0 - 32.f * kstep;
        float va = __builtin_fmaf(s0[i], c1, -slope2 * da), vb = __builtin_fmaf(s1[i], c1, -slope2 * db);
        if (CHECK) { va = (da >= 0.f && da < wlim && lanevalid) ? va : NEG; vb = (db >= 0.f && db < wlim && lanevalid) ? vb : NEG; }
        s0[i] = va; s1[i] = vb;
    }
}
__device__ __forceinline__ float tile_max(const f32x16& s0, const f32x16& s1) {
    float a = fmaxf(fmaxf(s0[0], s0[1]), s1[0]), b = fmaxf(fmaxf(s0[2], s0[3]), s1[1]);
    a = fmaxf(fmaxf(a, s1[2]), s1[3]);
#pragma unroll
    for (int i = 4; i < 16; i += 4) { a = fmaxf(fmaxf(a, s0[i]), s0[i + 1]); b = fmaxf(fmaxf(b, s0[i + 2]), s0[i + 3]); a = fmaxf(fmaxf(a, s1[i]), s1[i + 1]); b = fmaxf(fmaxf(b, s1[i + 2]), s1[i + 3]); }
    return hmax(fmaxf(a, b));
}
__device__ __forceinline__ float tile_max_half(const f32x16& s0, const f32x16& s1) {
    float a = fmaxf(fmaxf(s0[0], s0[1]), s1[0]), b = fmaxf(fmaxf(s0[2], s0[3]), s1[1]);
    a = fmaxf(fmaxf(a, s1[2]), s1[3]);
#pragma unroll
    for (int i = 4; i < 16; i += 4) { a = fmaxf(fmaxf(a, s0[i]), s0[i + 1]); b = fmaxf(fmaxf(b, s0[i + 2]), s0[i + 3]); a = fmaxf(fmaxf(a, s1[i]), s1[i + 1]); b = fmaxf(fmaxf(b, s1[i + 2]), s1[i + 3]); }
    return fmaxf(a, b);
}
__device__ __forceinline__ void pack_p(const f32x16& s0, const f32x16& s1, bf16x8 (&pa)[4]) {
#pragma unroll
    for (int sp = 0; sp < 2; ++sp) {
        u32x4 w0, w1;
        w0.x = pk2(s0[8 * sp + 0], s0[8 * sp + 1]); w0.y = pk2(s0[8 * sp + 2], s0[8 * sp + 3]); w0.z = pk2(s0[8 * sp + 4], s0[8 * sp + 5]); w0.w = pk2(s0[8 * sp + 6], s0[8 * sp + 7]);
        w1.x = pk2(s1[8 * sp + 0], s1[8 * sp + 1]); w1.y = pk2(s1[8 * sp + 2], s1[8 * sp + 3]); w1.z = pk2(s1[8 * sp + 4], s1[8 * sp + 5]); w1.w = pk2(s1[8 * sp + 6], s1[8 * sp + 7]);
        pa[sp] = __builtin_bit_cast(bf16x8, w0); pa[2 + sp] = __builtin_bit_cast(bf16x8, w1);
    }
}
__device__ __forceinline__ float softmax_step(f32x16& s0, f32x16& s1, float& m, float& l) {
    const float mx = tile_max(s0, s1);
    const float mn = fmaxf(m, mx);
    const float alpha = fexp2(m - mn);
    m = mn;
    float ra = 0.f, rb = 0.f;
#pragma unroll
    for (int i = 0; i < 16; ++i) { s0[i] = fexp2(s0[i] - mn); s1[i] = fexp2(s1[i] - mn); ra += s0[i]; rb += s1[i]; }
    l = l * alpha + hsum(ra + rb);
    return alpha;
}
template <int DV>
__device__ __forceinline__ int v_swz(int key) { return DV == 64 ? (((key >> 1) & 1) << 6) : ((key & 3) << 6); }
template <int DV>
__device__ __forceinline__ void v_load(const LAS char* vl, int lane, int dvb0, bf16x8 (&vf)[2][4]) {
    constexpr int VSTR = DV * 2;
    const int g16 = lane >> 4, i16 = lane & 15, q = i16 >> 2, p = i16 & 3, hb = lane >> 5;
    const int f = (DV == 64) ? ((q >> 1) & 1) : q;
    const int rowb = (4 * hb + q) * VSTR + 2 * (16 * (g16 & 1) + 4 * p);
#pragma unroll
    for (int d = 0; d < 2; ++d) {
        unsigned vba = (unsigned)(uintptr_t)vl + (unsigned)(rowb + (((dvb0 + d) ^ f) << 6));
        asm volatile("" : "+v"(vba));
        const LAS char* vb = (const LAS char*)vba;
#pragma unroll
        for (int ks = 0; ks < 4; ++ks) {
            const s16x4 lo = vtr(vb + (16 * ks) * VSTR), hi = vtr(vb + (16 * ks + 8) * VSTR);
            vf[d][ks] = (bf16x8){lo[0], lo[1], lo[2], lo[3], hi[0], hi[1], hi[2], hi[3]};
        }
    }
}
__device__ __forceinline__ void pv_mma(const bf16x8 (&vf)[2][4], const bf16x8 (&pa)[4], f32x16& oa, f32x16& ob) {
#pragma unroll
    for (int ks = 0; ks < 4; ++ks) {
        oa = __builtin_amdgcn_mfma_f32_32x32x16_bf16(vf[0][ks], pa[ks], oa, 0, 0, 0);
        ob = __builtin_amdgcn_mfma_f32_32x32x16_bf16(vf[1][ks], pa[ks], ob, 0, 0, 0);
    }
}
template <int DV>
__device__ __forceinline__ void pv_tile(const LAS char* vl, const bf16x8 (&pa)[4], f32x16 (&o)[DV / 32], int lane) {
#pragma unroll
    for (int d0 = 0; d0 < DV / 32; d0 += 2) { bf16x8 vf[2][4]; v_load<DV>(vl, lane, d0, vf); __builtin_amdgcn_sched_barrier(0); pv_mma(vf, pa, o[d0], o[d0 + 1]); }
}
}

constexpr int A_KB = 13312, A_VB0 = 26624, A_VB = 16384;
constexpr int A_SC = 61440, A_SM = 129920, A_UN = 130944;
__device__ __forceinline__ float alibi_slope(int idx) { return fexp2(-8.0f * (float)(idx + 1) / 12.0f); }
__device__ __forceinline__ unsigned getw(const u32x4& w, int i) { return i == 0 ? w.x : (i == 1 ? w.y : (i == 2 ? w.z : w.w)); }
__device__ __forceinline__ int next_bit(const u32x4& w, int from) {
    int res = 128;
#pragma unroll
    for (int wi = 3; wi >= 0; --wi) { unsigned x = getw(w, wi); const int lo = wi * 32;
        if (from > lo + 31) x = 0u; else if (from > lo) x &= (~0u) << (from - lo);
        if (x) res = lo + __builtin_ctz(x); }
    return res;
}

struct Ld64 {
    const char* kp; const char* vp; int kstr, vstr; u32x4 rk, rv;
    __device__ __forceinline__ void issue(int key0, int tid, bool withV) { const int row = tid >> 3, ch = tid & 7;
        rk = *(const u32x4*)(kp + (size_t)(key0 + row) * kstr + ch * 16); if (withV) rv = *(const u32x4*)(vp + (size_t)(key0 + row) * vstr + ch * 16); }
    __device__ __forceinline__ void commit(LAS char* kl, LAS char* vl, int tid, bool withV) { const int row = tid >> 3, ch = tid & 7;
        *(LAS u32x4*)(kl + row * 144 + ch * 16) = rk; if (withV) *(LAS u32x4*)(vl + row * 128 + ((ch * 16) ^ fa::v_swz<64>(row))) = rv; }
};
struct LdDiff {
    const char* kp; const char* vp; u32x4 rk, rv0, rv1;
    __device__ __forceinline__ void issue(int key0, int tid) {
        rk = *(const u32x4*)(kp + (size_t)(key0 + (tid >> 3)) * (PW * 2) + (tid & 7) * 16);
        const char* v = vp + (size_t)(key0 + (tid >> 4)) * (PW * 2) + (tid & 15) * 16; rv0 = *(const u32x4*)v; rv1 = *(const u32x4*)(v + (size_t)32 * PW * 2); }
    __device__ __forceinline__ void commit(LAS char* kl, LAS char* vl, int tid) {
        *(LAS u32x4*)(kl + (tid >> 3) * 144 + (tid & 7) * 16) = rk;
        const int row = tid >> 4, off = ((tid & 15) * 16) ^ fa::v_swz<128>(row);
        *(LAS u32x4*)(vl + row * 256 + off) = rv0; *(LAS u32x4*)(vl + (row + 32) * 256 + off) = rv1; }
};
struct LdMla {
    const char* knp; const char* krp; const char* vp; u32x4 rk0, rk1, rv;
    __device__ __forceinline__ const char* ksrc(int key0, int c) const { const int row = c / 12, ch = c - row * 12;
        return ch < 8 ? knp + (size_t)(key0 + row) * 2048 + ch * 16 : krp + (size_t)(key0 + row) * (PW * 2) + (ch - 8) * 16; }
    __device__ __forceinline__ void issue(int key0, int tid) {
        rk0 = *(const u32x4*)ksrc(key0, tid); if (tid < 256) rk1 = *(const u32x4*)ksrc(key0, tid + 512);
        rv = *(const u32x4*)(vp + (size_t)(key0 + (tid >> 3)) * 2048 + (tid & 7) * 16); }
    __device__ __forceinline__ void commit(LAS char* kl, LAS char* vl, int tid) {
        { const int row = tid / 12, ch = tid - row * 12; *(LAS u32x4*)(kl + row * 208 + ch * 16) = rk0; }
        if (tid < 256) { const int c = tid + 512, row = c / 12, ch = c - row * 12; *(LAS u32x4*)(kl + row * 208 + ch * 16) = rk1; }
        const int row = tid >> 3; *(LAS u32x4*)(vl + row * 128 + (((tid & 7) * 16) ^ fa::v_swz<64>(row))) = rv; }
};

template <int DQK, int DV, class Ld>
__device__ __forceinline__ void flash_causal(LAS char* lds, Ld& ld, const bf16x8 (&qf)[DQK / 16], f32x16 (&o)[DV / 32], float& m, float& l,
                                             int q0, int wq0, int t, float c1, float slope2, int tid, int lane, int r32, int hb) {
    const int nt = (q0 + 256) >> 6;
    ld.issue(0, tid); ld.commit(lds, lds + A_VB0, tid); __syncthreads();
    for (int kt = 0; kt < nt; ++kt) {
        const int buf = kt & 1, key0 = 64 * kt;
        if (kt + 1 < nt) ld.issue(key0 + 64, tid);
        if (key0 <= wq0 + 31) {
            f32x16 s0, s1; fa::qk_tile<DQK>(lds + buf * A_KB, qf, s0, s1, r32, hb);
            if (key0 + 63 > wq0) fa::score_tile<true>(s0, s1, (float)(t - key0), 1.f, c1, slope2, 1.0e9f, true, hb);
            else fa::score_tile<false>(s0, s1, (float)(t - key0), 1.f, c1, slope2, 1.0e9f, true, hb);
            const float alpha = fa::softmax_step(s0, s1, m, l);
#pragma unroll
            for (int d = 0; d < DV / 32; ++d) o[d] = o[d] * alpha;
            bf16x8 pa[4]; fa::pack_p(s0, s1, pa);
            fa::pv_tile<DV>(lds + A_VB0 + buf * A_VB, pa, o, lane);
        }
        if (kt + 1 < nt) ld.commit(lds + (buf ^ 1) * A_KB, lds + A_VB0 + (buf ^ 1) * A_VB, tid);
        __syncthreads();
    }
}


#ifndef DIFF_PIPE
#define DIFF_PIPE false
#endif
#ifndef MLA_PIPE
#define MLA_PIPE false
#endif
#ifndef USE_PIPE
#define USE_PIPE 3
#endif
#ifndef FP_KL
#define FP_KL 8
#endif
#ifndef ATT_QUEUE
#define ATT_QUEUE 1
#endif
#ifndef FP_ROT
#define FP_ROT 0
#endif
#ifndef FP_NPRE
#define FP_NPRE 6
#endif
#ifndef FP_VL
#define FP_VL 8
#endif
#ifndef PROBE_VAR
#define PROBE_VAR 0
#endif
namespace fr {
template <int DQK, int DV> struct Geo {
    static constexpr int KS = DQK / 16, NDV = DV / 32;
    static constexpr int KROWB = (DQK == 64) ? 128 : 256;
    static constexpr int KSLOT = 64 * KROWB, VSLOT = 64 * DV * 2;
    static constexpr int KBASE = 0, VBASE = 3 * KSLOT;
    static constexpr int PK = KSLOT / 8192, PV = VSLOT / 8192;
};
template <int DQK> __device__ __forceinline__ void k_offsets(unsigned* vo, int wid, int lane, int strideB) {
    if constexpr (DQK == 64) { const int row = 8 * wid + (lane >> 3), cp = lane & 7, c = cp ^ ((row >> 1) & 7); vo[0] = (unsigned)(row * strideB + c * 16); }
    else {
#pragma unroll
        for (int j = 0; j < 2; ++j) { const int p = wid + 8 * j, row = 4 * p + (lane >> 4), cp = lane & 15; int c = cp ^ (row & 15); if (c >= 12) c = 0; vo[j] = (unsigned)(row * strideB + c * 16); }
    }
}
template <int DV> __device__ __forceinline__ void v_offsets(unsigned* vo, int wid, int lane, int strideB) {
    if constexpr (DV == 64) { const int row = 8 * wid + (lane >> 3), pp = lane & 7, lg = ((((pp >> 2) ^ ((row >> 1) & 1))) << 2) | (pp & 3); vo[0] = (unsigned)(row * strideB + lg * 16); }
    else {
#pragma unroll
        for (int j = 0; j < 2; ++j) { const int p = wid + 8 * j, row = 4 * p + (lane >> 4), pp = lane & 15, lg = (((pp >> 2) ^ (row & 3)) << 2) | (pp & 3); vo[j] = (unsigned)(row * strideB + lg * 16); }
    }
}
template <int DQK, bool BATCH = true>
__device__ __forceinline__ void qk_ring(const LAS char* kl, const int (&ka)[DQK / 16], const bf16x8 (&qf)[DQK / 16], f32x16& s0, f32x16& s1) {
    constexpr int KROWB = (DQK == 64) ? 128 : 256, KS = DQK / 16;
    bf16x8 k0[KS], k1[KS];
#pragma unroll
    for (int s = 0; s < KS; ++s) { unsigned a = (unsigned)(uintptr_t)kl + (unsigned)ka[s]; asm volatile("" : "+v"(a)); const LAS char* kp = (const LAS char*)a;
        k0[s] = *(const LAS bf16x8*)kp; k1[s] = *(const LAS bf16x8*)(kp + 32 * KROWB); }
    if constexpr (BATCH) __builtin_amdgcn_sched_barrier(0);
    const f32x16 z = {0.f, 0.f, 0.f, 0.f, 0.f, 0.f, 0.f, 0.f, 0.f, 0.f, 0.f, 0.f, 0.f, 0.f, 0.f, 0.f};
    s0 = __builtin_amdgcn_mfma_f32_32x32x16_bf16(k0[0], qf[0], z, 0, 0, 0);
    s1 = __builtin_amdgcn_mfma_f32_32x32x16_bf16(k1[0], qf[0], z, 0, 0, 0);
#pragma unroll
    for (int s = 1; s < KS; ++s) {
        s0 = __builtin_amdgcn_mfma_f32_32x32x16_bf16(k0[s], qf[s], s0, 0, 0, 0);
        s1 = __builtin_amdgcn_mfma_f32_32x32x16_bf16(k1[s], qf[s], s1, 0, 0, 0);
    }
}
template <bool ALIBI, bool CHECK, int NDV>
__device__ __forceinline__ void soft_tile(f32x16& s0, f32x16& s1, float c1, float slope2, float d0, int hb, float& m, float& l, f32x16 (&o)[NDV], bf16x8 (&pa)[4]) {
    const float dh = d0 - (float)(4 * hb);
    const float E = ALIBI ? -slope2 * d0 : 0.f;
    if constexpr (CHECK) {
#pragma unroll
        for (int i = 0; i < 16; ++i) { const float ci = (float)((i & 3) + 8 * (i >> 2)); if (ci > dh) s0[i] = fa::NEG; if (ci + 32.f > dh) s1[i] = fa::NEG; }
    }
    const float mx = fa::tile_max(s0, s1) + E;
    const float mn = fmaxf(m, mx);
    if (NDV > 2 || __builtin_amdgcn_ballot_w64(mn > m) != 0ull) {
        const float alpha = fexp2(m - mn); l *= alpha;
#pragma unroll
        for (int d = 0; d < NDV; ++d) o[d] = o[d] * alpha;
    }
    m = mn;
    float ra = 0.f, rb = 0.f; const float sub = mn - E;
#pragma unroll
    for (int i = 0; i < 16; ++i) {
        s0[i] = fexp2(s0[i] - sub); s1[i] = fexp2(s1[i] - sub);
        ra += s0[i]; rb += s1[i]; }
    l += hsum(ra + rb);
    fa::pack_p(s0, s1, pa);
}
#define FR_WAITBAR(N) asm volatile("s_waitcnt vmcnt(" #N ") lgkmcnt(0)\n\ts_barrier" ::: "memory")
template <int DQK, int DV, bool ALIBI, bool PIPE, int VAR = 0>
__device__ __forceinline__ void flash_ring(LAS char* lds, const char* kbase, const char* vbase, const int strideB, const bf16x8 (&qf)[DQK / 16], f32x16 (&o)[DV / 32], float& m, float& l,
                                           const int q0, const int wq0, const int t, const float c1, const float slope2, const int wid, const int lane) {
    typedef Geo<DQK, DV> GG;
    constexpr int PK = GG::PK, PV = GG::PV, NDV = DV / 32;
    const int r32 = lane & 31, hb = lane >> 5;
    const int nt = (q0 + 256) >> 6, tmax = (wq0 + 31) >> 6;
    const int iskip = nt - 1 - tmax;
    unsigned voK[PK], voV[PV];
    k_offsets<DQK>(voK, wid, lane, strideB); v_offsets<DV>(voV, wid, lane, strideB);
    int ka[DQK / 16];
    { const int f = (DQK == 64) ? ((r32 >> 1) & 7) : (r32 & 15);
#pragma unroll
      for (int s = 0; s < DQK / 16; ++s) ka[s] = r32 * GG::KROWB + (((2 * s + hb) ^ f) << 4); }
    const unsigned ldsb = (unsigned)(uintptr_t)lds + (unsigned)wid * 1024u;
#define FR_ISSUE_K(it) do { const int it_ = (it); const char* b_ = kbase + (size_t)(nt - 1 - it_) * 64 * strideB; const unsigned d_ = ldsb + GG::KBASE + (unsigned)(it_ % 3) * GG::KSLOT; \
        _Pragma("unroll") for (int j_ = 0; j_ < PK; ++j_) pg8::glds16_s(b_, voK[j_], d_ + j_ * 8192); } while (0)
#define FR_ISSUE_V(it) do { const int it_ = (it); const char* b_ = vbase + (size_t)(nt - 1 - it_) * 64 * strideB; const unsigned d_ = ldsb + GG::VBASE + (unsigned)(it_ % 3) * GG::VSLOT; \
        _Pragma("unroll") for (int j_ = 0; j_ < PV; ++j_) pg8::glds16_s(b_, voV[j_], d_ + j_ * 8192); } while (0)
    constexpr bool KPRE = PIPE;
    constexpr int KA = KPRE ? 1 : 0, KS = DQK / 16;
#define FR_ISSUE(i_) do { if ((i_) + 2 + KA < nt) FR_ISSUE_K((i_) + 2 + KA); if ((i_) + 2 < nt) FR_ISSUE_V((i_) + 2); } while (0)
#define FR_END(i_) do { if ((i_) + 2 + KA < nt) { if constexpr (PK + PV == 2) FR_WAITBAR(2); else FR_WAITBAR(3); } \
        else if ((i_) + 2 < nt) { if constexpr (PV == 1) FR_WAITBAR(1); else FR_WAITBAR(2); } else FR_WAITBAR(0); } while (0)
#define FR_KSLOT(i_) (lds + GG::KBASE + ((i_) % 3) * GG::KSLOT)
#define FR_VSLOT(i_) (lds + GG::VBASE + ((i_) % 3) * GG::VSLOT)
    bf16x8 kf0[KS], kf1[KS];
    bf16x8 kx0 = {0, 0, 0, 0, 0, 0, 0, 0}, kx1 = {0, 0, 0, 0, 0, 0, 0, 0}, qx = {0, 0, 0, 0, 0, 0, 0, 0};
    if constexpr (ALIBI) { if (hb == 0) { const short a0 = (short)f2bf((float)r32), a1 = (short)f2bf((float)(r32 + 32)); kx0[0] = a0; kx0[1] = a0; kx1[0] = a1; kx1[1] = a1;
        float sl_ = slope2; asm volatile("" : "+v"(sl_));
        const unsigned hi = f2bf(sl_); const float lo = sl_ - __uint_as_float(hi << 16); qx[0] = (short)hi; qx[1] = (short)f2bf(lo); } }
#define FR_KLOAD(i_) do { const LAS char* kl_ = FR_KSLOT(i_); _Pragma("unroll") for (int s_ = 0; s_ < KS; ++s_) { unsigned a_ = (unsigned)(uintptr_t)kl_ + (unsigned)ka[s_]; asm volatile("" : "+v"(a_)); \
        const LAS char* kp_ = (const LAS char*)a_; kf0[s_] = *(const LAS bf16x8*)kp_; kf1[s_] = *(const LAS bf16x8*)(kp_ + 32 * GG::KROWB); } } while (0)
#define FR_QKMMA(S0_, S1_) do { const f32x16 z_ = {0.f, 0.f, 0.f, 0.f, 0.f, 0.f, 0.f, 0.f, 0.f, 0.f, 0.f, 0.f, 0.f, 0.f, 0.f, 0.f}; \
        S0_ = __builtin_amdgcn_mfma_f32_32x32x16_bf16(kf0[0], qf[0], z_, 0, 0, 0); S1_ = __builtin_amdgcn_mfma_f32_32x32x16_bf16(kf1[0], qf[0], z_, 0, 0, 0); \
        _Pragma("unroll") for (int s_ = 1; s_ < KS; ++s_) { S0_ = __builtin_amdgcn_mfma_f32_32x32x16_bf16(kf0[s_], qf[s_], S0_, 0, 0, 0); S1_ = __builtin_amdgcn_mfma_f32_32x32x16_bf16(kf1[s_], qf[s_], S1_, 0, 0, 0); } \
        if constexpr (ALIBI) { S0_ = __builtin_amdgcn_mfma_f32_32x32x16_bf16(kx0, qx, S0_, 0, 0, 0); S1_ = __builtin_amdgcn_mfma_f32_32x32x16_bf16(kx1, qx, S1_, 0, 0, 0); } } while (0)
    FR_ISSUE_K(0); if constexpr (KPRE) FR_ISSUE_K(1); FR_ISSUE_V(0);
    FR_ISSUE_K(1 + KA); FR_ISSUE_V(1);
    if constexpr (PK + PV == 2) FR_WAITBAR(2); else FR_WAITBAR(3);
    int i = 0;
    if (KPRE && iskip == 0) FR_KLOAD(0);
    for (; i < iskip; ++i) { FR_ISSUE(i); if (KPRE && i == iskip - 1) FR_KLOAD(i + 1); FR_END(i); }
    f32x16 sc0, sc1;
#define FR_TILE(CHK) do { FR_ISSUE(i); bf16x8 pa[4], vf[2][4]; const float d0f = (float)(t - 64 * (nt - 1 - i)); \
        if constexpr (!KPRE) { FR_KLOAD(i); } \
        if constexpr (VAR != 3 && VAR != 5) FR_QKMMA(sc0, sc1); \
        if constexpr (DV == 64 && VAR != 2 && VAR != 5) { fa::v_load<DV>(FR_VSLOT(i), lane, 0, vf); __builtin_amdgcn_sched_barrier(0); } \
        if constexpr (CHK || (VAR != 1 && VAR != 5)) soft_tile<ALIBI, CHK, NDV>(sc0, sc1, c1, slope2, d0f, hb, m, l, o, pa); else fa::pack_p(sc0, sc1, pa); \
        if constexpr (KPRE) { if (i + 1 < nt) FR_KLOAD(i + 1); __builtin_amdgcn_sched_barrier(0); } \
        if constexpr (!CHK && (VAR == 2 || VAR == 5)) { o[0][0] += __builtin_bit_cast(float, (int)pa[0][0] + (int)pa[1][1] + (int)pa[2][2] + (int)pa[3][3]); } else { \
        _Pragma("unroll") for (int d0 = 0; d0 < NDV; d0 += 2) { if (DV != 64 || d0 != 0) { fa::v_load<DV>(FR_VSLOT(i), lane, d0, vf); __builtin_amdgcn_sched_barrier(0); } fa::pv_mma(vf, pa, o[d0], o[d0 + 1]); } } \
        FR_END(i); } while (0)
    FR_TILE(true); ++i;
    for (; i < nt; ++i) FR_TILE(false);
#undef FR_TILE
#undef FR_KLOAD
#undef FR_QKMMA
#undef FR_ISSUE_K
#undef FR_ISSUE_V
#undef FR_ISSUE
#undef FR_END
#undef FR_KSLOT
#undef FR_VSLOT
}

#define FP_SBAR() __builtin_amdgcn_sched_barrier(0)
#define FP_PIN(x) asm volatile("" : "+v"(x))
#define FP_MFMA(a_, b_, c_) __builtin_amdgcn_mfma_f32_32x32x16_bf16(a_, b_, c_, 0, 0, 0)
template <int DQK, int DV, bool ALIBI, bool FILLB, class QL>
__device__ __forceinline__ void flash_pipe(LAS char* lds, const char* kbase, const char* vbase, const int strideB, const QL& qload, f32x16 (&o)[DV / 32], float& l_out,
                                           const int q0, const int wq0, const int t, const float slope2, const int wid, const int lane) {
    typedef Geo<DQK, DV> GG;
    constexpr int PK = GG::PK, PV = GG::PV, NDV = DV / 32, KS = DQK / 16, NGA = 2 * KS + (ALIBI ? 2 : 0), NGB = 4 * NDV, VSTR = DV * 2;
    static_assert(PK + PV == 3, "wait counts below assume three DMA pieces per wave and step");
    constexpr float THR = 8.f;
    constexpr int KL = FP_KL, VL = FP_VL, NPRE = FP_NPRE;
    const int r32 = lane & 31, hb = lane >> 5;
    const int nt = (q0 + 256) >> 6, tmax = (wq0 + 31) >> 6, iskip = nt - 1 - tmax;
    unsigned voK[PK], voV[PV];
    k_offsets<DQK>(voK, wid, lane, strideB); v_offsets<DV>(voV, wid, lane, strideB);
    int ka[KS];
    { const int f = (DQK == 64) ? ((r32 >> 1) & 7) : (r32 & 15);
#pragma unroll
      for (int s = 0; s < KS; ++s) ka[s] = r32 * GG::KROWB + (((2 * s + hb) ^ f) << 4); }
    int va[NDV];
    { const int g16 = lane >> 4, i16 = lane & 15, q = i16 >> 2, p = i16 & 3; const int f = (DV == 64) ? ((q >> 1) & 1) : q; const int rowb = (4 * hb + q) * VSTR + 2 * (16 * (g16 & 1) + 4 * p);
#pragma unroll
      for (int d = 0; d < NDV; ++d) va[d] = rowb + ((d ^ f) << 6); }
    const unsigned ldsu = (unsigned)(uintptr_t)lds, ldsb = ldsu + (unsigned)wid * 1024u;
    bf16x8 kx0 = {0, 0, 0, 0, 0, 0, 0, 0}, kx1 = {0, 0, 0, 0, 0, 0, 0, 0}, qx = {0, 0, 0, 0, 0, 0, 0, 0};
    if constexpr (ALIBI) { if (hb == 0) { const short a0 = (short)f2bf((float)r32), a1 = (short)f2bf((float)(r32 + 32)); kx0[0] = a0; kx0[1] = a0; kx1[0] = a1; kx1[1] = a1;
        float sl_ = slope2; asm volatile("" : "+v"(sl_));
        const unsigned hi = f2bf(sl_); const float lo = sl_ - __uint_as_float(hi << 16); qx[0] = (short)hi; qx[1] = (short)f2bf(lo); } }
#define FP_ISSUE_K(it) do { const int it_ = (it); const char* b_ = kbase + (size_t)(nt - 1 - it_) * 64 * strideB; const unsigned d_ = ldsb + GG::KBASE + (unsigned)(it_ % 3) * GG::KSLOT; \
        _Pragma("unroll") for (int j_ = 0; j_ < PK; ++j_) pg8::glds16_s(b_, voK[j_], d_ + j_ * 8192); } while (0)
#define FP_ISSUE_V(it) do { const int it_ = (it); const char* b_ = vbase + (size_t)(nt - 1 - it_) * 64 * strideB; const unsigned d_ = ldsb + GG::VBASE + (unsigned)(it_ & 3) * GG::VSLOT; \
        _Pragma("unroll") for (int j_ = 0; j_ < PV; ++j_) pg8::glds16_s(b_, voV[j_], d_ + j_ * 8192); } while (0)
#define FP_ISSUE(i_) do { if ((i_) + 2 < nt) FP_ISSUE_K((i_) + 2); if ((i_) + 1 < nt) FP_ISSUE_V((i_) + 1); } while (0)
#define FP_END(i_) do { if ((i_) + 2 < nt) FR_WAITBAR(3); else if ((i_) + 1 < nt) { if constexpr (PV == 1) FR_WAITBAR(1); else FR_WAITBAR(2); } else FR_WAITBAR(0); } while (0)
#define FP_KRD(s_) do { unsigned a_ = kl_ + (unsigned)ka[s_]; asm volatile("" : "+v"(a_)); const LAS char* kp_ = (const LAS char*)a_; \
        kf0[s_] = *(const LAS bf16x8*)kp_; kf1[s_] = *(const LAS bf16x8*)(kp_ + 32 * GG::KROWB); } while (0)
#define FP_KRD1(g_) do { const LAS char* kp_ = (const LAS char*)(kl_ + (unsigned)ka[(g_) >> 1]); if (((g_) & 1) == 0) kf0[(g_) >> 1] = *(const LAS bf16x8*)kp_; else kf1[(g_) >> 1] = *(const LAS bf16x8*)(kp_ + 32 * GG::KROWB); } while (0)
#define FP_VD(j_) (NDV == 2 ? ((j_) & 1) : ((((j_) >> 3) * 2) + ((j_) & 1)))
#define FP_VKS(j_) (((j_) & 7) >> 1)
#define FP_VRD(j_) do { const LAS char* vb_ = (const LAS char*)vba[FP_VD(j_)]; vlo[j_] = fa::vtr(vb_ + (16 * FP_VKS(j_)) * VSTR); vhi[j_] = fa::vtr(vb_ + (16 * FP_VKS(j_) + 8) * VSTR); } while (0)
#define FP_VFR(j_) (bf16x8){vlo[j_][0], vlo[j_][1], vlo[j_][2], vlo[j_][3], vhi[j_][0], vhi[j_][1], vhi[j_][2], vhi[j_][3]}
#define FP_FILL(P0_, P1_, u_) do { const float x_ = ((u_) < 8) ? P0_[2 * ((u_) & 7)] : P1_[2 * ((u_) & 7)], y_ = ((u_) < 8) ? P0_[2 * ((u_) & 7) + 1] : P1_[2 * ((u_) & 7) + 1]; \
        sa += x_; FP_PIN(sa); sb += y_; FP_PIN(sb); pw[(u_) >> 2][(u_) & 3] = pk2(x_, y_); FP_PIN(pw[(u_) >> 2]); } while (0)
    const f32x16 z16 = {0.f, 0.f, 0.f, 0.f, 0.f, 0.f, 0.f, 0.f, 0.f, 0.f, 0.f, 0.f, 0.f, 0.f, 0.f, 0.f};
    FP_ISSUE_K(0); FP_ISSUE_K(1); FP_ISSUE_V(0);
    bf16x8 qf[KS]; qload(qf);
    FR_WAITBAR(3);
    int i = 0;
    for (; i < iskip; ++i) { FP_ISSUE(i); FP_END(i); }
    f32x16 pA0, pA1, pB0, pB1;
    float mhat, lsum = 0.f, fres = 1.f, subc = 0.f; bool resc = false;
    f32x16 cinit = z16;
    u32x4 pw[4] = {{0u, 0u, 0u, 0u}, {0u, 0u, 0u, 0u}, {0u, 0u, 0u, 0u}, {0u, 0u, 0u, 0u}}; s16x4 vlo[NGB], vhi[NGB]; unsigned vba[NDV];
#pragma unroll
    for (int j = 0; j < NGB; ++j) { vlo[j] = (s16x4){0, 0, 0, 0}; vhi[j] = (s16x4){0, 0, 0, 0}; }
#pragma unroll
    for (int d = 0; d < NDV; ++d) vba[d] = 0u;
#define FP_TB(k_) unsigned long long tb##k_ = 0ull; if (PROBE_STAMP == 200 + (k_) && wid == PROBE_WAVE) tb##k_ = __builtin_amdgcn_s_memrealtime()
#define FP_TE(k_) do { if (PROBE_STAMP == 200 + (k_) && wid == PROBE_WAVE) { const unsigned long long te_ = __builtin_amdgcn_s_memrealtime(); if (lane == 0) *(volatile LAS unsigned*)(lds + 131072 + 800) += (unsigned)(te_ - tb##k_); } } while (0)
#define FP_DIAG(DOEXP) do { FP_ISSUE(i); \
        const unsigned kl_ = ldsu + GG::KBASE + (unsigned)(i % 3) * GG::KSLOT; \
        bf16x8 kf0[KS], kf1[KS]; \
        _Pragma("unroll") for (int s = 0; s < KS; ++s) FP_KRD(s); \
        FP_SBAR(); \
        pA0 = FP_MFMA(kf0[0], qf[0], z16); pA1 = FP_MFMA(kf1[0], qf[0], z16); \
        _Pragma("unroll") for (int s = 1; s < KS; ++s) { pA0 = FP_MFMA(kf0[s], qf[s], pA0); pA1 = FP_MFMA(kf1[s], qf[s], pA1); } \
        if constexpr (ALIBI) { pA0 = FP_MFMA(kx0, qx, pA0); pA1 = FP_MFMA(kx1, qx, pA1); } \
        const float d0f = (float)(t - 64 * (nt - 1 - i)), E = ALIBI ? -slope2 * d0f : 0.f, dh = d0f - (float)(4 * hb); \
        _Pragma("unroll") for (int k = 0; k < 16; ++k) { const float ci = (float)((k & 3) + 8 * (k >> 2)); if (ci > dh) pA0[k] = fa::NEG; if (ci + 32.f > dh) pA1[k] = fa::NEG; } \
        mhat = fa::tile_max(pA0, pA1) + E; subc = mhat - E; \
        if constexpr (!ALIBI) { _Pragma("unroll") for (int k_ = 0; k_ < 16; ++k_) cinit[k_] = -mhat; } \
        if (DOEXP) { _Pragma("unroll") for (int k = 0; k < 16; ++k) { pA0[k] = fexp2(pA0[k] - subc); pA1[k] = fexp2(pA1[k] - subc); } } \
        if constexpr (FILLB) { float sa = 0.f, sb = 0.f; _Pragma("unroll") for (int u_ = 0; u_ < 16; ++u_) FP_FILL(pA0, pA1, u_); lsum += sa + sb; } \
        FP_END(i); ++i; } while (0)
#define FP_PHA(C0, C1, P0, P1, it, DOISSUE) do { const int i_ = (it); \
        const unsigned kl_ = ldsu + GG::KBASE + (unsigned)(i_ % 3) * GG::KSLOT; \
        { const unsigned vl_ = ldsu + GG::VBASE + (unsigned)((i_ - 1) & 3) * GG::VSLOT; _Pragma("unroll") for (int d_ = 0; d_ < NDV; ++d_) { vba[d_] = vl_ + (unsigned)va[d_]; asm volatile("" : "+v"(vba[d_])); } } \
        bf16x8 kf0[KS], kf1[KS]; float sa = 0.f, sb = 0.f; \
        if constexpr (ALIBI) { float ci_ = -slope2 * (float)(t - 64 * (nt - 1 - i_)) - mhat; _Pragma("unroll") for (int k_ = 0; k_ < 16; ++k_) cinit[k_] = ci_; } \
        _Pragma("unroll") for (int g_ = 0; g_ < KL; ++g_) FP_KRD1(g_); \
        FP_SBAR(); \
        if (DOISSUE) FP_ISSUE(i_);                                                 \
        if constexpr (!FILLB) { _Pragma("unroll") for (int u_ = 0; u_ < NPRE; ++u_) FP_FILL(P0, P1, u_); } \
        FP_SBAR(); \
        _Pragma("unroll") for (int g_ = 0; g_ < NGA; ++g_) { const int s_ = g_ >> 1, sc_ = s_ < KS ? s_ : 0; \
            if (g_ + KL < 2 * KS) FP_KRD1(g_ + KL); \
            if (g_ >= NGA - VL) FP_VRD(g_ - (NGA - VL)); \
            FP_SBAR(); \
            if (s_ < KS) { if ((g_ & 1) == 0) C0 = FP_MFMA(kf0[sc_], qf[sc_], (s_ == 0) ? cinit : C0); else C1 = FP_MFMA(kf1[sc_], qf[sc_], (s_ == 0) ? cinit : C1); } \
            else { if ((g_ & 1) == 0) C0 = FP_MFMA(kx0, qx, C0); else C1 = FP_MFMA(kx1, qx, C1); } \
            if constexpr (!FILLB) { _Pragma("unroll") for (int u_ = NPRE + (g_ * (16 - NPRE)) / NGA; u_ < NPRE + ((g_ + 1) * (16 - NPRE)) / NGA; ++u_) FP_FILL(P0, P1, u_); } \
            FP_SBAR(); } \
        lsum += sa + sb; } while (0)
#define FP_PHM(C0, C1, it) do { resc = false; \
        const float dh_ = fa::tile_max_half(C0, C1);                               \
        if (__builtin_amdgcn_ballot_w64(dh_ > THR) != 0ull) { const float gr_ = fmaxf(hmax(dh_), 0.f); mhat += gr_; fres = fexp2(-gr_); lsum *= fres; resc = true; \
            _Pragma("unroll") for (int k_ = 0; k_ < 16; ++k_) { C0[k_] -= gr_; C1[k_] -= gr_; } \
            if constexpr (!ALIBI) { _Pragma("unroll") for (int k_ = 0; k_ < 16; ++k_) cinit[k_] = -mhat; } } } while (0)
#define FP_PHB(C0, C1, DOPV) do { bf16x8 pa_[4]; _Pragma("unroll") for (int k_ = 0; k_ < 4; ++k_) pa_[k_] = __builtin_bit_cast(bf16x8, pw[k_]); \
        FP_SBAR(); \
        _Pragma("unroll") for (int j_ = 0; j_ < NGB; ++j_) { \
            if (DOPV && j_ + VL < NGB) FP_VRD(j_ + VL); \
            FP_SBAR(); \
            if (DOPV) o[FP_VD(j_)] = FP_MFMA(FP_VFR(j_), pa_[FP_VKS(j_)], o[FP_VD(j_)]); \
            _Pragma("unroll") for (int e_ = (j_ * 32) / NGB; e_ < ((j_ + 1) * 32) / NGB; ++e_) { if (e_ < 16) C0[e_ & 15] = fexp2(DOPV ? C0[e_ & 15] : C0[e_ & 15] - subc); else C1[e_ & 15] = fexp2(DOPV ? C1[e_ & 15] : C1[e_ & 15] - subc); } \
            if (((j_ * 32) / NGB) < 16) FP_PIN(C0); else FP_PIN(C1); \
            FP_SBAR(); } \
        if constexpr (FILLB) { float sa = 0.f, sb = 0.f; _Pragma("unroll") for (int u_ = 0; u_ < 16; ++u_) FP_FILL(C0, C1, u_); lsum += sa + sb; } } while (0)
#define FP_RESC() do { if (resc) { _Pragma("unroll") for (int d_ = 0; d_ < NDV; ++d_) o[d_] = o[d_] * fres; } } while (0)
#define FP_DRAIN(P0, P1) do { float sa = 0.f, sb = 0.f; _Pragma("unroll") for (int k_ = 0; k_ < 16; ++k_) { sa += P0[k_]; sb += P1[k_]; } lsum += sa + sb; \
        bf16x8 pa_[4]; fa::pack_p(P0, P1, pa_); const LAS char* vl_ = lds + GG::VBASE + ((nt - 1) & 3) * GG::VSLOT; \
        _Pragma("unroll") for (int d0_ = 0; d0_ < NDV; d0_ += 2) { bf16x8 vf_[2][4]; fa::v_load<DV>(vl_, lane, d0_, vf_); FP_SBAR(); fa::pv_mma(vf_, pa_, o[d0_], o[d0_ + 1]); } } while (0)
    if (!FP_ROT || FILLB || wid < 4) {
#define FP_STEP(C0, C1, P0, P1, it) do { FP_TB(4); FP_TB(1); FP_PHA(C0, C1, P0, P1, it, true); FP_TE(1); FP_PHM(C0, C1, it); FP_TB(3); FP_PHB(C0, C1, true); FP_TE(3); FP_TB(0); FP_END(it); FP_TE(0); FP_TE(4); FP_RESC(); } while (0)
        FP_DIAG(true);
        if constexpr (FILLB) {
            for (; i < nt; ++i) FP_STEP(pA0, pA1, pA0, pA1, i);
            bf16x8 pa_[4];
#pragma unroll
            for (int k_ = 0; k_ < 4; ++k_) pa_[k_] = __builtin_bit_cast(bf16x8, pw[k_]);
            const LAS char* vl_ = lds + GG::VBASE + ((nt - 1) & 3) * GG::VSLOT;
#pragma unroll
            for (int d0_ = 0; d0_ < NDV; d0_ += 2) { bf16x8 vf_[2][4]; fa::v_load<DV>(vl_, lane, d0_, vf_); FP_SBAR(); fa::pv_mma(vf_, pa_, o[d0_], o[d0_ + 1]); }
        } else {
        for (; i + 1 < nt; i += 2) { FP_STEP(pB0, pB1, pA0, pA1, i); FP_STEP(pA0, pA1, pB0, pB1, i + 1); }
        if (i < nt) { FP_STEP(pB0, pB1, pA0, pA1, i); FP_DRAIN(pB0, pB1); } else { FP_DRAIN(pA0, pA1); }
        }
#undef FP_STEP
    } else {
#define FP_STEPY(X0, X1, N0, N1, it, DOPV) do { FP_TB(4); FP_ISSUE(it); FP_TB(3); FP_PHB(X0, X1, DOPV); FP_TE(3); FP_RESC(); FP_TB(1); FP_PHA(N0, N1, X0, X1, it, false); FP_TE(1); FP_PHM(N0, N1, it); FP_TB(0); FP_END(it); FP_TE(0); FP_TE(4); } while (0)
        FP_DIAG(false);
        FP_STEPY(pA0, pA1, pB0, pB1, i, false); ++i;
        for (; i + 1 < nt; i += 2) { FP_STEPY(pB0, pB1, pA0, pA1, i, true); FP_STEPY(pA0, pA1, pB0, pB1, i + 1, true); }
        if (i < nt) { FP_STEPY(pB0, pB1, pA0, pA1, i, true); FP_PHB(pA0, pA1, true); FP_RESC(); FP_DRAIN(pA0, pA1); }
        else { FP_PHB(pB0, pB1, true); FP_RESC(); FP_DRAIN(pB0, pB1); }
#undef FP_STEPY
    }
    l_out = hsum(lsum);
    asm volatile("s_waitcnt lgkmcnt(0)\n\ts_barrier" ::: "memory");
#undef FP_DIAG
#undef FP_PHA
#undef FP_PHM
#undef FP_PHB
#undef FP_RESC
#undef FP_TB
#undef FP_TE
#undef FP_DRAIN
#undef FP_FILL
#undef FP_VFR
#undef FP_VRD
#undef FP_VKS
#undef FP_VD
#undef FP_KRD
#undef FP_END
#undef FP_ISSUE
#undef FP_ISSUE_V
#undef FP_ISSUE_K
}
}

struct QLoadDiff { const bf16* qp; float c1;
    __device__ __forceinline__ void operator()(bf16x8 (&qf)[4]) const {
#pragma unroll
        for (int s = 0; s < 4; ++s) { const u32x4 w = *(const u32x4*)(qp + 16 * s); u32x4 r;
            r.x = pk2(bflo(w.x) * c1, bfhi(w.x) * c1); r.y = pk2(bflo(w.y) * c1, bfhi(w.y) * c1); r.z = pk2(bflo(w.z) * c1, bfhi(w.z) * c1); r.w = pk2(bflo(w.w) * c1, bfhi(w.w) * c1);
            qf[s] = __builtin_bit_cast(bf16x8, r); } } };
struct QLoadMla { const bf16* qp; const float* rsqp;
    __device__ __forceinline__ void operator()(bf16x8 (&qf)[6]) const {
#pragma unroll
        for (int s = 0; s < 6; ++s) qf[s] = *(const bf16x8*)(qp + 16 * s);
        const float c1 = 0.10206207261596575f * LOG2E * rsqp[0];
#pragma unroll
        for (int s = 0; s < 6; ++s) { const u32x4 w = __builtin_bit_cast(u32x4, qf[s]); u32x4 r;
            r.x = pk2(bflo(w.x) * c1, bfhi(w.x) * c1); r.y = pk2(bflo(w.y) * c1, bfhi(w.y) * c1); r.z = pk2(bflo(w.z) * c1, bfhi(w.z) * c1); r.w = pk2(bflo(w.w) * c1, bfhi(w.w) * c1);
            qf[s] = __builtin_bit_cast(bf16x8, r); } } };
__device__ __forceinline__ void diff_unit(LAS char* lds, int b, int h, int qt, bf16* P, float lam, float lam_init, const float* subg, bf16* scratch, int wid, bool dry = false) {
    const int lane = lane_id_v(), r32 = lane & 31, hb = lane >> 5;
    const int q0 = 256 * qt, wq0 = q0 + 32 * wid, t = wq0 + r32;
    bf16* prow = P + ((size_t)b * S + t) * PW;
    const char* pb = (const char*)(P + (size_t)b * S * PW);
    const float slope2 = alibi_slope(8 + h) * LOG2E, c1 = 0.125f * LOG2E;
    u32x4* o1g = (u32x4*)scratch + wid * 64 + lane;
    f32x16 o[4]; float m = 0.f, l = 0.f;
    for (int map = 0; map < 2; ++map) {
        const QLoadDiff ql{prow + PC_DQ + h * 128 + map * 64 + 8 * hb, c1};
#pragma unroll
        for (int d = 0; d < 4; ++d)
#pragma unroll
            for (int i = 0; i < 16; ++i) o[d][i] = 0.f;
        m = fa::NEG; l = 0.f;
        if constexpr ((USE_PIPE & 2) != 0) fr::flash_pipe<64, 128, true, true>(lds, pb + (PC_DK + h * 128 + map * 64) * 2, pb + (PC_DV + h * 128) * 2, PW * 2, ql, o, l, q0, wq0, t, slope2, wid, lane);
        else { bf16x8 qf[4]; ql(qf); fr::flash_ring<64, 128, true, DIFF_PIPE>(lds, pb + (PC_DK + h * 128 + map * 64) * 2, pb + (PC_DV + h * 128) * 2, PW * 2, qf, o, m, l, q0, wq0, t, c1, slope2, wid, lane); }
        if (map == 0) { const float inv = 1.f / l;
#pragma unroll
            for (int d = 0; d < 4; ++d)
#pragma unroll
                for (int k = 0; k < 2; ++k) { u32x4 w; w.x = pk2(o[d][8 * k] * inv, o[d][8 * k + 1] * inv); w.y = pk2(o[d][8 * k + 2] * inv, o[d][8 * k + 3] * inv);
                    w.z = pk2(o[d][8 * k + 4] * inv, o[d][8 * k + 5] * inv); w.w = pk2(o[d][8 * k + 6] * inv, o[d][8 * k + 7] * inv); o1g[512 * (2 * d + k)] = w; } }
    }
    const float inv2 = lam / l; float ss = 0.f;
#pragma unroll
    for (int d = 0; d < 4; ++d)
#pragma unroll
        for (int k = 0; k < 2; ++k) { u32x4 w;
            { const unsigned long long* p64 = (const unsigned long long*)(o1g + 512 * (2 * d + k));
              const unsigned long long x0 = __hip_atomic_load(p64, __ATOMIC_RELAXED, __HIP_MEMORY_SCOPE_AGENT), x1 = __hip_atomic_load(p64 + 1, __ATOMIC_RELAXED, __HIP_MEMORY_SCOPE_AGENT);
              w.x = (unsigned)x0; w.y = (unsigned)(x0 >> 32); w.z = (unsigned)x1; w.w = (unsigned)(x1 >> 32); }
            const float a0 = bflo(w.x) - o[d][8 * k] * inv2, a1 = bfhi(w.x) - o[d][8 * k + 1] * inv2, a2 = bflo(w.y) - o[d][8 * k + 2] * inv2, a3 = bfhi(w.y) - o[d][8 * k + 3] * inv2;
            const float a4 = bflo(w.z) - o[d][8 * k + 4] * inv2, a5 = bfhi(w.z) - o[d][8 * k + 5] * inv2, a6 = bflo(w.w) - o[d][8 * k + 6] * inv2, a7 = bfhi(w.w) - o[d][8 * k + 7] * inv2;
            o[d][8 * k] = a0; o[d][8 * k + 1] = a1; o[d][8 * k + 2] = a2; o[d][8 * k + 3] = a3; o[d][8 * k + 4] = a4; o[d][8 * k + 5] = a5; o[d][8 * k + 6] = a6; o[d][8 * k + 7] = a7;
            ss += (a0 * a0 + a1 * a1) + (a2 * a2 + a3 * a3) + (a4 * a4 + a5 * a5) + (a6 * a6 + a7 * a7); }
    ss = hsum(ss);
    const float rs = __builtin_amdgcn_rsqf(ss * (1.f / 128.f) + 1e-6f) * (1.f - lam_init);
#pragma unroll
    for (int d = 0; d < 4; ++d)
#pragma unroll
        for (int k = 0; k < 4; ++k) { const int dv = 32 * d + 8 * k + 4 * hb; const f32x4 g = *(const f32x4*)(subg + dv);
            u32x2 w; w.x = pk2(o[d][4 * k] * rs * g[0], o[d][4 * k + 1] * rs * g[1]); w.y = pk2(o[d][4 * k + 2] * rs * g[2], o[d][4 * k + 3] * rs * g[3]);
            if (!dry) *(u32x2*)(prow + PC_DQ + h * 128 + dv) = w; }
}

constexpr int KVW = 1280;
__device__ __forceinline__ void mla_unit(LAS char* lds, int b, int h, int qt, bf16* QM, const bf16* KVM, const float* rsq, int wid, bool dry = false) {
    const int lane = lane_id_v(), r32 = lane & 31, hb = lane >> 5;
    const int q0 = 256 * qt, wq0 = q0 + 32 * wid, t = wq0 + r32; const size_t mrow = (size_t)b * S + t;
    bf16* qrow = QM + mrow * 768 + h * 96;
    const QLoadMla ql{qrow + 8 * hb, rsq + mrow};
    const char* kb = (const char*)(KVM + (size_t)b * S * KVW + h * 160);
    f32x16 o[2];
#pragma unroll
    for (int d = 0; d < 2; ++d)
#pragma unroll
        for (int i = 0; i < 16; ++i) o[d][i] = 0.f;
    float m = fa::NEG, l = 0.f;
    if constexpr ((USE_PIPE & 1) != 0) fr::flash_pipe<96, 64, false, true>(lds, kb, kb + 192, KVW * 2, ql, o, l, q0, wq0, t, 0.f, wid, lane);
    else { bf16x8 qf[6]; ql(qf); const float c1 = 0.10206207261596575f * LOG2E * rsq[mrow]; fr::flash_ring<96, 64, false, MLA_PIPE>(lds, kb, kb + 192, KVW * 2, qf, o, m, l, q0, wq0, t, c1, 0.f, wid, lane); }
    const float inv = 1.f / l;
#pragma unroll
    for (int d = 0; d < 2; ++d)
#pragma unroll
        for (int k = 0; k < 4; ++k) { u32x2 w; w.x = pk2(o[d][4 * k] * inv, o[d][4 * k + 1] * inv); w.y = pk2(o[d][4 * k + 2] * inv, o[d][4 * k + 3] * inv);
            if (!dry) *(u32x2*)(qrow + 32 * d + 8 * k + 4 * hb) = w; }
}

template <int MODE, bool INIT>
__device__ __forceinline__ void nsa_tile(const LAS char* kl, const LAS char* vl, const bf16x8 (&qs)[4], const bf16x8& kx0, const bf16x8& kx1, const bf16x8& qx,
                                         const float slope2, const float d0, const bool lanevalid, float& mhat, float& lsum, f32x16 (&o)[2], const int lane) {
    const int r32 = lane & 31, hb = lane >> 5;
    const float E = -slope2 * d0;
    const LAS char* kp = kl + r32 * 144 + hb * 16;
    bf16x8 k0[4], k1[4];
#pragma unroll
    for (int s = 0; s < 4; ++s) { k0[s] = *(const LAS bf16x8*)(kp + s * 32); k1[s] = *(const LAS bf16x8*)(kp + 32 * 144 + s * 32); }
    __builtin_amdgcn_sched_barrier(0);
    f32x16 cin; { const float ci = INIT ? 0.f : (lanevalid ? E - mhat : -1.0e30f);
#pragma unroll
        for (int k = 0; k < 16; ++k) cin[k] = ci; }
    f32x16 c0 = __builtin_amdgcn_mfma_f32_32x32x16_bf16(k0[0], qs[0], cin, 0, 0, 0), c1 = __builtin_amdgcn_mfma_f32_32x32x16_bf16(k1[0], qs[0], cin, 0, 0, 0);
#pragma unroll
    for (int s = 1; s < 4; ++s) { c0 = __builtin_amdgcn_mfma_f32_32x32x16_bf16(k0[s], qs[s], c0, 0, 0, 0); c1 = __builtin_amdgcn_mfma_f32_32x32x16_bf16(k1[s], qs[s], c1, 0, 0, 0); }
    c0 = __builtin_amdgcn_mfma_f32_32x32x16_bf16(kx0, qx, c0, 0, 0, 0); c1 = __builtin_amdgcn_mfma_f32_32x32x16_bf16(kx1, qx, c1, 0, 0, 0);
    if constexpr (MODE != 0) { const float dh = d0 - (float)(4 * hb);
#pragma unroll
        for (int k = 0; k < 16; ++k) { const float ck = (float)((k & 3) + 8 * (k >> 2));
            if constexpr (MODE == 1) { if (ck > dh) c0[k] = fa::NEG; if (ck + 32.f > dh) c1[k] = fa::NEG; }
            else { if (ck <= dh - 512.f) c0[k] = fa::NEG; if (ck + 32.f <= dh - 512.f) c1[k] = fa::NEG; } } }
    if constexpr (INIT) { mhat = fa::tile_max(c0, c1) + E; const float sub = mhat - E;
#pragma unroll
        for (int k = 0; k < 16; ++k) { c0[k] = fexp2(c0[k] - sub); c1[k] = fexp2(c1[k] - sub); } }
    else { const float dh_ = fa::tile_max_half(c0, c1);
        if (__builtin_amdgcn_ballot_w64(dh_ > 8.f) != 0ull) { const float gr = fmaxf(hmax(dh_), 0.f); mhat += gr; const float f = fexp2(-gr); lsum *= f; o[0] = o[0] * f; o[1] = o[1] * f;
#pragma unroll
            for (int k = 0; k < 16; ++k) { c0[k] -= gr; c1[k] -= gr; } }
#pragma unroll
        for (int k = 0; k < 16; ++k) { c0[k] = fexp2(c0[k]); c1[k] = fexp2(c1[k]); } }
    float ra = 0.f, rb = 0.f;
#pragma unroll
    for (int k = 0; k < 16; ++k) { ra += c0[k]; asm volatile("" : "+v"(ra)); rb += c1[k]; asm volatile("" : "+v"(rb)); }
    lsum += ra + rb;
    bf16x8 pa[4]; fa::pack_p(c0, c1, pa);
    fa::pv_tile<64>(vl, pa, o, lane);
}

#define LAUNDER(x) asm volatile("" : "+v"(x))
#define NSA_IDS const int lane = lane_id_v(), tid = wid * 64 + lane, r32 = lane & 31, hb = lane >> 5, h4 = r32 >> 3, qi = r32 & 7; (void)h4; (void)qi; (void)hb; (void)r32;
__device__ __forceinline__ void nsa_unit(LAS char* lds, int b, int g, int j, bf16* P, const bf16* KCMP, const bf16* VCMP, int wid, bool dry = false) {
    const int lane = lane_id_v(), r32 = lane & 31, hb = lane >> 5, h4 = r32 >> 3, qi = r32 & 7;
    const int head = 4 * g + h4, t0 = 64 * j, t = t0 + 8 * wid + qi;
    bf16* prow = P + ((size_t)b * S + t) * PW;
    const char* pb = (const char*)(P + (size_t)b * S * PW);
    bf16x8 qf[4];
#pragma unroll
    for (int s = 0; s < 4; ++s) qf[s] = *(const bf16x8*)(prow + PC_NQ + head * 64 + 16 * s + 8 * hb);
    const float slope2 = alibi_slope(head) * LOG2E, c1 = 0.125f * LOG2E;
    const float gc = sigmoidf_(bf2f(prow[PC_NG + head * 3 + 0])), gs = sigmoidf_(bf2f(prow[PC_NG + head * 3 + 1])), gw = sigmoidf_(bf2f(prow[PC_NG + head * 3 + 2]));
    bf16x8 qs[4], kx0 = {0, 0, 0, 0, 0, 0, 0, 0}, kx1 = {0, 0, 0, 0, 0, 0, 0, 0}, qx = {0, 0, 0, 0, 0, 0, 0, 0};
#pragma unroll
    for (int s = 0; s < 4; ++s) { const u32x4 w = __builtin_bit_cast(u32x4, qf[s]); u32x4 r;
        r.x = pk2(bflo(w.x) * c1, bfhi(w.x) * c1); r.y = pk2(bflo(w.y) * c1, bfhi(w.y) * c1); r.z = pk2(bflo(w.z) * c1, bfhi(w.z) * c1); r.w = pk2(bflo(w.w) * c1, bfhi(w.w) * c1);
        qs[s] = __builtin_bit_cast(bf16x8, r); }
    if (hb == 0) { const short a0 = (short)f2bf((float)r32), a1 = (short)f2bf((float)(r32 + 32)); kx0[0] = a0; kx0[1] = a0; kx1[0] = a1; kx1[1] = a1;
        float sl_ = slope2; asm volatile("" : "+v"(sl_));
        const unsigned hi = f2bf(sl_); const float lo = sl_ - __uint_as_float(hi << 16); qx[0] = (short)hi; qx[1] = (short)f2bf(lo); }
    LAS float* sc = (LAS float*)(lds + A_SC + wid * 4096);
    { float z = 0.f; LAUNDER(z);
#pragma unroll
    for (int k = 0; k < 4; ++k) *(LAS f32x4*)(sc + lane * 16 + 4 * k) = (f32x4){z, z, z, z}; }
    f32x16 ob[2];
#pragma unroll
    for (int d = 0; d < 2; ++d)
#pragma unroll
        for (int i = 0; i < 16; ++i) ob[d][i] = 0.f;
#define NSA_TB(k_) unsigned long long ntb##k_ = 0ull; if (PROBE_STAMP == 210 + (k_) && wid == PROBE_WAVE) ntb##k_ = __builtin_amdgcn_s_memrealtime()
#define NSA_TE(k_) do { if (PROBE_STAMP == 210 + (k_) && wid == PROBE_WAVE) { const unsigned long long te_ = __builtin_amdgcn_s_memrealtime(); if (lane_id_v() == 0) *(volatile LAS unsigned*)(lds + 131072 + 800) += (unsigned)(te_ - ntb##k_); } } while (0)
    NSA_TB(0); NSA_TB(4);
    {
        NSA_IDS
        const int ntc = (4 * j + 3 + 63) >> 6;
        Ld64 ld; ld.kp = (const char*)(KCMP + (size_t)(b * 2 + g) * 512 * 64); ld.vp = (const char*)(VCMP + (size_t)(b * 2 + g) * 512 * 64); ld.kstr = 128; ld.vstr = 128;
        float mc = fa::NEG, lc = 0.f;
        Ld64 ld2 = ld;
        ld.issue(0, tid, false); ld.commit(lds, lds + A_VB0, tid, false); __syncthreads();
        ld2.issue(0, tid, true);
        Ld64 ldB = ld;
        if (1 < ntc) ld.issue(64, tid, false);
        if (2 < ntc) ldB.issue(128, tid, false);
        for (int kt = 0; kt < ntc; ++kt) {
            const int buf = kt & 1;
            f32x16 s0, s1; fa::qk_tile<64>(lds + buf * A_KB, qf, s0, s1, r32, hb);
            if (t0 + 8 * wid >= 1024 * kt + 1039) fa::score_tile<false>(s0, s1, (float)(t - 31 - 1024 * kt), 16.f, c1, slope2, 1.0e9f, true, hb);
            else fa::score_tile<true>(s0, s1, (float)(t - 31 - 1024 * kt), 16.f, c1, slope2, 1.0e9f, true, hb);
            (void)fa::softmax_step(s0, s1, mc, lc);
            if (kt & 1) { if (kt + 1 < ntc) ldB.commit(lds + (buf ^ 1) * A_KB, lds + A_VB0, tid, false); }
            else { if (kt + 1 < ntc) ld.commit(lds + (buf ^ 1) * A_KB, lds + A_VB0, tid, false); }
            __syncthreads();
            if (kt & 1) { if (kt + 3 < ntc) ldB.issue(64 * (kt + 3), tid, false); }
            else { if (kt + 3 < ntc) ld.issue(64 * (kt + 3), tid, false); }
        }
        const float inv = (mc > -1.0e29f) ? 1.f / lc : 0.f;
        float carry = 0.f;
        ld2.commit(lds, lds + A_VB0, tid, true); __syncthreads();
        if (1 < ntc) ld.issue(64, tid, true);
        if (2 < ntc) ldB.issue(128, tid, true);
        for (int kt = 0; kt < ntc; ++kt) {
            const int buf = kt & 1;
            f32x16 s0, s1; fa::qk_tile<64>(lds + buf * A_KB, qf, s0, s1, r32, hb);
            if (t0 + 8 * wid >= 1024 * kt + 1039) fa::score_tile<false>(s0, s1, (float)(t - 31 - 1024 * kt), 16.f, c1, slope2, 1.0e9f, true, hb);
            else fa::score_tile<true>(s0, s1, (float)(t - 31 - 1024 * kt), 16.f, c1, slope2, 1.0e9f, true, hb);
#pragma unroll
            for (int i = 0; i < 16; ++i) { s0[i] = fexp2(s0[i] - mc) * inv; s1[i] = fexp2(s1[i] - mc) * inv; }
            { float mainv[8], ps[8];
#pragma unroll
              for (int gq = 0; gq < 8; ++gq) { const int kb = gq >> 2, k = gq & 3;
                  const float p0 = kb ? s1[4 * k] : s0[4 * k], p1 = kb ? s1[4 * k + 1] : s0[4 * k + 1], p2 = kb ? s1[4 * k + 2] : s0[4 * k + 2], p3 = kb ? s1[4 * k + 3] : s0[4 * k + 3];
                  float mv = 2.f * (p0 + p1 + p2) + p3, sv = p3;
                  mv = xsum16(xsum8(mv)); sv = xsum16(xsum8(sv));
                  mainv[gq] = mv;
                  auto rr = __builtin_amdgcn_permlane32_swap(__float_as_uint(sv), __float_as_uint(sv), false, false);
                  ps[gq] = __uint_as_float(hb ? rr[0] : rr[1]); }
#pragma unroll
              for (int gq = 0; gq < 8; ++gq) { const float prev = gq ? ps[gq - 1] : carry; const float fin = mainv[gq] + (hb ? ps[gq] : prev);
                  if (h4 == 0) sc[qi * 128 + 16 * kt + 8 * (gq >> 2) + 2 * (gq & 3) + hb] = fin; }
              carry = ps[7]; }
            bf16x8 pa[4]; fa::pack_p(s0, s1, pa);
            fa::pv_tile<64>(lds + A_VB0 + buf * A_VB, pa, ob, lane);
            if (kt & 1) { if (kt + 1 < ntc) ldB.commit(lds + (buf ^ 1) * A_KB, lds + A_VB0 + (buf ^ 1) * A_VB, tid, true); }
            else { if (kt + 1 < ntc) ld.commit(lds + (buf ^ 1) * A_KB, lds + A_VB0 + (buf ^ 1) * A_VB, tid, true); }
            __syncthreads();
            if (kt & 1) { if (kt + 3 < ntc) ldB.issue(64 * (kt + 3), tid, true); }
            else { if (kt + 3 < ntc) ld.issue(64 * (kt + 3), tid, true); }
        }
#pragma unroll
        for (int d = 0; d < 2; ++d)
#pragma unroll
            for (int i = 0; i < 16; ++i) ob[d][i] = gc * ob[d][i];
    }
    NSA_TE(0); NSA_TB(1);
    Ld64 ldW; ldW.kp = pb + (PC_KW + g * 64) * 2; ldW.vp = pb + (PC_VW + g * 64) * 2; ldW.kstr = PW * 2; ldW.vstr = PW * 2; ldW.rk = (u32x4){0u, 0u, 0u, 0u}; ldW.rv = (u32x4){0u, 0u, 0u, 0u};
    Ld64 ldS0; ldS0.kp = pb + (PC_KS + g * 64) * 2; ldS0.vp = pb + (PC_VS + g * 64) * 2; ldS0.kstr = PW * 2; ldS0.vstr = PW * 2;
    { const int tid_ = wid * 64 + lane_id_v(); ldS0.issue(0, tid_, true); }
    {
        NSA_IDS
        asm volatile("s_waitcnt lgkmcnt(0)" ::: "memory");
        const int qq = lane >> 3, sub = lane & 7, cur = j;
        float v[16];
#pragma unroll
        for (int k = 0; k < 4; ++k) { const f32x4 x = *(const LAS f32x4*)(sc + qq * 128 + 16 * sub + 4 * k); v[4 * k] = x[0]; v[4 * k + 1] = x[1]; v[4 * k + 2] = x[2]; v[4 * k + 3] = x[3]; }
        unsigned bits = 0u;
        if (cur < 16) {
#pragma unroll
            for (int jj = 0; jj < 16; ++jj) if (16 * sub + jj <= cur) bits |= 1u << jj;
        } else {
#pragma unroll
            for (int jj = 0; jj < 16; ++jj) { const int blk = 16 * sub + jj; if (!(blk >= 1 && blk <= cur - 2)) v[jj] = -1.f; }
            for (int round = 0; round < 13; ++round) {
                float bm = v[0]; int bi = 0;
#pragma unroll
                for (int jj = 1; jj < 16; ++jj) if (v[jj] > bm) { bm = v[jj]; bi = jj; }
                int gi = 16 * sub + bi;
                { const float ov = __int_as_float(xl1(__float_as_int(bm))); const int oi = xl1(gi); if (ov > bm || (ov == bm && oi < gi)) { bm = ov; gi = oi; } }
                { const float ov = __int_as_float(xl2(__float_as_int(bm))); const int oi = xl2(gi); if (ov > bm || (ov == bm && oi < gi)) { bm = ov; gi = oi; } }
                { const float ov = __int_as_float(xl4(__float_as_int(bm))); const int oi = xl4(gi); if (ov > bm || (ov == bm && oi < gi)) { bm = ov; gi = oi; } }
                const bool own = (gi >> 4) == sub; const int wj = gi & 15;
#pragma unroll
                for (int jj = 0; jj < 16; ++jj) if (own && jj == wj) { v[jj] = -1.f; bits |= 1u << jj; }
            }
#pragma unroll
            for (int jj = 0; jj < 16; ++jj) { const int blk = 16 * sub + jj; if (blk == 0 || blk == cur || blk == cur - 1) bits |= 1u << jj; }
        }
        ((LAS unsigned short*)(lds + A_SM + wid * 128))[qq * 8 + sub] = (unsigned short)bits;
        unsigned ub = bits; ub |= __shfl_xor(ub, 8); ub |= __shfl_xor(ub, 16); ub |= __shfl_xor(ub, 32);
        if (lane < 8) ((LAS unsigned short*)(lds + A_UN))[wid * 8 + lane] = (unsigned short)ub;
    }
    __syncthreads();
    NSA_TE(1); NSA_TB(2);
    LAS float* otl = (LAS float*)(lds + A_SC + wid * 8192) + lane;
#pragma unroll
    for (int d = 0; d < 2; ++d)
#pragma unroll
        for (int i = 0; i < 16; ++i) { otl[64 * (16 * d + i)] = ob[d][i]; ob[d][i] = 0.f; }
    {
        NSA_IDS
        u32x4 un = (u32x4){0u, 0u, 0u, 0u};
#pragma unroll
        for (int w = 0; w < 8; ++w) { const u32x4 x = *(const LAS u32x4*)(lds + A_UN + w * 16); un.x |= x.x; un.y |= x.y; un.z |= x.z; un.w |= x.w; }
        un.x = __builtin_amdgcn_readfirstlane(un.x); un.y = __builtin_amdgcn_readfirstlane(un.y); un.z = __builtin_amdgcn_readfirstlane(un.z); un.w = __builtin_amdgcn_readfirstlane(un.w);
        u32x4 wv = *(const LAS u32x4*)(lds + A_UN + wid * 16);
        wv.x = __builtin_amdgcn_readfirstlane(wv.x); wv.y = __builtin_amdgcn_readfirstlane(wv.y); wv.z = __builtin_amdgcn_readfirstlane(wv.z); wv.w = __builtin_amdgcn_readfirstlane(wv.w);
        const u32x4 mq = *(const LAS u32x4*)(lds + A_SM + wid * 128 + qi * 16);
        Ld64 ld; ld.kp = pb + (PC_KS + g * 64) * 2; ld.vp = pb + (PC_VS + g * 64) * 2; ld.kstr = PW * 2; ld.vstr = PW * 2;
        float ms = fa::NEG, ls = 0.f;
        Ld64 ldB = ld;
        int blk = next_bit(un, 0), buf = 0;
        ldS0.commit(lds, lds + A_VB0, tid, true); __syncthreads();
        ldW.issue(64 * j, tid, true);
        int nb1 = next_bit(un, blk + 1); if (nb1 < 128) ld.issue(64 * nb1, tid, true);
        int nb2 = nb1 < 128 ? next_bit(un, nb1 + 1) : 128; if (nb2 < 128) ldB.issue(64 * nb2, tid, true);
#define NSA_SEL_STEP(LDX) do { \
            if ((getw(wv, blk >> 5) >> (blk & 31)) & 1u) { \
                const bool lsel = ((getw(mq, blk >> 5) >> (blk & 31)) & 1u) != 0u; \
                const LAS char* kl_ = lds + buf * A_KB; const LAS char* vl_ = lds + A_VB0 + buf * A_VB; const float d0_ = (float)(t - 64 * blk); \
                if (blk == 0) { if (j == 0) nsa_tile<1, true>(kl_, vl_, qs, kx0, kx1, qx, slope2, d0_, true, ms, ls, ob, lane); else nsa_tile<0, true>(kl_, vl_, qs, kx0, kx1, qx, slope2, d0_, true, ms, ls, ob, lane); } \
                else if (blk == j) nsa_tile<1, false>(kl_, vl_, qs, kx0, kx1, qx, slope2, d0_, lsel, ms, ls, ob, lane); \
                else nsa_tile<0, false>(kl_, vl_, qs, kx0, kx1, qx, slope2, d0_, lsel, ms, ls, ob, lane); \
            } \
            if (nb1 < 128) LDX.commit(lds + (buf ^ 1) * A_KB, lds + A_VB0 + (buf ^ 1) * A_VB, tid, true); \
            __syncthreads(); buf ^= 1; blk = nb1; nb1 = nb2; nb2 = nb2 < 128 ? next_bit(un, nb2 + 1) : 128; \
            if (nb2 < 128) LDX.issue(64 * nb2, tid, true); } while (0)
        while (blk < 128) { NSA_SEL_STEP(ld); if (blk >= 128) break; NSA_SEL_STEP(ldB); }
#undef NSA_SEL_STEP
        const float f = gs / hsum(ls);
#pragma unroll
        for (int d = 0; d < 2; ++d)
#pragma unroll
            for (int i = 0; i < 16; ++i) { otl[64 * (16 * d + i)] += f * ob[d][i]; ob[d][i] = 0.f; }
    }
    NSA_TE(2); NSA_TB(3);
    {
        NSA_IDS
        Ld64 ld; ld.kp = pb + (PC_KW + g * 64) * 2; ld.vp = pb + (PC_VW + g * 64) * 2; ld.kstr = PW * 2; ld.vstr = PW * 2;
        float mw = fa::NEG, lw = 0.f;
        const int b0 = j >= 8 ? j - 8 : 0; int buf = 0;
        ldW.commit(lds, lds + A_VB0, tid, true); __syncthreads();
        for (int blk = j; blk >= b0; --blk) {
            if (blk > b0) ld.issue(64 * (blk - 1), tid, true);
            const LAS char* kl_ = lds + buf * A_KB; const LAS char* vl_ = lds + A_VB0 + buf * A_VB; const float d0_ = (float)(t - 64 * blk);
            if (blk == j) nsa_tile<1, true>(kl_, vl_, qs, kx0, kx1, qx, slope2, d0_, true, mw, lw, ob, lane);
            else if (blk == j - 8) nsa_tile<2, false>(kl_, vl_, qs, kx0, kx1, qx, slope2, d0_, true, mw, lw, ob, lane);
            else nsa_tile<0, false>(kl_, vl_, qs, kx0, kx1, qx, slope2, d0_, true, mw, lw, ob, lane);
            if (blk > b0) ld.commit(lds + (buf ^ 1) * A_KB, lds + A_VB0 + (buf ^ 1) * A_VB, tid, true);
            __syncthreads(); buf ^= 1;
        }
        const float f = gw / hsum(lw);
#pragma unroll
        for (int d = 0; d < 2; ++d)
#pragma unroll
            for (int i = 0; i < 16; ++i) ob[d][i] = otl[64 * (16 * d + i)] + f * ob[d][i];
    }
#pragma unroll
    for (int d = 0; d < 2; ++d)
#pragma unroll
        for (int k = 0; k < 4; ++k) { u32x2 w; w.x = pk2(ob[d][4 * k], ob[d][4 * k + 1]); w.y = pk2(ob[d][4 * k + 2], ob[d][4 * k + 3]);
            if (!dry) *(u32x2*)(prow + PC_NQ + head * 64 + 32 * d + 8 * k + 4 * hb) = w; }
    __syncthreads();
    NSA_TE(3); NSA_TE(4);
#undef NSA_TB
#undef NSA_TE
}

__device__ __forceinline__ int srccol(int mode, int n) {
    if (mode == 0) return n;
    if (mode == 3) { mode = 1; n += 3200; }
    if (mode == 1) {
        if (n < 1280) return n;
        if (n < 2816) return n - 1280 + 1304;
        if (n < 3200) return n - 2816 + 2840;
        if (n < 3232) { const int i = n - 3200; return 3224 + (i & 1) * 16 + (i >> 1); }
        if (n < 3256) return 1280 + (n - 3232);
        return -1; }
    { const int h = n / 96, c = n - h * 96; if (c < 64) return n; const int i = c - 64; return h * 96 + 64 + (i & 1) * 16 + (i >> 1); }
}
__device__ __forceinline__ void tconv_item(const float* W, int ldw, const float* kscale, bf16* WT, int K, int N, int mode, int item, LAS float* scr, int lane) {
    const int nblk = N / 32, kb = item / nblk, nb = item - kb * nblk, k0 = 64 * kb, n0 = 32 * nb;
    if (mode == 0 || (mode == 1 && n0 + 31 < 3200)) {
        const int c0 = srccol(mode, n0), kq = lane >> 3, n4 = (lane & 7) * 4;
        f32x4 x[8];
#pragma unroll
        for (int i = 0; i < 8; ++i) x[i] = *(const f32x4*)(W + (size_t)(k0 + kq + 8 * i) * ldw + c0 + n4);
#pragma unroll
        for (int i = 0; i < 8; ++i) { const int kk = kq + 8 * i; const float ksc = kscale ? kscale[k0 + kk] : 1.f; LAS float* d = scr + kk * 33 + n4;
            d[0] = x[i][0] * ksc; d[1] = x[i][1] * ksc; d[2] = x[i][2] * ksc; d[3] = x[i][3] * ksc; }
    } else {
    const int sc = srccol(mode, n0 + (lane & 31));
#pragma unroll 8
    for (int i = 0; i < 32; ++i) { const int kk = 2 * i + (lane >> 5); float x = 0.f; if (sc >= 0) { x = W[(size_t)(k0 + kk) * ldw + sc]; if (kscale) x *= kscale[k0 + kk]; } scr[kk * 33 + (lane & 31)] = x; }
    }
    asm volatile("s_waitcnt lgkmcnt(0)" ::: "memory");
    const int c = lane & 7;
#pragma unroll
    for (int j = 0; j < 4; ++j) { const int n = (lane >> 3) + 8 * j; const LAS float* s = scr + (8 * c) * 33 + n;
        u32x4 o; o.x = pk2(s[0 * 33], s[1 * 33]); o.y = pk2(s[2 * 33], s[3 * 33]); o.z = pk2(s[4 * 33], s[5 * 33]); o.w = pk2(s[6 * 33], s[7 * 33]);
        *(u32x4*)(WT + (size_t)(n0 + n) * K + k0 + 8 * c) = o; }
    asm volatile("s_waitcnt lgkmcnt(0)" ::: "memory");
}
struct TJob { const float* W; bf16* WT; int ldw, K, N, mode, item; };
__device__ __forceinline__ void tconv_load(const TJob& j, f32x4 (&x)[16], int lane) {
    const int nblk = j.N / 64, kb = j.item / nblk, nb = j.item - kb * nblk, k0 = 64 * kb, n0 = 64 * nb;
    const int c0 = srccol(j.mode, n0), kq = lane >> 4, n4 = (lane & 15) * 4;
#pragma unroll
    for (int i = 0; i < 16; ++i) x[i] = *(const f32x4*)(j.W + (size_t)(k0 + 16 * kq + i) * j.ldw + c0 + n4);
}
__device__ __forceinline__ void tconv_finish(const TJob& j, const f32x4 (&x)[16], LAS float* scr, int lane) {
    const int nblk = j.N / 64, kb = j.item / nblk, nb = j.item - kb * nblk, k0 = 64 * kb, n0 = 64 * nb;
    const int kq = lane >> 4, n4 = (lane & 15) * 4; LAS unsigned* sw = (LAS unsigned*)scr;
#pragma unroll
    for (int nn = 0; nn < 4; ++nn) { u32x4 w0, w1;
        w0.x = pk2(x[0][nn], x[1][nn]); w0.y = pk2(x[2][nn], x[3][nn]); w0.z = pk2(x[4][nn], x[5][nn]); w0.w = pk2(x[6][nn], x[7][nn]);
        w1.x = pk2(x[8][nn], x[9][nn]); w1.y = pk2(x[10][nn], x[11][nn]); w1.z = pk2(x[12][nn], x[13][nn]); w1.w = pk2(x[14][nn], x[15][nn]);
        *(LAS u32x4*)(sw + (n4 + nn) * 36 + 8 * kq) = w0; *(LAS u32x4*)(sw + (n4 + nn) * 36 + 8 * kq + 4) = w1; }
    asm volatile("s_waitcnt lgkmcnt(0)" ::: "memory");
    const int c = lane & 7;
#pragma unroll
    for (int q = 0; q < 8; ++q) { const int n = (lane >> 3) + 8 * q; const u32x4 o = *(const LAS u32x4*)(sw + n * 36 + 4 * c);
        *(u32x4*)(j.WT + (size_t)(n0 + n) * j.K + k0 + 8 * c) = o; }
    asm volatile("s_waitcnt lgkmcnt(0)" ::: "memory");
}
#define TCONV_LOOP(NITEMS, DECODE) do { int it_ = gw; if (it_ < (NITEMS)) { TJob cur_; f32x4 xc_[16]; DECODE(it_, cur_); tconv_load(cur_, xc_, lane); \
        for (;;) { const int nit_ = it_ + NGW; const bool hn_ = nit_ < (NITEMS); TJob nx_ = cur_; f32x4 xn_[16]; \
            _Pragma("unroll") for (int q_ = 0; q_ < 16; ++q_) xn_[q_] = xc_[q_]; \
            if (hn_) { DECODE(nit_, nx_); tconv_load(nx_, xn_, lane); } \
            tconv_finish(cur_, xc_, scr, lane); if (!hn_) break; cur_ = nx_; it_ = nit_; \
            _Pragma("unroll") for (int q_ = 0; q_ < 16; ++q_) xc_[q_] = xn_[q_]; } } } while (0)
__device__ __forceinline__ void ln_row(f32x4 (&v)[4], const float* g, const float* b, int lane) {
    float s = 0.f, s2 = 0.f;
#pragma unroll
    for (int j = 0; j < 4; ++j) { s += (v[j][0] + v[j][1]) + (v[j][2] + v[j][3]); s2 += (v[j][0] * v[j][0] + v[j][1] * v[j][1]) + (v[j][2] * v[j][2] + v[j][3] * v[j][3]); }
    s = hsum(xsum16(xsum_lo16(s))); s2 = hsum(xsum16(xsum_lo16(s2)));
    const float mean = s * (1.f / 1024.f); const float var = fmaxf(s2 * (1.f / 1024.f) - mean * mean, 0.f);
    const float rstd = 1.f / sqrtf(var + 1e-5f);
#pragma unroll
    for (int j = 0; j < 4; ++j) { const f32x4 gg = *(const f32x4*)(g + 4 * lane + 256 * j), bb = *(const f32x4*)(b + 4 * lane + 256 * j); v[j] = (v[j] - mean) * rstd * gg + bb; }
}
__device__ __forceinline__ void store_row_bf16(bf16* row, const f32x4 (&v)[4], int lane) {
#pragma unroll
    for (int j = 0; j < 4; ++j) { u32x2 w; w.x = pk2(v[j][0], v[j][1]); w.y = pk2(v[j][2], v[j][3]); *(u32x2*)(row + 4 * lane + 256 * j) = w; }
}

struct InPtrs { const float* const* p; __device__ __forceinline__ const float* operator[](int i) const { return (const float*)(GAS const float*)p[i]; } };
#define PHASE_IDS int wid_l_ = wid_k; asm volatile("" : "+s"(wid_l_)); const int lane_l_ = lane_id_v(); \
    const int wid = wid_l_, lane = lane_l_, tid = wid * 64 + lane, gw = c * 8 + wid; (void)lane; (void)gw; (void)wid; (void)tid; \
    GAS unsigned char* ws_l_ = (GAS unsigned char*)ws_k; GAS unsigned char* dout_l_ = (GAS unsigned char*)dout_k; asm volatile("" : "+s"(ws_l_), "+s"(dout_l_)); \
    unsigned char* const ws = (unsigned char*)ws_l_; unsigned char* const dout = (unsigned char*)dout_l_; (void)dout;
struct Args { const float* in[29]; float* out; unsigned char* ws; int ph_lo, ph_hi; };

__global__ void __launch_bounds__(512, 2) fwd(Args a) {
    extern __shared__ __attribute__((aligned(16))) unsigned char lds_[];
    LAS unsigned char* lds = (LAS unsigned char*)lds_;
    LAS char* ldc = (LAS char*)lds_;
    const int wid_k = __builtin_amdgcn_readfirstlane((int)threadIdx.x >> 6);
    const int G = gridDim.x, c = blockIdx.x, v = (G % 8 == 0) ? (c % 8) * (G / 8) + c / 8 : c;
    const int NGW = G * 8;
    volatile LAS unsigned* MISC = (volatile LAS unsigned*)(lds + LDS_MISC);
    if (threadIdx.x < 256) MISC[threadIdx.x] = 0u;
    __syncthreads();
    const InPtrs INP{a.in};
    unsigned char* const ws_k = a.ws;
    unsigned* ctl = (unsigned*)(ws_k + WS_CTL);
#if !MK_PER_PHASE
    XcdBarrier bar = xcd_barrier_post(ctl + CW_BAR, MISC + 8);
#define GRID_BAR() do { xcd_barrier(bar); if (PROBE_REPEAT == 17) xcd_barrier(bar); if (PROBE_STAMP >= 0) { ++st_ph; if (st_ph == PROBE_STAMP) st_t0 = __builtin_amdgcn_s_memrealtime(); if (st_ph == PROBE_STAMP + 1) st_t1 = __builtin_amdgcn_s_memrealtime(); } } while (0)
#else
#define GRID_BAR() do {} while (0)
#endif
    const int lo = a.ph_lo, hi = a.ph_hi;
#define STAMP_POINT(id) do { if (PROBE_STAMP == (id)) st_t0 = __builtin_amdgcn_s_memrealtime(); if (PROBE_STAMP + 1 == (id)) st_t1 = __builtin_amdgcn_s_memrealtime(); } while (0)
    int st_ph = 0; unsigned long long st_t0 = 0ull, st_t1 = 0ull; if (PROBE_STAMP == 0) st_t0 = __builtin_amdgcn_s_memrealtime(); (void)st_ph;
#define IN(k) (lo <= (k) && (k) < hi)
#define BOTH(k) (IN(k) && IN((k) + 1))
    unsigned char* const dout_k = (unsigned char*)a.out;
#define CS ((float*)(ws + WS_CS))
#define MISCF ((float*)(ws + WS_MISC))
#define RSQ ((float*)(ws + WS_RSQ))
#define RSKV ((float*)(ws + WS_RSKV))
#define RTE ((int*)(ws + WS_RTE))
#define RTP ((int*)(ws + WS_RTP))
#define RTG ((float*)(ws + WS_RTG))
#define ROWIDX ((int*)(ws + WS_ROWIDX))
#define KCMP ((bf16*)(ws + WS_KCMP))
#define VCMP ((bf16*)(ws + WS_VCMP))
#define UL ((bf16*)(ws + WS_UL))
#define Hb ((bf16*)(ws + WS_HB))
#define P ((bf16*)(ws + WS_P))
#define Z ((bf16*)(ws + WS_P))
#define YS ((bf16*)(ws + WS_P))
#define HS ((bf16*)(ws + WS_HS))
#define GSwg ((bf16*)(ws + WS_GS) + (size_t)c * 3 * 65536)
#define QM ((bf16*)(dout + DO_QM))
#define KVM ((bf16*)(dout + DO_KVM))
#define Y ((bf16*)(dout + DO_KVM))
#define W13T ((bf16*)(ws + WS_W13))
#define W2T ((bf16*)(ws + WS_W2))
#define LAYER_W unsigned char* wl = ws + WS_WTS + (size_t)l * WL_STRIDE; \
        const bf16* WinT = (const bf16*)(wl + WL_WIN); const bf16* WgT = (const bf16*)(wl + WL_WG); const bf16* WbrT = (const bf16*)(wl + WL_WBR); const bf16* WoutT = (const bf16*)(wl + WL_WOUT); \
        const bf16* WuqT = (const bf16*)(wl + WL_WUQ); const bf16* WukvT = (const bf16*)(wl + WL_WUKV); const bf16* Wc1T = (const bf16*)(wl + WL_WC1); \
        unsigned* gcnt = (unsigned*)(ws + WS_CTL) + CW_CNT + l * 16 * 64; (void)WinT; (void)WgT; (void)WbrT; (void)WoutT; (void)WuqT; (void)WukvT; (void)Wc1T; (void)gcnt;
    if (PHON(0) && IN(0)) { PHASE_IDS
        for (int rep_ = (PROBE_REPEAT == 15 ? 0 : 1); rep_ < 2; ++rep_) {
        LAS float* scr = (LAS float*)(lds + wid * 9216);
#define DEC_PRO(it, J) do { const int l_ = (it) / 2464; int r_ = (it) - l_ * 2464; unsigned char* wl_ = ws + WS_WTS + (size_t)l_ * WL_STRIDE; \
            if (r_ < 800) { J = TJob{INP[3] + (size_t)l_ * 1024 * IN_W, (bf16*)(wl_ + WL_WIN), IN_W, 1024, 3200, 1, r_}; } \
            else if ((r_ -= 800) < 768) { J = TJob{INP[3] + (size_t)l_ * 1024 * IN_W + 3256, (bf16*)(wl_ + WL_WG), IN_W, 1024, 3072, 0, r_}; } \
            else if ((r_ -= 768) < 384) { const int jb_ = r_ / 128; J = TJob{INP[16 + jb_] + (size_t)l_ * 512 * 1024, (bf16*)(wl_ + WL_WBR) + (size_t)jb_ * 1024 * 512, 1024, 512, 1024, 0, r_ - jb_ * 128}; } \
            else if ((r_ -= 384) < 256) { J = TJob{INP[19] + (size_t)l_ * 1024 * 1024, (bf16*)(wl_ + WL_WOUT), 1024, 1024, 1024, 0, r_}; } \
            else { r_ -= 256; const int job_ = r_ / 64, kv_ = job_ >> 1, half_ = job_ & 1; \
                J = TJob{INP[kv_ ? 8 : 5] + (size_t)l_ * 2048 * 256 + (size_t)half_ * 1024 * 256, (bf16*)(wl_ + WL_WC1) + (size_t)kv_ * 512 * 1024 + (size_t)half_ * 256 * 1024, 256, 1024, 256, 0, r_ - job_ * 64}; } } while (0)
        TCONV_LOOP(2 * 2464, DEC_PRO);
        for (int it = NGW - 1 - gw; it < 2 * 224; it += NGW) {   const int l_ = it / 224; int r_ = it - l_ * 224; unsigned char* wl_ = ws + WS_WTS + (size_t)l_ * WL_STRIDE;
            if (r_ < 64) tconv_item(INP[3] + (size_t)l_ * 1024 * IN_W, IN_W, nullptr, (bf16*)(wl_ + WL_WIN) + (size_t)3200 * 1024, 1024, 128, 3, r_, scr, lane);
            else if ((r_ -= 64) < 96) tconv_item(INP[14] + (size_t)l_ * 256 * 768, 768, INP[12] + l_ * 256, (bf16*)(wl_ + WL_WUQ), 256, 768, 2, r_, scr, lane);
            else tconv_item(INP[15] + (size_t)l_ * 128 * 1024, 1024, INP[13] + l_ * 128, (bf16*)(wl_ + WL_WUKV), 128, 1024, 0, r_ - 96, scr, lane); }
#undef DEC_PRO
        for (int i = c * 512 + tid; i < S * 16; i += G * 512) { const int pos = i >> 4, k = i & 15;
            const float freq = fexp2(-(float)k * (13.287712379549449f / 16.f)); const float ang = (float)pos * freq;
            const double rev = (double)ang * 0.15915494309189535; const float fr = (float)(rev - __builtin_rint(rev));
            CS[2 * i] = __builtin_amdgcn_cosf(fr); CS[2 * i + 1] = __builtin_amdgcn_sinf(fr); }
        for (int jt = c * 512 + tid; jt < 32768; jt += G * 512) { const int i = jt & 1023, ch = jt >> 10; const int l = i >> 9, kv = (i >> 8) & 1, n = i & 255;
            const float* pos = INP[kv ? 7 : 4] + l * 2048 + ch * 64; const float* w1 = INP[kv ? 8 : 5] + (size_t)l * 2048 * 256 + (size_t)ch * 64 * 256 + n; float s = 0.f;
#pragma unroll
            for (int k = 0; k < 64; ++k) s += pos[k] * w1[(size_t)k * 256];
            MISCF[2048 + ch * 1024 + i] = s; }
        if (c == 0 && tid < 2) { const float* lp = INP[10] + tid * 256; float s1 = 0.f, s2 = 0.f;
            for (int k = 0; k < 64; ++k) { s1 += lp[k] * lp[64 + k]; s2 += lp[128 + k] * lp[192 + k]; }
            const float li = 0.8f - 0.6f * __expf(-0.3f * (float)tid); MISCF[1024 + tid] = __expf(s1) - __expf(s2) + li; MISCF[1026 + tid] = li; }
        { f32x4 xn[4];
          if (gw < T) {
#pragma unroll
              for (int j = 0; j < 4; ++j) xn[j] = *(const f32x4*)(INP[0] + (size_t)gw * 1024 + 4 * lane + 256 * j); }
          for (int m = gw; m < T; m += NGW) { f32x4 x[4];
#pragma unroll
            for (int j = 0; j < 4; ++j) x[j] = xn[j];
            const int mn_ = m + NGW < T ? m + NGW : m;
#pragma unroll
            for (int j = 0; j < 4; ++j) xn[j] = *(const f32x4*)(INP[0] + (size_t)mn_ * 1024 + 4 * lane + 256 * j);
            ln_row(x, INP[1], INP[2], lane); store_row_bf16(Hb + (size_t)m * 1024, x, lane); } }
        }
        if (BOTH(0)) GRID_BAR();
    }

    for (int l = 0; l < NLAYER; ++l) {
        const int pbase = 1 + 11 * l;
        if (PHON(1) && IN(pbase + 0)) { PHASE_IDS LAYER_W
            for (int rep_ = (PROBE_REPEAT == 1 ? 0 : 1); rep_ < 2; ++rep_) {
            pg8::TileSched Sd{(const char*)Hb, (const char*)WinT, 2048, 1024, 13, 128 * 13, G, v}; pg8::EpiStore E{P, PW, nullptr, 0, false};
            pg8::gemm_phase<pg8::EpiStore, pg8::TileSched, true>(lds, wid, 1024, 128u, Sd, E);
            }
            if (BOTH(pbase + 0)) GRID_BAR();
        }
        if (PHON(2) && IN(pbase + 1)) { PHASE_IDS LAYER_W
            for (int i = gw; i < 512; i += NGW) {
                float sacc = lane < 32 ? MISCF[2048 + lane * 1024 + l * 512 + i] : 0.f;
#pragma unroll
                for (int o2 = 1; o2 < 32; o2 <<= 1) sacc += __shfl_xor(sacc, o2);
                if (lane == 0) MISCF[l * 512 + i] = sacc; }
            {
                const int grp = lane >> 4, q = lane & 15;
                const int nquad = (T + 3) >> 2;
                for (int qd = gw; qd < nquad; qd += NGW) {
                    const int m = 4 * qd + grp < T ? 4 * qd + grp : T - 1; const bf16* pr = P + (size_t)m * PW;
                    const u32x4 wa = *(const u32x4*)(pr + PC_CQ + 16 * q), wb = *(const u32x4*)(pr + PC_CQ + 16 * q + 8), wc = *(const u32x4*)(pr + PC_CKV + 8 * q);
                    const u32x4 wk = *(const u32x4*)(pr + PC_KR + 8 * (q & 3));
#define SQ8_(V_) (bflo((V_).x) * bflo((V_).x) + bfhi((V_).x) * bfhi((V_).x) + bflo((V_).y) * bflo((V_).y) + bfhi((V_).y) * bfhi((V_).y) + bflo((V_).z) * bflo((V_).z) + bfhi((V_).z) * bfhi((V_).z) + bflo((V_).w) * bflo((V_).w) + bfhi((V_).w) * bfhi((V_).w))
                    float sq = SQ8_(wa) + SQ8_(wb), skv = SQ8_(wc);
#undef SQ8_
                    if (q < 4) { const int i0 = q * 4, pos = m & (S - 1);
                        const f32x4* cs = (const f32x4*)(CS + ((size_t)pos * 16 + i0) * 2); const f32x4 ca = cs[0], cb = cs[1];
                        u32x4 o;
                        o.x = pk2(bflo(wk.x) * ca[0] - bfhi(wk.x) * ca[1], bflo(wk.x) * ca[1] + bfhi(wk.x) * ca[0]);
                        o.y = pk2(bflo(wk.y) * ca[2] - bfhi(wk.y) * ca[3], bflo(wk.y) * ca[3] + bfhi(wk.y) * ca[2]);
                        o.z = pk2(bflo(wk.z) * cb[0] - bfhi(wk.z) * cb[1], bflo(wk.z) * cb[1] + bfhi(wk.z) * cb[0]);
                        o.w = pk2(bflo(wk.w) * cb[2] - bfhi(wk.w) * cb[3], bflo(wk.w) * cb[3] + bfhi(wk.w) * cb[2]);
                        bf16* kr = KVM + (size_t)m * KVW + 64 + i0 * 2;
#pragma unroll
                        for (int hh = 0; hh < 8; ++hh) *(u32x4*)(kr + hh * 160) = o; }
                    sq = xsum_lo16(sq); skv = xsum_lo16(skv);
                    if (q == 0) { RSQ[m] = 1.f / sqrtf(sq * (1.f / 256.f) + 1e-6f); RSKV[m] = 1.f / sqrtf(skv * (1.f / 128.f) + 1e-6f); } }
            }
            if (BOTH(pbase + 1)) GRID_BAR();
        }
        if (PHON(3) && IN(pbase + 2)) { PHASE_IDS LAYER_W
            for (int rep_ = (PROBE_REPEAT == 3 ? 0 : 1); rep_ < 2; ++rep_) {
            const bool cmpwg = G > 64 && v >= G - 64; const int Gs = G > 64 ? G - 64 : G;
            { pg8::TileSched Sd{(const char*)(P + PC_CQ), (const char*)WuqT, PW * 2, 256, 3, cmpwg ? 0 : 384, Gs, v}; pg8::EpiRope E{QM, CS};
              pg8::gemm_phase<pg8::EpiRope, pg8::TileSched, true>(lds, wid, 256, 128u, Sd, E); }
            { pg8::TileSched Sd{(const char*)(P + PC_CKV), (const char*)WukvT, PW * 2, 128, 4, cmpwg ? 0 : 512, Gs, v}; pg8::EpiStore E{KVM, KVW, RSKV, 0, true};
              pg8::gemm_phase<pg8::EpiStore, pg8::TileSched, true>(lds, wid, 128, 128u, Sd, E); }
            { pg8::CmpSched Sd{(const char*)P, (const char*)Wc1T, G, v >= G - 64 ? v - (G - 64) : 64 + v}; pg8::EpiStore E{UL, 512, nullptr, (size_t)512 * 512, false};
              pg8::gemm_phase<pg8::EpiStore, pg8::CmpSched, true>(lds, wid, 1024, (unsigned)(PW * 2), Sd, E); }
            }
            if (BOTH(pbase + 2)) GRID_BAR();
        }
        if (PHON(4) && IN(pbase + 3)) { PHASE_IDS LAYER_W
            for (int rep_ = (PROBE_REPEAT == 4 ? 0 : 1); rep_ < 2; ++rep_) {
            for (int task = c; task < 256; task += G) {
                const int kv = task >> 7, bg = (task >> 4) & 7, i = 32 * (task & 15) + (lane & 31), hb2 = lane >> 5, r32c = lane & 31, ic = i < 511 ? i : 510;
                const bf16* u_ = UL + ((size_t)(kv * 8 + bg) * 512 + ic) * 512 + 8 * hb2; const float* pbv = MISCF + l * 512 + kv * 256 + 8 * hb2;
                const float* w2 = INP[kv ? 9 : 6] + (size_t)l * 256 * 64 + (size_t)(8 * hb2) * 64 + r32c;
                f32x16 acc0, acc1;
#pragma unroll
                for (int q = 0; q < 16; ++q) { acc0[q] = 0.f; acc1[q] = 0.f; }
#pragma unroll
                for (int kk = 0; kk < 2; ++kk) { const int ks = 2 * wid + kk;
                    const u32x4 ua = *(const u32x4*)(u_ + 16 * ks), la = *(const u32x4*)(u_ + 512 + 256 + 16 * ks); const f32x4 p0 = *(const f32x4*)(pbv + 16 * ks), p1 = *(const f32x4*)(pbv + 16 * ks + 4);
                    float x[8] = {bflo(ua.x) + bflo(la.x) + p0[0], bfhi(ua.x) + bfhi(la.x) + p0[1], bflo(ua.y) + bflo(la.y) + p0[2], bfhi(ua.y) + bfhi(la.y) + p0[3],
                                  bflo(ua.z) + bflo(la.z) + p1[0], bfhi(ua.z) + bfhi(la.z) + p1[1], bflo(ua.w) + bflo(la.w) + p1[2], bfhi(ua.w) + bfhi(la.w) + p1[3]};
#pragma unroll
                    for (int q = 0; q < 8; ++q) { const float xx = x[q]; const float y = 0.7978845608028654f * (xx + 0.044715f * xx * xx * xx);
                        const float th = 1.f - 2.f * __builtin_amdgcn_rcpf(fexp2(2.f * LOG2E * y) + 1.f); x[q] = 0.5f * xx * (1.f + th); }
                    u32x4 hw; hw.x = pk2(x[0], x[1]); hw.y = pk2(x[2], x[3]); hw.z = pk2(x[4], x[5]); hw.w = pk2(x[6], x[7]);
                    const float* wk = w2 + (size_t)(16 * ks) * 64;
                    u32x4 a0, a1;
                    a0.x = pk2(wk[0], wk[64]); a0.y = pk2(wk[128], wk[192]); a0.z = pk2(wk[256], wk[320]); a0.w = pk2(wk[384], wk[448]);
                    a1.x = pk2(wk[32], wk[96]); a1.y = pk2(wk[160], wk[224]); a1.z = pk2(wk[288], wk[352]); a1.w = pk2(wk[416], wk[480]);
                    acc0 = __builtin_amdgcn_mfma_f32_32x32x16_bf16(__builtin_bit_cast(bf16x8, a0), __builtin_bit_cast(bf16x8, hw), acc0, 0, 0, 0);
                    acc1 = __builtin_amdgcn_mfma_f32_32x32x16_bf16(__builtin_bit_cast(bf16x8, a1), __builtin_bit_cast(bf16x8, hw), acc1, 0, 0, 0);
                }
                LAS float* part = (LAS float*)lds;
#pragma unroll
                for (int q = 0; q < 16; ++q) { part[(wid * 32 + q) * 64 + lane] = acc0[q]; part[(wid * 32 + 16 + q) * 64 + lane] = acc1[q]; }
                __syncthreads();
                float r4[4] = {0.f, 0.f, 0.f, 0.f};
#pragma unroll
                for (int w = 0; w < 8; ++w)
#pragma unroll
                    for (int q = 0; q < 4; ++q) r4[q] += part[(w * 32 + 4 * wid + q) * 64 + lane];
                const bool pad = (i == 511);
                u32x2 wv_; wv_.x = pad ? 0u : pk2(r4[0], r4[1]); wv_.y = pad ? 0u : pk2(r4[2], r4[3]);
                *(u32x2*)((kv ? VCMP : KCMP) + ((size_t)bg * 512 + i) * 64 + 32 * (wid >> 2) + 8 * (wid & 3) + 4 * hb2) = wv_;
                __syncthreads();
            }
            }
            if (BOTH(pbase + 3)) GRID_BAR();
        }
        if (PHON(5) && IN(pbase + 4)) { PHASE_IDS LAYER_W
            const int xcd = c & 7, ii = c >> 3;
            if (G == 256) {
                if (l == 0) STAMP_POINT(110);
#if ATT_QUEUE
                if (l == 0) STAMP_POINT(100);
                if (PHON(11)) for (int k = 0; k < 4; ++k) { const int bh = xcd + 8 * k; mla_unit(ldc, bh >> 3, bh & 7, (k & 1) ? ii : 31 - ii, QM, KVM, RSQ, wid); }
                if (l == 0) STAMP_POINT(101);
                if (PHON(12)) for (int k = 0; k < 2; ++k) { const int bh = xcd + 8 * k; diff_unit(ldc, bh >> 2, bh & 3, k ? ii : 31 - ii, P, MISCF[1024 + l], MISCF[1026 + l], INP[11] + l * 128, GSwg, wid); }
                if (l == 0) STAMP_POINT(102);
                if (PHON(13)) { volatile LAS int* qs = (volatile LAS int*)(MISC + 240);
                    unsigned* qh = (unsigned*)(ws + WS_CTL) + CW_ATQ + (l * 8 + xcd) * 64;
                    __syncthreads();
                    if (tid == 0) qs[0] = (int)xb_add(qh, 1u);
                    __syncthreads();
                    for (;;) {
                        const int idx = __builtin_amdgcn_readfirstlane(qs[0]);
                        __syncthreads();
                        if (idx >= 128) break;
                        int nxt = 0; if (tid == 0) nxt = (int)xb_add(qh, 1u);
                        nsa_unit(ldc, xcd >> 1, xcd & 1, 127 - idx, P, KCMP, VCMP, wid);
                        if (tid == 0) qs[0] = nxt;
                        __syncthreads();
                    }
                }
#else
                if (l == 0) STAMP_POINT(100);
                for (int rep = (PROBE_REPEAT == 11 ? 0 : 1); rep < 2; ++rep)
                if (PHON(11)) for (int k = 0; k < 4; ++k) { const int bh = xcd + 8 * k; mla_unit(ldc, bh >> 3, bh & 7, (k & 1) ? ii : 31 - ii, QM, KVM, RSQ, wid, rep == 0); }
                if (l == 0) STAMP_POINT(101);
                for (int rep = (PROBE_REPEAT == 12 ? 0 : 1); rep < 2; ++rep)
                if (PHON(12)) for (int k = 0; k < 2; ++k) { const int bh = xcd + 8 * k; diff_unit(ldc, bh >> 2, bh & 3, k ? ii : 31 - ii, P, MISCF[1024 + l], MISCF[1026 + l], INP[11] + l * 128, GSwg, wid, rep == 0); }
                if (l == 0) STAMP_POINT(102);
                if (PHON(13)) for (int k = (PROBE_REPEAT == 13 ? -4 : 0); k < 4; ++k) { const int kk = k & 3; const int tile = (kk == 0) ? ii : (kk == 1) ? 63 - ii : (kk == 2) ? 64 + ii : 127 - ii; nsa_unit(ldc, xcd >> 1, xcd & 1, tile, P, KCMP, VCMP, wid, k < 0); }
                if (l == 0) STAMP_POINT(103);
#endif
                if (l == 0) STAMP_POINT(111);
            } else {
                if (PHON(11)) for (int u = c; u < 1024; u += G) { const int bh = u & 31; mla_unit(ldc, bh >> 3, bh & 7, 31 - (u >> 5), QM, KVM, RSQ, wid); }
                if (PHON(12)) for (int u = c; u < 512; u += G) { const int bh = u & 15; diff_unit(ldc, bh >> 2, bh & 3, 31 - (u >> 4), P, MISCF[1024 + l], MISCF[1026 + l], INP[11] + l * 128, GSwg, wid); }
                if (PHON(13)) for (int u = c; u < 1024; u += G) { const int bg = u & 7; nsa_unit(ldc, bg >> 1, bg & 1, 127 - (u >> 3), P, KCMP, VCMP, wid); }
            }
            { __syncthreads();
              unsigned* cvq = (unsigned*)(ws + WS_CTL) + CW_CVQ + l * 64;
              const int lane_c = lane_id_v(); LAS float* scr = (LAS float*)(lds + wid * 9216);
#define CVQ_DECODE(it_, J_) do { const int e_ = (it_) / 384; const int r_ = (it_) - e_ * 384; (J_).mode = 0; \
                  if (r_ < 256) { const int job_ = r_ >> 5, pn_ = job_ >> 1, half_ = job_ & 1; (J_).W = INP[half_ ? 25 : 24] + ((size_t)l * 16 + e_) * 1024 * 512 + pn_ * 128; (J_).ldw = 512; \
                      (J_).WT = W13T + (size_t)e_ * 1024 * 1024 + (size_t)(pn_ * 256 + half_ * 128) * 1024; (J_).K = 1024; (J_).N = 128; (J_).item = r_ & 31; } \
                  else { (J_).W = INP[26] + ((size_t)l * 16 + e_) * 512 * 1024; (J_).ldw = 1024; (J_).WT = W2T + (size_t)e_ * 1024 * 512; (J_).K = 512; (J_).N = 1024; (J_).item = r_ - 256; } } while (0)
              int it = 0; if (lane_c == 0) it = (int)xb_add(cvq, 1u); it = __builtin_amdgcn_readfirstlane(it);
              if (it < 16 * 384) { TJob cur_; f32x4 xc_[16]; CVQ_DECODE(it, cur_); tconv_load(cur_, xc_, lane_c);
                  for (;;) { int nit = 0; if (lane_c == 0) nit = (int)xb_add(cvq, 1u); nit = __builtin_amdgcn_readfirstlane(nit);
                      const bool hn_ = nit < 16 * 384; TJob nx_ = cur_; f32x4 xn_[16];
#pragma unroll
                      for (int q_ = 0; q_ < 16; ++q_) xn_[q_] = xc_[q_];
                      if (hn_) { CVQ_DECODE(nit, nx_); tconv_load(nx_, xn_, lane_c); }
                      tconv_finish(cur_, xc_, scr, lane_c); if (!hn_) break; cur_ = nx_;
#pragma unroll
                      for (int q_ = 0; q_ < 16; ++q_) xc_[q_] = xn_[q_]; } }
#undef CVQ_DECODE
            }
            if (BOTH(pbase + 4)) GRID_BAR();
        }
        if (PHON(6) && IN(pbase + 5)) { PHASE_IDS LAYER_W
            for (int rep_ = (PROBE_REPEAT == 6 ? 0 : 1); rep_ < 2; ++rep_) {
            for (int tl = v; tl < 512; tl += G) {
                const int pm = tl >> 2, pn = tl & 3;
                { pg8::GateSched Sd{(const char*)Hb, (const char*)WgT, pm, pn, true}; pg8::EpiGate E{(unsigned char*)GSwg};
                  pg8::gemm_phase<pg8::EpiGate, pg8::GateSched, true>(lds, wid, 1024, 128u, Sd, E); }
                { pg8::ChainSched Sd{(const char*)(P + PC_NQ), (const char*)(P + PC_DQ), (const char*)QM, (const char*)WbrT, pm, pn, true}; pg8::EpiChain E{Y, (const unsigned char*)GSwg};
                  pg8::gemm_phase<pg8::EpiChain, pg8::ChainSched, true>(lds, wid, 512, 128u, Sd, E); }
            }
            }
            if (BOTH(pbase + 5)) GRID_BAR();
        }
        if (PHON(7) && IN(pbase + 6)) { PHASE_IDS LAYER_W
            for (int rep_ = (PROBE_REPEAT == 7 ? 0 : 1); rep_ < 2; ++rep_) {
            pg8::TileSched Sd{(const char*)Y, (const char*)WoutT, 2048, 1024, 4, 512, G, v}; pg8::EpiResid E{Z, Hb};
            pg8::gemm_phase<pg8::EpiResid, pg8::TileSched, true>(lds, wid, 1024, 128u, Sd, E);
            }
            if (BOTH(pbase + 6)) GRID_BAR();
        }
        if (PHON(8) && IN(pbase + 7)) { PHASE_IDS LAYER_W
            if (l == 0) STAMP_POINT(120);
            for (int i = tid; i < 2048; i += 512) { const int s_ = i >> 6, ln_ = i & 63, e_ = ln_ & 15, k0_ = 32 * s_ + 8 * (ln_ >> 4); float wv_[8]; unsigned hi_[8], lo_[8];
#pragma unroll
                for (int q = 0; q < 8; ++q) { wv_[q] = INP[22][(size_t)(k0_ + q) * 16 + e_]; hi_[q] = f2bf(wv_[q]); lo_[q] = f2bf(wv_[q] - __uint_as_float(hi_[q] << 16)); }
                *(LAS u32x4*)(lds + i * 16) = (u32x4){hi_[0] | (hi_[1] << 16), hi_[2] | (hi_[3] << 16), hi_[4] | (hi_[5] << 16), hi_[6] | (hi_[7] << 16)};
                *(LAS u32x4*)(lds + 32768 + i * 16) = (u32x4){lo_[0] | (lo_[1] << 16), lo_[2] | (lo_[3] << 16), lo_[4] | (lo_[5] << 16), lo_[6] | (lo_[7] << 16)}; }
            volatile LAS int* cntL = (volatile LAS int*)(MISC + 16); volatile LAS int* cbase = (volatile LAS int*)(MISC + 32);
            const float* g1 = INP[20] + l * 1024; const float* b1 = INP[21] + l * 1024; const float* rb = INP[23];
            const int nit = (T + G * 128 - 1) / (G * 128);
            for (int rep_ = (PROBE_REPEAT == 8 ? 0 : 1); rep_ < 2; ++rep_)
            for (int it = 0; it < nit; ++it) {
                if (tid < 16) cntL[tid] = 0;
                __syncthreads();
                const int base = (it * G + c) * 128 + wid * 16;
                int e0 = -1, e1 = -1; float g0 = 0.f, g1v = 0.f;
                { const int n16 = lane & 15, c4 = lane >> 4; const int m = base + n16 < T ? base + n16 : T - 1;
                  const bf16* zrow = Z + (size_t)m * 1024 + 8 * c4; bf16* hrow = Hb + (size_t)m * 1024 + 8 * c4;
                  if (l == 0) STAMP_POINT(121);
                  float sm = 0.f, sq = 0.f;
                  for (int sb_ = 0; sb_ < 32; sb_ += 8) { u32x4 zt[8];
#pragma unroll
                      for (int q = 0; q < 8; ++q) zt[q] = *(const u32x4*)(zrow + 32 * (sb_ + q));
#pragma unroll
                      for (int q = 0; q < 8; ++q) { const u32x4 w = zt[q]; const float a0 = bflo(w.x), a1 = bfhi(w.x), a2 = bflo(w.y), a3 = bfhi(w.y), a4 = bflo(w.z), a5 = bfhi(w.z), a6 = bflo(w.w), a7 = bfhi(w.w);
                          sm += ((a0 + a1) + (a2 + a3)) + ((a4 + a5) + (a6 + a7)); sq += ((a0 * a0 + a1 * a1) + (a2 * a2 + a3 * a3)) + ((a4 * a4 + a5 * a5) + (a6 * a6 + a7 * a7)); } }
                  sm = hsum(xsum16(sm)); sq = hsum(xsum16(sq));
                  const float mean = sm * (1.f / 1024.f), var = fmaxf(sq * (1.f / 1024.f) - mean * mean, 0.f), rstd = __builtin_amdgcn_rsqf(var + 1e-5f);
                  f32x4 lg = {0.f, 0.f, 0.f, 0.f};
#pragma unroll 4
                  for (int s_ = 0; s_ < 32; ++s_) { const u32x4 w = *(const u32x4*)(zrow + 32 * s_);
                      const f32x4 ga = *(const f32x4*)(g1 + 32 * s_ + 8 * c4), gb = *(const f32x4*)(g1 + 32 * s_ + 8 * c4 + 4), ba = *(const f32x4*)(b1 + 32 * s_ + 8 * c4), bb = *(const f32x4*)(b1 + 32 * s_ + 8 * c4 + 4);
                      const float x0 = (bflo(w.x) - mean) * rstd * ga[0] + ba[0], x1 = (bfhi(w.x) - mean) * rstd * ga[1] + ba[1], x2 = (bflo(w.y) - mean) * rstd * ga[2] + ba[2], x3 = (bfhi(w.y) - mean) * rstd * ga[3] + ba[3];
                      const float x4 = (bflo(w.z) - mean) * rstd * gb[0] + bb[0], x5 = (bfhi(w.z) - mean) * rstd * gb[1] + bb[1], x6 = (bflo(w.w) - mean) * rstd * gb[2] + bb[2], x7 = (bfhi(w.w) - mean) * rstd * gb[3] + bb[3];
                      u32x4 hi; hi.x = pk2(x0, x1); hi.y = pk2(x2, x3); hi.z = pk2(x4, x5); hi.w = pk2(x6, x7);
                      if (base + n16 < T) *(u32x4*)(hrow + 32 * s_) = hi;
                      u32x4 lo; lo.x = pk2(x0 - bflo(hi.x), x1 - bfhi(hi.x)); lo.y = pk2(x2 - bflo(hi.y), x3 - bfhi(hi.y)); lo.z = pk2(x4 - bflo(hi.z), x5 - bfhi(hi.z)); lo.w = pk2(x6 - bflo(hi.w), x7 - bfhi(hi.w));
                      const bf16x8 ah = *(const LAS bf16x8*)(lds + (s_ * 64 + lane) * 16), al = *(const LAS bf16x8*)(lds + 32768 + (s_ * 64 + lane) * 16);
                      lg = __builtin_amdgcn_mfma_f32_16x16x32_bf16(ah, __builtin_bit_cast(bf16x8, hi), lg, 0, 0, 0);
                      lg = __builtin_amdgcn_mfma_f32_16x16x32_bf16(al, __builtin_bit_cast(bf16x8, hi), lg, 0, 0, 0);
                      lg = __builtin_amdgcn_mfma_f32_16x16x32_bf16(ah, __builtin_bit_cast(bf16x8, lo), lg, 0, 0, 0); }
                  const f32x4 rbv = *(const f32x4*)(rb + 4 * c4);
                  float aff[4], sel[4];
#pragma unroll
                  for (int q = 0; q < 4; ++q) { aff[q] = sigmoidf_(lg[q]); sel[q] = aff[q] + rbv[q]; }
                  float m1 = sel[0], m2 = -1e30f;
#pragma unroll
                  for (int q = 1; q < 4; ++q) { const float sv = sel[q]; if (sv > m1) { m2 = m1; m1 = sv; } else if (sv > m2) m2 = sv; }
                  const float gsc = m1 + m2;
                  int grp = 0; float best = __shfl(gsc, n16);
#pragma unroll
                  for (int gq = 1; gq < 4; ++gq) { const float sc = __shfl(gsc, n16 + 16 * gq); if (sc > best) { best = sc; grp = gq; } }
                  int i1 = 0;
#pragma unroll
                  for (int q = 1; q < 4; ++q) if (sel[q] > sel[i1 == 0 ? 0 : i1 == 1 ? 1 : i1 == 2 ? 2 : 3]) i1 = q;
                  int i2 = -1; float b2 = -1e30f;
#pragma unroll
                  for (int q = 0; q < 4; ++q) if (q != i1 && sel[q] > b2) { b2 = sel[q]; i2 = q; }
                  const float a1 = i1 == 0 ? aff[0] : i1 == 1 ? aff[1] : i1 == 2 ? aff[2] : aff[3], a2 = i2 == 0 ? aff[0] : i2 == 1 ? aff[1] : i2 == 2 ? aff[2] : aff[3];
                  const float inv = __builtin_amdgcn_rcpf(a1 + a2);
                  const int src = n16 + 16 * grp;
                  const int te0 = __shfl(4 * c4 + i1, src), te1 = __shfl(4 * c4 + i2, src); const float tg0 = __shfl(a1 * inv, src), tg1 = __shfl(a2 * inv, src);
                  if (lane < 16 && base + lane < T) { e0 = te0; e1 = te1; g0 = tg0; g1v = tg1; } }
                if (l == 0) STAMP_POINT(122);
                int p0 = 0, p1 = 0, mycount = 0; const unsigned long long lt = (1ull << lane) - 1ull;
#pragma unroll
                for (int e = 0; e < 16; ++e) { const unsigned long long b0 = __ballot(e0 == e), bb1 = __ballot(e1 == e); const int c0 = __popcll(b0);
                    if (lane == e) mycount = c0 + __popcll(bb1); if (e0 == e) p0 = __popcll(b0 & lt); if (e1 == e) p1 = c0 + __popcll(bb1 & lt); }
                int woff = 0; if (lane < 16) woff = __hip_atomic_fetch_add((LAS int*)(MISC + 16) + lane, mycount, __ATOMIC_RELAXED, __HIP_MEMORY_SCOPE_WORKGROUP);
                __syncthreads();
                if (tid < 16 && rep_) cbase[tid] = (int)xb_add(gcnt + tid * 64, (unsigned)cntL[tid]);
                __syncthreads();
                const int wo0 = __shfl(woff, e0 < 0 ? 0 : e0), wo1 = __shfl(woff, e1 < 0 ? 0 : e1);
                if (e0 >= 0 && rep_) { const int m = base + lane; const int q0 = cbase[e0] + wo0 + p0, q1 = cbase[e1] + wo1 + p1;
                    ROWIDX[e0 * CAP + q0] = m; ROWIDX[e1 * CAP + q1] = m; RTE[2 * m] = e0; RTE[2 * m + 1] = e1; RTP[2 * m] = q0; RTP[2 * m + 1] = q1; RTG[2 * m] = g0; RTG[2 * m + 1] = g1v; }
                __syncthreads();
            }
            if (BOTH(pbase + 7)) GRID_BAR();
        }
        if (PHON(9) && (IN(pbase + 8) || IN(pbase + 9))) { PHASE_IDS LAYER_W
            volatile LAS int* TP = (volatile LAS int*)(MISC + 64); volatile LAS int* CNT = (volatile LAS int*)(MISC + 96);
            if (tid == 0) { int acc = 0; for (int e = 0; e < 16; ++e) { const int cn = (int)xb_ld(gcnt + e * 64); CNT[e] = cn; TP[e] = acc; acc += (cn + 255) >> 8; } TP[16] = acc; }
            __syncthreads();
            if (IN(pbase + 8)) {
                pg8::MoeSched Sd{(const char*)Hb, (const char*)W13T, ROWIDX, TP, CNT, 2048, 1024, (size_t)1024 * 1024 * 2, true, G, v}; pg8::EpiSwiglu E{HS};
                for (int rep_ = (PROBE_REPEAT == 9 ? 0 : 1); rep_ < 2; ++rep_)
                pg8::gemm_phase<pg8::EpiSwiglu, pg8::MoeSched, true>(lds, wid, 1024, 128u, Sd, E);
                if (BOTH(pbase + 8)) GRID_BAR();
            }
            if (IN(pbase + 9)) {
                pg8::MoeSched Sd{(const char*)HS, (const char*)W2T, ROWIDX, TP, CNT, 1024, 512, (size_t)1024 * 512 * 2, false, G, v}; pg8::EpiStore E{YS, 1024, nullptr, 0, false};
                for (int rep_ = (PROBE_REPEAT == 14 ? 0 : 1); rep_ < 2; ++rep_)
                pg8::gemm_phase<pg8::EpiStore, pg8::MoeSched, true>(lds, wid, 512, 128u, Sd, E);
                if (BOTH(pbase + 9)) GRID_BAR();
            }
        }
        if (PHON(10) && IN(pbase + 10)) { PHASE_IDS LAYER_W
            int tp = 0;
            { const int cn = lane < 16 ? (int)xb_ld(gcnt + lane * 64) : 0; const int tl = (cn + 255) >> 8; int inc = tl;
#pragma unroll
              for (int o = 1; o < 16; o <<= 1) { const int n = __shfl_up(inc, o); if (lane >= o) inc += n; }
              tp = inc - tl; }
            const float* g2 = INP[27] + l * 1024; const float* b2 = INP[28] + l * 1024;
            {
                auto clampm = [&](int mm) { return mm < T ? mm : (T - 1); };
                int m = gw;
                int2 re_n, rp_n; float2 rg_n;
                u32x2 hw_c[4], y0_c[4], y1_c[4]; float g0_c, g1_c;
                { const int mc = clampm(m); const int2 re = *(const int2*)(RTE + 2 * mc), rp = *(const int2*)(RTP + 2 * mc); const float2 rg = *(const float2*)(RTG + 2 * mc);
                  const int r0 = __shfl(tp, re.x) * 256 + rp.x, r1 = __shfl(tp, re.y) * 256 + rp.y; g0_c = rg.x; g1_c = rg.y;
#pragma unroll
                  for (int j = 0; j < 4; ++j) { const int col = 4 * lane + 256 * j; hw_c[j] = *(const u32x2*)(Hb + (size_t)mc * 1024 + col); y0_c[j] = *(const u32x2*)(YS + (size_t)r0 * 1024 + col); y1_c[j] = *(const u32x2*)(YS + (size_t)r1 * 1024 + col); }
                  const int mn = clampm(m + NGW); re_n = *(const int2*)(RTE + 2 * mn); rp_n = *(const int2*)(RTP + 2 * mn); rg_n = *(const float2*)(RTG + 2 * mn); }
                for (; m < T; m += NGW) {
                    u32x2 hw_n[4], y0_n[4], y1_n[4]; const float g0_n = rg_n.x, g1_n = rg_n.y;
                    { const int mn = clampm(m + NGW); const int r0 = __shfl(tp, re_n.x) * 256 + rp_n.x, r1 = __shfl(tp, re_n.y) * 256 + rp_n.y;
#pragma unroll
                      for (int j = 0; j < 4; ++j) { const int col = 4 * lane + 256 * j; hw_n[j] = *(const u32x2*)(Hb + (size_t)mn * 1024 + col); y0_n[j] = *(const u32x2*)(YS + (size_t)r0 * 1024 + col); y1_n[j] = *(const u32x2*)(YS + (size_t)r1 * 1024 + col); }
                      const int m2 = clampm(m + 2 * NGW); re_n = *(const int2*)(RTE + 2 * m2); rp_n = *(const int2*)(RTP + 2 * m2); rg_n = *(const float2*)(RTG + 2 * m2); }
                    f32x4 x[4];
#pragma unroll
                    for (int j = 0; j < 4; ++j) { const u32x2 hw = hw_c[j], y0 = y0_c[j], y1 = y1_c[j];
                        x[j][0] = ALPHA * bflo(hw.x) + g0_c * bflo(y0.x) + g1_c * bflo(y1.x); x[j][1] = ALPHA * bfhi(hw.x) + g0_c * bfhi(y0.x) + g1_c * bfhi(y1.x);
                        x[j][2] = ALPHA * bflo(hw.y) + g0_c * bflo(y0.y) + g1_c * bflo(y1.y); x[j][3] = ALPHA * bfhi(hw.y) + g0_c * bfhi(y0.y) + g1_c * bfhi(y1.y); }
                    ln_row(x, g2, b2, lane);
                    if (l == NLAYER - 1) {
#pragma unroll
                        for (int j = 0; j < 4; ++j) *(f32x4*)((float*)dout + (size_t)m * 1024 + 4 * lane + 256 * j) = x[j];
                    } else store_row_bf16(Hb + (size_t)m * 1024, x, lane);
#pragma unroll
                    for (int j = 0; j < 4; ++j) { hw_c[j] = hw_n[j]; y0_c[j] = y0_n[j]; y1_c[j] = y1_n[j]; }
                    g0_c = g0_n; g1_c = g1_n;
                }
            }
            if (BOTH(pbase + 10)) GRID_BAR();
        }
    }
    if (PROBE_STAMP >= 0 && blockIdx.x == PROBE_BLOCK && threadIdx.x == 0) {
        if (st_t1 == 0ull) st_t1 = __builtin_amdgcn_s_memrealtime();
        const unsigned long long d = (PROBE_STAMP >= 200) ? (unsigned long long)*(volatile LAS unsigned*)(lds + 131072 + 800) : st_t1 - st_t0, tend = __builtin_amdgcn_s_memrealtime();
        while (__builtin_amdgcn_s_memrealtime() - tend < 8ull * d) __builtin_amdgcn_s_sleep(8);
    }
#undef IN
#undef BOTH
}

extern "C" void kernel_launch(void* const* d_in, const int* in_sizes, int n_in, void* d_out, int out_size, void* d_ws, size_t ws_size, hipStream_t stream) {
    static int grid = 0;
    if (grid == 0) {
        if (n_in != 29 || out_size != T * DM || ws_size < WS_END) { fprintf(stderr, "kernel_launch: unexpected shapes (n_in %d out %d ws %zu)\n", n_in, out_size, ws_size); grid = -1; return; }
        int dev = 0, cus = 0, per_cu = 0;
        if (hipGetDevice(&dev) != hipSuccess || hipDeviceGetAttribute(&cus, hipDeviceAttributeMultiprocessorCount, dev) != hipSuccess) { grid = -1; return; }
        if (hipFuncSetAttribute((const void*)fwd, hipFuncAttributeMaxDynamicSharedMemorySize, LDS_BYTES) != hipSuccess) { fprintf(stderr, "kernel_launch: hipFuncSetAttribute failed\n"); grid = -1; return; }
        if (hipOccupancyMaxActiveBlocksPerMultiprocessor(&per_cu, (const void*)fwd, 512, LDS_BYTES) != hipSuccess || per_cu < 1) fprintf(stderr, "kernel_launch: occupancy query reports %d\n", per_cu);
        (void)hipGetLastError();
        grid = cus;
    }
    if (grid < 0) return;
    (void)hipMemsetAsync((char*)d_ws + WS_CTL, 0, CTL_BYTES, stream);
    Args a{};
    for (int i = 0; i < 29; ++i) a.in[i] = (const float*)d_in[i];
    a.out = (float*)d_out; a.ws = (unsigned char*)d_ws;
#if MK_PER_PHASE
    for (int p = 0; p < NPHASE; ++p) { a.ph_lo = p; a.ph_hi = p + 1; hipLaunchKernelGGL(fwd, dim3(grid), dim3(512), LDS_BYTES, stream, a); }
#else
    a.ph_lo = 0; a.ph_hi = NPHASE; hipLaunchKernelGGL(fwd, dim3(grid), dim3(512), LDS_BYTES, stream, a);
#endif
}
```
